# Optimizing an MI355X kernel written in HIP

```python
import jax, jax.numpy as jnp
from jax import lax
import numpy as np

D_MODEL = 1024
BATCH = 8
SEQ = 2048
DEPTH = 1
DEC_BATCH = 16
DEC_SEQ = 4096
PAST_LEN = 128

MIX_WIDTH = D_MODEL
ATTN_WIDTH = MIX_WIDTH // 2
HEAD_DIM = 64
N_HEADS = ATTN_WIDTH // HEAD_DIM
N_KV_HEADS = 2
KV_GROUP = N_HEADS // N_KV_HEADS
KV_WIDTH = N_KV_HEADS * HEAD_DIM
WINDOW = 128
ATTN_BLOCK = 128
HG_WIDTH = MIX_WIDTH - ATTN_WIDTH
HG_EXPAND = 128
HG_HEADS = HG_WIDTH // HG_EXPAND
HG_DK = HG_EXPAND
HG_DV = HG_WIDTH // HG_HEADS
HG_KDIM = HG_HEADS * HG_DK
HG_CHUNK = 64
D_FF = 2816
ALPHA = (2.0 * DEPTH) ** 0.25
BETA_INIT = (8.0 * DEPTH) ** -0.25
EPS = 1e-5
IN_SIZES = (ATTN_WIDTH, KV_WIDTH, KV_WIDTH, HG_KDIM, HG_KDIM, HG_KDIM, HG_WIDTH, HG_WIDTH)
IN_COLS = ATTN_WIDTH + 2 * KV_WIDTH + 3 * HG_KDIM + 2 * HG_WIDTH

kernel_name = "hymba_swa_hgrn2_macaron_deepnorm_encoder"


def layer_norm(x, g, b):
    xf = x.astype(jnp.float32)
    mu = jnp.mean(xf, axis=-1, keepdims=True)
    var = jnp.mean(jnp.square(xf - mu), axis=-1, keepdims=True)
    y = (xf - mu) * lax.rsqrt(var + EPS) * g.astype(jnp.float32) + b.astype(jnp.float32)
    return y.astype(x.dtype)


def group_rms_norm(x, g, n_groups):
    shp = x.shape
    xf = x.astype(jnp.float32).reshape(shp[:-1] + (n_groups, shp[-1] // n_groups))
    xf = xf * lax.rsqrt(jnp.mean(jnp.square(xf), axis=-1, keepdims=True) + EPS)
    return (xf.reshape(shp) * g.astype(jnp.float32)).astype(x.dtype)


def swiglu_ffn(x, w13, w2):
    gate, up = jnp.split(x @ w13, 2, axis=-1)
    return (jax.nn.silu(gate) * up) @ w2


def split_in_proj(proj):
    outs, off = [], 0
    for s in IN_SIZES:
        outs.append(proj[..., off:off + s])
        off += s
    return outs


def windowed_gqa_attention(q, k, v, sink):
    B, T = q.shape[0], q.shape[1]
    nb = T // ATTN_BLOCK
    span = ATTN_BLOCK + 2 * WINDOW
    qb = jnp.moveaxis(q.reshape(B, nb, ATTN_BLOCK, N_KV_HEADS, KV_GROUP, HEAD_DIM), 1, 0)
    pad = ((0, 0), (WINDOW, WINDOW), (0, 0), (0, 0))
    kp = jnp.pad(k, pad)
    vp = jnp.pad(v, pad)
    slopes = 2.0 ** (-8.0 * jnp.arange(1, N_HEADS + 1, dtype=jnp.float32) / N_HEADS)
    slopes = slopes.reshape(1, N_KV_HEADS, KV_GROUP, 1, 1)
    sink5 = sink.astype(jnp.float32).reshape(1, N_KV_HEADS, KV_GROUP, 1, 1)
    scale = HEAD_DIM ** -0.5
    offs_q = jnp.arange(ATTN_BLOCK)
    offs_k = jnp.arange(span) - WINDOW
    rel = offs_k[None, :] - offs_q[:, None]
    alibi = slopes * jnp.abs(rel).astype(jnp.float32)

    def block(args):
        qi, i = args
        start = i * ATTN_BLOCK
        ki = lax.dynamic_slice_in_dim(kp, start, span, axis=1)
        vi = lax.dynamic_slice_in_dim(vp, start, span, axis=1)
        s_pos = start + offs_k
        valid = (jnp.abs(rel) <= WINDOW) & ((s_pos >= 0) & (s_pos < T))[None, :]
        logits = jnp.einsum('bqkgd,bskd->bkgqs', qi, ki,
                            preferred_element_type=jnp.float32) * scale - alibi
        logits = jnp.where(valid, logits, -jnp.inf)
        sink_col = jnp.broadcast_to(sink5, logits.shape[:-1] + (1,))
        p = jax.nn.softmax(jnp.concatenate([logits, sink_col], axis=-1), axis=-1)[..., :-1]
        return jnp.einsum('bkgqs,bskd->bqkgd', p.astype(vi.dtype), vi)

    out = lax.map(block, (qb, jnp.arange(nb)))
    return jnp.moveaxis(out, 0, 1).reshape(B, T, N_HEADS * HEAD_DIM)


def gla_chunk_scan(q, k, v, g):
    B, T, H, dk = q.shape
    dv = v.shape[-1]
    n = T // HG_CHUNK

    def to_chunks(a):
        return jnp.moveaxis(a.reshape(B, n, HG_CHUNK, H, a.shape[-1]), 1, 0)

    causal = jnp.tril(jnp.ones((HG_CHUNK, HG_CHUNK), dtype=bool))[None, :, :, None, None]

    def step(S, xs):
        qc, kc, vc, gc = xs
        b = jnp.cumsum(gc, axis=1)
        diff = b[:, :, None] - b[:, None, :]
        decay = jnp.exp(jnp.where(causal, diff, -jnp.inf))
        A = jnp.einsum('bthd,bshd,btshd->bhts', qc, kc, decay)
        o_intra = jnp.einsum('bhts,bshv->bthv', A, vc)
        o_inter = jnp.einsum('bthd,bhdv->bthv', qc * jnp.exp(b), S)
        b_last = b[:, -1]
        k_dec = kc * jnp.exp(b_last[:, None] - b)
        S_new = jnp.exp(b_last)[..., None] * S + jnp.einsum('bshd,bshv->bhdv', k_dec, vc)
        return S_new, o_intra + o_inter

    S0 = jnp.zeros((B, H, dk, dv), jnp.float32)
    _, o = lax.scan(step, S0, (to_chunks(q), to_chunks(k), to_chunks(v), to_chunks(g)))
    return jnp.moveaxis(o, 0, 1).reshape(B, T, H, dv)


def hgrn2_gate(f_logit, lb_param, layer):
    lb = jnp.cumsum(jax.nn.softmax(lb_param.astype(jnp.float32), axis=0), axis=0)[layer]
    s = jax.nn.sigmoid(f_logit.astype(jnp.float32))
    log_f = jnp.log(lb + (1.0 - lb) * s)
    k = (1.0 - lb) * (1.0 - s)
    return log_f, k


def hgrn2_bidirectional(q, f_fwd, f_bwd, i_in, lb_fwd, lb_bwd, layer):
    B, T = q.shape[0], q.shape[1]
    heads = lambda a, d: a.astype(jnp.float32).reshape(B, T, HG_HEADS, d)
    qh = heads(q, HG_DK)
    vh = heads(i_in, HG_DV)
    gf, kf = hgrn2_gate(f_fwd, lb_fwd, layer)
    gb, kb = hgrn2_gate(f_bwd, lb_bwd, layer)
    gf, kf, gb, kb = heads(gf, HG_DK), heads(kf, HG_DK), heads(gb, HG_DK), heads(kb, HG_DK)
    o_f = gla_chunk_scan(qh, kf, vh, gf)
    flip = lambda a: jnp.flip(a, axis=1)
    o_b = flip(gla_chunk_scan(flip(qh), flip(kb), flip(vh), flip(gb)))
    return (o_f + o_b).reshape(B, T, HG_WIDTH)


def token_mixer(h, w_in, w_out, sink, attn_norm_g, lb_fwd, lb_bwd, hg_norm_g, layer):
    B, T, _ = h.shape
    q_a, k_a, v_a, q_h, f_f, f_b, i_h, g_h = split_in_proj(h @ w_in)
    o_attn = windowed_gqa_attention(q_a.reshape(B, T, N_HEADS, HEAD_DIM),
                                    k_a.reshape(B, T, N_KV_HEADS, HEAD_DIM),
                                    v_a.reshape(B, T, N_KV_HEADS, HEAD_DIM), sink)
    o_attn = group_rms_norm(o_attn, attn_norm_g, 1)
    o_hg = hgrn2_bidirectional(q_h, f_f, f_b, i_h, lb_fwd, lb_bwd, layer).astype(h.dtype)
    o_hg = group_rms_norm(o_hg, hg_norm_g, HG_HEADS) * jax.nn.silu(g_h)
    return jnp.concatenate([o_attn, o_hg], axis=-1) @ w_out


def trunk(x, ln_g, ln_b, ffn_w13, ffn_w2, w_in, attn_sink, attn_norm_g,
          hg_lb_fwd, hg_lb_bwd, hg_norm_g, w_out):
    for l in range(DEPTH):
        x = layer_norm(ALPHA * x + 0.5 * swiglu_ffn(x, ffn_w13[l, 0], ffn_w2[l, 0]),
                       ln_g[l, 0], ln_b[l, 0])
        mix = token_mixer(x, w_in[l], w_out[l], attn_sink[l], attn_norm_g[l],
                          hg_lb_fwd, hg_lb_bwd, hg_norm_g[l], l)
        x = layer_norm(ALPHA * x + mix, ln_g[l, 1], ln_b[l, 1])
        x = layer_norm(ALPHA * x + 0.5 * swiglu_ffn(x, ffn_w13[l, 1], ffn_w2[l, 1]),
                       ln_g[l, 2], ln_b[l, 2])
    return x


def setup_inputs(seed: int = 0) -> dict:
    key = jax.random.key(seed)
    ks = jax.random.split(key, 16)
    f32 = jnp.float32
    nrm = lambda k, shp, s: jax.random.normal(k, shp, f32) * s
    x_prompt = jax.random.normal(ks[0], (BATCH, SEQ, D_MODEL), f32)
    x_sample = jax.random.normal(ks[1], (DEC_BATCH, DEC_SEQ, D_MODEL), f32)
    ln_g = 1.0 + nrm(ks[2], (DEPTH, 3, D_MODEL), 0.02)
    ln_b = nrm(ks[3], (DEPTH, 3, D_MODEL), 0.02)
    ffn_w13 = nrm(ks[4], (DEPTH, 2, D_MODEL, 2 * D_FF), D_MODEL ** -0.5)
    ffn_w2 = nrm(ks[5], (DEPTH, 2, D_FF, D_MODEL), BETA_INIT * D_FF ** -0.5)
    col_scale = jnp.concatenate([
        jnp.ones((ATTN_WIDTH + KV_WIDTH,), f32),
        jnp.full((KV_WIDTH,), BETA_INIT, f32),
        jnp.ones((3 * HG_KDIM,), f32),
        jnp.full((HG_WIDTH,), BETA_INIT, f32),
        jnp.ones((HG_WIDTH,), f32)])
    w_in = nrm(ks[6], (DEPTH, D_MODEL, IN_COLS), D_MODEL ** -0.5) * col_scale
    attn_sink = nrm(ks[7], (DEPTH, N_HEADS), 0.5)
    attn_norm_g = 1.0 + nrm(ks[8], (DEPTH, ATTN_WIDTH), 0.02)
    hg_lb_fwd = nrm(ks[9], (DEPTH + 1, HG_KDIM), 0.5)
    hg_lb_bwd = nrm(ks[10], (DEPTH + 1, HG_KDIM), 0.5)
    hg_norm_g = 1.0 + nrm(ks[11], (DEPTH, HG_WIDTH), 0.02)
    w_out = nrm(ks[12], (DEPTH, MIX_WIDTH, D_MODEL), BETA_INIT * MIX_WIDTH ** -0.5)
    return {"x_prompt": x_prompt, "x_sample": x_sample, "ln_g": ln_g, "ln_b": ln_b,
            "ffn_w13": ffn_w13, "ffn_w2": ffn_w2, "w_in": w_in, "attn_sink": attn_sink,
            "attn_norm_g": attn_norm_g, "hg_lb_fwd": hg_lb_fwd, "hg_lb_bwd": hg_lb_bwd,
            "hg_norm_g": hg_norm_g, "w_out": w_out}


def reference(x_prompt, x_sample, ln_g, ln_b, ffn_w13, ffn_w2, w_in, attn_sink,
              attn_norm_g, hg_lb_fwd, hg_lb_bwd, hg_norm_g, w_out):
    y_prompt = trunk(x_prompt, ln_g, ln_b, ffn_w13, ffn_w2, w_in, attn_sink, attn_norm_g,
                     hg_lb_fwd, hg_lb_bwd, hg_norm_g, w_out)
    y_sample = trunk(x_sample, ln_g, ln_b, ffn_w13, ffn_w2, w_in, attn_sink, attn_norm_g,
                     hg_lb_fwd, hg_lb_bwd, hg_norm_g, w_out)
    return (y_prompt, y_sample)
```

```cpp
#include <hip/hip_runtime.h>
#include <cstdio>
#include <cstdint>
namespace pg8 {
#define PG8_LAS __attribute__((address_space(3)))
typedef unsigned short bf16_t;
typedef short bf16x8 __attribute__((ext_vector_type(8)));
typedef float f32x4 __attribute__((ext_vector_type(4)));
typedef unsigned u32x4 __attribute__((ext_vector_type(4)));
constexpr int BM = 256, BK = 64, HALF = 128, HTB = HALF * BK * 2  , STAGE_BYTES = 8 * HTB, NXCD = 8, WGM = 8;

__host__ __device__ __forceinline__ int lds_byte(int r, int c) { const int st = (r >> 4) * 2 + (c >> 5), rr = r & 15, cc = c & 31, ob = rr * 64 + cc * 2; return st * 1024 + (ob ^ (((ob >> 9) & 1) << 5)); }
__host__ __device__ __forceinline__ void stage_rc(int b, int& R, int& C) { const int st = b / 1024, sb = b % 1024, swz = sb ^ (((sb >> 9) & 1) << 5); R = (st >> 1) * 16 + swz / 64; C = (st & 1) * 32 + (swz % 64) / 2; }
__host__ __device__ __forceinline__ int perm32(int rho) { const int n = rho >> 4, i = rho & 15; return 8 * (i >> 2) + 4 * n + (i & 3); }

struct Unit { int pm, pn; };
struct Gemm { const bf16_t* A; const bf16_t* Bt; int M, N, K; };

struct StaticOrder {
    int nM, nN, nwg, G, c;
    __host__ __device__ void init(int M, int N, int G_, int c_) { nM = M / BM; nN = N / BM; nwg = nM * nN; G = G_; c = c_; }
    __host__ __device__ bool next(int i, Unit& u) const {
        const long L = (long)i * G + c; if (L >= nwg) return false;
        int wgid = (int)L; { const int q = nwg / NXCD, r = nwg % NXCD, xcd = wgid % NXCD, off = wgid / NXCD; wgid = (xcd < r ? xcd * (q + 1) : r * (q + 1) + (xcd - r) * q) + off; }
        const int nig = WGM * nN, gid = wgid / nig, fm = gid * WGM, gsz = (nM - fm) < WGM ? (nM - fm) : WGM;
        u.pm = fm + ((wgid % nig) % gsz); u.pn = (wgid % nig) / gsz; return true;
    }
    __device__ __forceinline__ void a_ready(const Unit&) const {}
    __device__ __forceinline__ void done(const Unit&) const {}
};

__device__ __forceinline__ unsigned cvt_pk_bf16(float lo, float hi) { unsigned r; asm volatile("v_cvt_pk_bf16_f32 %0, %1, %2" : "=v"(r) : "v"(lo), "v"(hi)); return r; }
typedef float f32x2 __attribute__((ext_vector_type(2)));
__device__ __forceinline__ f32x2 gelu_pk(f32x2 v) {
    const f32x2 av = __builtin_elementwise_abs(v), d = av * 0.2316418882f + 1.0f;
    f32x2 t; t.x = __builtin_amdgcn_rcpf(d.x); t.y = __builtin_amdgcn_rcpf(d.y);
    f32x2 q = t * 0.5307027145f + (-0.7265760135f); q = q * t + 0.7107068705f; q = q * t + (-0.142248368f); q = q * t + 0.127414796f; q = q * t;
    const f32x2 s = (v * v) * (-0.72134752044f);
    f32x2 e; e.x = __builtin_amdgcn_exp2f(s.x); e.y = __builtin_amdgcn_exp2f(s.y);
    const f32x2 m = v * (q * e), r = v - m;
    f32x2 o; o.x = v.x < 0.f ? m.x : r.x; o.y = v.y < 0.f ? m.y : r.y; return o;
}

template <int ACT  > struct EpiBf16 {
    static constexpr bool PERM = true, AFTER_DRAIN = false; static_assert(ACT == 0 || ACT == 1, "EpiBf16: ACT is 0 (none) or 1 (gelu_pk)");
    bf16_t* O; int ldc; const float* bias; int split_cols; size_t split_stride; float scale0;
    __device__ __forceinline__ void operator()(const f32x4 (&acc)[2][2][4][2], const Unit& u, int wr, int wc, int fr, int fq) const {
        const int row0 = u.pm * BM + wr * 64 + fr; int colt = u.pn * BM; bf16_t* base = O;
        float sc = 1.f; if (split_cols) { const int t = colt / split_cols; base += (size_t)t * split_stride; colt -= t * split_cols; if (t == 0) sc = scale0; }
        const int col0 = colt + wc * 32 + 8 * fq, bcol0 = u.pn * BM + wc * 32 + 8 * fq;
        f32x4 bv[2][2];
#pragma unroll
        for (int bj = 0; bj < 2; ++bj)
#pragma unroll
            for (int n = 0; n < 2; ++n) bv[bj][n] = bias ? *(const f32x4*)(bias + bcol0 + bj * HALF + 4 * n) : (f32x4){0.f, 0.f, 0.f, 0.f};
#pragma unroll
        for (int ai = 0; ai < 2; ++ai)
#pragma unroll
            for (int m = 0; m < 4; ++m) { bf16_t* rowp = base + (size_t)(row0 + ai * HALF + m * 16) * ldc + col0;
#pragma unroll
                for (int bj = 0; bj < 2; ++bj) { f32x4 v0 = acc[ai][bj][m][0] + bv[bj][0], v1 = acc[ai][bj][m][1] + bv[bj][1];
                    if (ACT == 1) { f32x2 a = gelu_pk((f32x2){v0[0], v0[1]}), b = gelu_pk((f32x2){v0[2], v0[3]}), c = gelu_pk((f32x2){v1[0], v1[1]}), d = gelu_pk((f32x2){v1[2], v1[3]});
                        v0 = (f32x4){a.x, a.y, b.x, b.y}; v1 = (f32x4){c.x, c.y, d.x, d.y}; }
                    v0 = v0 * sc; v1 = v1 * sc; u32x4 w; w.x = cvt_pk_bf16(v0[0], v0[1]); w.y = cvt_pk_bf16(v0[2], v0[3]); w.z = cvt_pk_bf16(v1[0], v1[1]); w.w = cvt_pk_bf16(v1[2], v1[3]);
                    *(u32x4*)(rowp + bj * HALF) = w; } }
    }
};

struct PanelStats {
    unsigned* xbuf;
    unsigned* cnt;
    unsigned* tmo;
    int ntn; float eps;
    unsigned code;
    __device__ __forceinline__ bool run(const f32x4 (&v)[2][2][4][2], const Unit& u, int wr, int wc, int fr, int fq, PG8_LAS unsigned char* lds, int wid, int lane) const {
        typedef float f32x2v __attribute__((ext_vector_type(2)));
        PG8_LAS f32x2v* P = (PG8_LAS f32x2v*)lds;
        PG8_LAS f32x2v* S = (PG8_LAS f32x2v*)(lds + 8192);
        PG8_LAS unsigned* flag = (PG8_LAS unsigned*)(lds + 8192 + 2048);
#pragma unroll
        for (int ai = 0; ai < 2; ++ai)
#pragma unroll
            for (int m = 0; m < 4; ++m) {
                float s = 0.f;
#pragma unroll
                for (int bj = 0; bj < 2; ++bj)
#pragma unroll
                    for (int n = 0; n < 2; ++n) { const f32x4 x = v[ai][bj][m][n]; s += (x[0] + x[1]) + (x[2] + x[3]); }
                s += __shfl_xor(s, 16); s += __shfl_xor(s, 32);
                const float mw = s * (1.0f / 64.0f); float q = 0.f;
#pragma unroll
                for (int bj = 0; bj < 2; ++bj)
#pragma unroll
                    for (int n = 0; n < 2; ++n) { const f32x4 d = v[ai][bj][m][n] - mw; q += (d[0] * d[0] + d[1] * d[1]) + (d[2] * d[2] + d[3] * d[3]); }
                q += __shfl_xor(q, 16); q += __shfl_xor(q, 32);
                if (fq == 0) P[(ai * HALF + wr * 64 + m * 16 + fr) * 4 + wc] = (f32x2v){mw, q};
            }
        asm volatile("s_waitcnt lgkmcnt(0)" ::: "memory"); __builtin_amdgcn_s_barrier(); asm volatile("" ::: "memory");
#if defined(BROKEN_EXCHANGE_NO_WAIT)
#warning BROKEN CONTROL BUILD: the row-statistics exchange does not wait; results are wrong by design
        if (blockIdx.x >= 64) { const long long t0_ = clock64(); while (clock64() - t0_ < 60000) __builtin_amdgcn_s_sleep(8); }
#endif
        const int row = wid * 32 + (lane & 31);
        if (lane < 32) {
            const f32x2v a = P[row * 4 + 0], b = P[row * 4 + 1], c = P[row * 4 + 2], d = P[row * 4 + 3];
            const float mt = (a.x + b.x + c.x + d.x) * 0.25f;
            const float da = a.x - mt, db = b.x - mt, dc = c.x - mt, dd = d.x - mt;
            const float m2 = (a.y + b.y) + (c.y + d.y) + 64.0f * ((da * da + db * db) + (dc * dc + dd * dd));
            unsigned long long* slot = (unsigned long long*)xbuf + ((size_t)(u.pm * BM + row) * 4 + u.pn);
            __hip_atomic_store(slot, ((unsigned long long)__float_as_uint(m2) << 32) | __float_as_uint(mt), __ATOMIC_RELAXED, __HIP_MEMORY_SCOPE_AGENT);
        }
        asm volatile("s_waitcnt vmcnt(0)" ::: "memory");
        if (lane == 0) __hip_atomic_fetch_add(cnt + 64 * u.pm, 1u, __ATOMIC_RELAXED, __HIP_MEMORY_SCOPE_AGENT);
        if (wid == 0) {
            bool dead = false; const unsigned long long t0 = __builtin_amdgcn_s_memrealtime(); const unsigned want = 8u * (unsigned)ntn;
            for (;;) {
#if defined(BROKEN_EXCHANGE_NO_WAIT)
                break;
#endif
                if ((unsigned)__builtin_amdgcn_readfirstlane(__hip_atomic_load(cnt + 64 * u.pm, __ATOMIC_RELAXED, __HIP_MEMORY_SCOPE_AGENT)) >= want) break;
                if (__builtin_amdgcn_s_memrealtime() - t0 > 2000000ull) {
                    if (lane == 0) { unsigned expect = 0u; __hip_atomic_compare_exchange_strong(tmo + 1, &expect, code | (unsigned)(u.pm & 0xff), __ATOMIC_RELAXED, __ATOMIC_RELAXED, __HIP_MEMORY_SCOPE_AGENT);
                                     __hip_atomic_store(tmo, 1u, __ATOMIC_RELAXED, __HIP_MEMORY_SCOPE_AGENT); }
                    dead = true; break; }
                __builtin_amdgcn_s_sleep(2);
            }
            __builtin_amdgcn_fence(__ATOMIC_ACQUIRE, "agent");
            if (lane == 0) flag[0] = dead ? 1u : 0u;
        }
        asm volatile("s_waitcnt vmcnt(0) lgkmcnt(0)" ::: "memory"); __builtin_amdgcn_s_barrier(); asm volatile("" ::: "memory");
        const bool bad = flag[0] != 0u;
        if (lane < 32) {
            const unsigned long long* slot = (const unsigned long long*)xbuf + (size_t)(u.pm * BM + row) * 4; float mt[4], m2[4]; float ms = 0.f;
#pragma unroll
            for (int t = 0; t < 4; ++t) { if (t < ntn) { const unsigned long long w = __hip_atomic_load(slot + t, __ATOMIC_RELAXED, __HIP_MEMORY_SCOPE_AGENT); mt[t] = __uint_as_float((unsigned)w); m2[t] = __uint_as_float((unsigned)(w >> 32)); } else { mt[t] = 0.f; m2[t] = 0.f; } ms += mt[t]; }
            const float mean = ms / (float)ntn; float q = 0.f;
#pragma unroll
            for (int t = 0; t < 4; ++t) if (t < ntn) { const float dm = mt[t] - mean; q += m2[t] + 256.0f * dm * dm; }
            S[row] = (f32x2v){mean, 1.0f / sqrtf(q / (256.0f * (float)ntn) + eps)};
        }
        asm volatile("s_waitcnt lgkmcnt(0)" ::: "memory"); __builtin_amdgcn_s_barrier(); asm volatile("" ::: "memory");
        return bad;
    }
};
struct EpiLnRes {
    static constexpr bool PERM = false, AFTER_DRAIN = true;
    const float* base; float* out; int ldc; const float* bias; PanelStats st; unsigned poison;
    __device__ __forceinline__ void fused(f32x4 (&acc)[2][2][4][2], const Unit& u, int wr, int wc, int fr, int fq, PG8_LAS unsigned char* lds, int wid, int lane) const {
        typedef float f32x2v __attribute__((ext_vector_type(2)));
        const PG8_LAS f32x2v* S = (const PG8_LAS f32x2v*)(lds + 8192);
        const int col0 = u.pn * BM + wc * 32 + 4 * fq;
#pragma unroll
        for (int bj = 0; bj < 2; ++bj)
#pragma unroll
            for (int n = 0; n < 2; ++n) { const f32x4 bv = bias ? *(const f32x4*)(bias + col0 + bj * HALF + n * 16) : (f32x4){0.f, 0.f, 0.f, 0.f};
#pragma unroll
                for (int ai = 0; ai < 2; ++ai)
#pragma unroll
                    for (int m = 0; m < 4; ++m) acc[ai][bj][m][n] += bv; }
        f32x4 pre[4][2][2];
#pragma unroll
        for (int m = 0; m < 4; ++m) { const size_t off = (size_t)(u.pm * BM + wr * 64 + m * 16 + fr) * ldc + col0;
#pragma unroll
            for (int bj = 0; bj < 2; ++bj)
#pragma unroll
                for (int n = 0; n < 2; ++n) pre[m][bj][n] = *(const f32x4*)(base + off + bj * HALF + n * 16); }
        const bool bad = st.run(acc, u, wr, wc, fr, fq, lds, wid, lane) || poison != 0u;
        const float qnan = __builtin_nanf("");
#pragma unroll
        for (int ai = 0; ai < 2; ++ai)
#pragma unroll
            for (int m = 0; m < 4; ++m) { const int r = ai * HALF + wr * 64 + m * 16 + fr; const f32x2v sr = S[r]; const size_t off = (size_t)(u.pm * BM + r) * ldc + col0;
#pragma unroll
                for (int bj = 0; bj < 2; ++bj)
#pragma unroll
                    for (int n = 0; n < 2; ++n) { const f32x4 bs = ai == 0 ? pre[m][bj][n] : *(const f32x4*)(base + off + bj * HALF + n * 16); f32x4 o = bs + (acc[ai][bj][m][n] - sr.x) * sr.y;
                        if (bad) o = (f32x4){qnan, qnan, qnan, qnan}; *(f32x4*)(out + off + bj * HALF + n * 16) = o; }
                if (m & 1) asm volatile("" ::: "memory"); }
    }
};
struct EpiLnResLn {
    static constexpr bool PERM = false, AFTER_DRAIN = true;
    const float* base; float* out; bf16_t* xn; int ldc; const float* bias; PanelStats st1, st2; unsigned poison;
    __device__ __forceinline__ void fused(f32x4 (&acc)[2][2][4][2], const Unit& u, int wr, int wc, int fr, int fq, PG8_LAS unsigned char* lds, int wid, int lane) const {
        typedef float f32x2v __attribute__((ext_vector_type(2))); typedef unsigned u32x2v __attribute__((ext_vector_type(2)));
        const PG8_LAS f32x2v* S = (const PG8_LAS f32x2v*)(lds + 8192);
        const int col0 = u.pn * BM + wc * 32 + 4 * fq;
#pragma unroll
        for (int bj = 0; bj < 2; ++bj)
#pragma unroll
            for (int n = 0; n < 2; ++n) { const f32x4 bv = bias ? *(const f32x4*)(bias + col0 + bj * HALF + n * 16) : (f32x4){0.f, 0.f, 0.f, 0.f};
#pragma unroll
                for (int ai = 0; ai < 2; ++ai)
#pragma unroll
                    for (int m = 0; m < 4; ++m) acc[ai][bj][m][n] += bv; }
        bool bad = st1.run(acc, u, wr, wc, fr, fq, lds, wid, lane) || poison != 0u;
        const float qnan = __builtin_nanf("");
#pragma unroll
        for (int ai = 0; ai < 2; ++ai)
#pragma unroll
            for (int m = 0; m < 4; ++m) { const int r = ai * HALF + wr * 64 + m * 16 + fr; const f32x2v sr = S[r]; const size_t off = (size_t)(u.pm * BM + r) * ldc + col0;
#pragma unroll
                for (int bj = 0; bj < 2; ++bj)
#pragma unroll
                    for (int n = 0; n < 2; ++n) { const f32x4 bs = *(const f32x4*)(base + off + bj * HALF + n * 16); acc[ai][bj][m][n] = bs + (acc[ai][bj][m][n] - sr.x) * sr.y; }
                asm volatile("" : "+v"(acc[ai][0][m][0]), "+v"(acc[ai][0][m][1]), "+v"(acc[ai][1][m][0]), "+v"(acc[ai][1][m][1]));
                if (m & 1) asm volatile("" ::: "memory"); }
        const bool bad1 = bad;
        bad = st2.run(acc, u, wr, wc, fr, fq, lds, wid, lane) || bad;
#pragma unroll
        for (int ai = 0; ai < 2; ++ai)
#pragma unroll
            for (int m = 0; m < 4; ++m) { const int r = ai * HALF + wr * 64 + m * 16 + fr; const f32x2v sr = S[r]; const size_t off = (size_t)(u.pm * BM + r) * ldc + col0;
#pragma unroll
                for (int bj = 0; bj < 2; ++bj)
#pragma unroll
                    for (int n = 0; n < 2; ++n) { const f32x4 x1 = acc[ai][bj][m][n]; *(f32x4*)(out + off + bj * HALF + n * 16) = bad1 ? (f32x4){qnan, qnan, qnan, qnan} : x1;
                        const f32x4 o = (x1 - sr.x) * sr.y; u32x2v w; w.x = cvt_pk_bf16(o[0], o[1]); w.y = cvt_pk_bf16(o[2], o[3]);
                        if (bad) { w.x = 0x7fc07fc0u; w.y = 0x7fc07fc0u; } *(u32x2v*)(xn + off + bj * HALF + n * 16) = w; }
                asm volatile("" ::: "memory"); }
    }
};

template <class Epi, class Sched, bool ALIGN_EPI = false, bool SP2 = false>
__device__ __forceinline__ void gemm_phase(PG8_LAS unsigned char* lds, const Gemm g, const Sched& S, const Epi& E) {
    const int tid = threadIdx.x, wid = __builtin_amdgcn_readfirstlane(tid >> 6), lane = tid & 63, wr = wid >> 2, wc = wid & 3, fr = lane & 15, fq = lane >> 4;
    const int K = g.K, nt = K / BK;
    unsigned voffA[2], voffB[2];
#pragma unroll
    for (int i = 0; i < 2; ++i) { int R, C; stage_rc(tid * 16 + i * 8192, R, C); const int Rb = Epi::PERM ? ((R & ~31) + perm32(R & 31)) : R;
        voffA[i] = (unsigned)(R * K + C) * 2u; voffB[i] = (unsigned)(Rb * K + C) * 2u; }
    const size_t kstep = (size_t)(BK * 2);
    const size_t hstep = (size_t)HALF * K * 2;
    const size_t tstep = 2 * hstep;
    const unsigned ldsw = (unsigned)wid * 1024u;
    const int aoff = lds_byte(wr * 64 + fr, fq * 8), boff = lds_byte(wc * 32 + fr, fq * 8);
#define PG8_SA(b, h) (((b) * 2 + (h)) * HTB)
#define PG8_SB(b, h) ((4 + (b) * 2 + (h)) * HTB)
#define PG8_STAGE(bufoff, gbase, voff) do { _Pragma("unroll") for (int _i = 0; _i < 2; ++_i) \
        __builtin_amdgcn_global_load_lds((const unsigned*)((const char*)(gbase) + (voff)[_i]), (PG8_LAS unsigned*)(lds + (bufoff) + ldsw + _i * 8192), 16, 0, 0); } while (0)
#define PG8_LDA(dst, b, h) do { _Pragma("unroll") for (int m = 0; m < 4; ++m) _Pragma("unroll") for (int k = 0; k < 2; ++k) dst[m][k] = *(const PG8_LAS bf16x8*)(lds + PG8_SA(b, h) + aoff + m * 2048 + k * 1024); } while (0)
#define PG8_LDB(dst, b, h) do { _Pragma("unroll") for (int n = 0; n < 2; ++n) _Pragma("unroll") for (int k = 0; k < 2; ++k) dst[n][k] = *(const PG8_LAS bf16x8*)(lds + PG8_SB(b, h) + boff + n * 2048 + k * 1024); } while (0)
#define PG8_MMA(ai, bj, At, Bt) do { __builtin_amdgcn_s_setprio(1); _Pragma("unroll") for (int m = 0; m < 4; ++m) _Pragma("unroll") for (int n = 0; n < 2; ++n) _Pragma("unroll") for (int k = 0; k < 2; ++k) \
        acc[ai][bj][m][n] = __builtin_amdgcn_mfma_f32_16x16x32_bf16(Bt[n][k], At[m][k], acc[ai][bj][m][n], 0, 0, 0); __builtin_amdgcn_s_setprio(0); } while (0)
#define PG8_WAIT_V(n) asm volatile("s_waitcnt vmcnt(" #n ")" ::: "memory")
#define PG8_WAIT_L(n) asm volatile("s_waitcnt lgkmcnt(" #n ")" ::: "memory")
#define PG8_BAR __builtin_amdgcn_s_barrier()
#define PG8_SCHED __builtin_amdgcn_sched_barrier(0)
    Unit cur, nxt; int ui = 0;
    if (!S.next(0, cur)) return;
    f32x4 acc[2][2][4][2];
#pragma unroll
    for (int a = 0; a < 2; ++a)
#pragma unroll
        for (int b = 0; b < 2; ++b)
#pragma unroll
            for (int m = 0; m < 4; ++m)
#pragma unroll
                for (int n = 0; n < 2; ++n) acc[a][b][m][n] = (f32x4){0.f, 0.f, 0.f, 0.f};
    bf16x8 At[4][2], B0[2][2], B1[2][2];
    const char* cA = (const char*)g.A + (size_t)cur.pm * tstep; const char* cB = (const char*)g.Bt + (size_t)cur.pn * tstep;
    S.a_ready(cur);
    if constexpr (SP2) {
        PG8_STAGE(PG8_SB(0, 0), cB, voffB); PG8_STAGE(PG8_SB(0, 1), cB + hstep, voffB); PG8_STAGE(PG8_SA(0, 0), cA, voffA); PG8_STAGE(PG8_SA(0, 1), cA + hstep, voffA);
        if (wr == 1) PG8_BAR;
        PG8_WAIT_V(2); PG8_BAR;
        PG8_STAGE(PG8_SB(1, 0), cB + kstep, voffB); PG8_STAGE(PG8_SA(1, 0), cA + kstep, voffA); PG8_STAGE(PG8_SB(1, 1), cB + hstep + kstep, voffB);
        PG8_WAIT_V(6); PG8_BAR;
    } else {
        PG8_STAGE(PG8_SB(0, 0), cB, voffB); PG8_STAGE(PG8_SA(0, 0), cA, voffA); PG8_STAGE(PG8_SB(0, 1), cB + hstep, voffB); PG8_STAGE(PG8_SA(0, 1), cA + hstep, voffA);
        if (wr == 1) PG8_BAR;
        PG8_WAIT_V(4); PG8_BAR;
        PG8_STAGE(PG8_SB(1, 0), cB + kstep, voffB); PG8_STAGE(PG8_SA(1, 0), cA + kstep, voffA); PG8_STAGE(PG8_SB(1, 1), cB + hstep + kstep, voffB);
        PG8_WAIT_V(6); PG8_BAR;
    }
    for (;;) {
        const bool has_next = S.next(ui + 1, nxt);
        const char* nA = has_next ? (const char*)g.A + (size_t)nxt.pm * tstep : cA; const char* nB = has_next ? (const char*)g.Bt + (size_t)nxt.pn * tstep : cB;
        for (int t = 0; t < nt; t += 2) {
            const bool last = (t == nt - 2);
            const char* a1 = cA + (size_t)(t + 1) * kstep;
            const char* a2 = last ? nA : cA + (size_t)(t + 2) * kstep; const char* b2 = last ? nB : cB + (size_t)(t + 2) * kstep;
            const char* a3 = a2 + kstep; const char* b3 = b2 + kstep;
            if (last && has_next) S.a_ready(nxt);
            if constexpr (SP2) {
            PG8_LDB(B0, 0, 0); PG8_LDB(B1, 0, 1); PG8_SCHED; PG8_LDA(At, 0, 0); PG8_STAGE(PG8_SA(1, 1), a1 + hstep, voffA);
            PG8_WAIT_V(8); PG8_WAIT_L(0); PG8_BAR; PG8_MMA(0, 0, At, B0); PG8_MMA(0, 1, At, B1); PG8_BAR; PG8_SCHED;
            PG8_LDA(At, 0, 1); PG8_STAGE(PG8_SB(0, 0), b2, voffB); PG8_STAGE(PG8_SB(0, 1), b2 + hstep, voffB); PG8_STAGE(PG8_SA(0, 0), a2, voffA);
            PG8_WAIT_V(8); PG8_WAIT_L(0); PG8_BAR; PG8_MMA(1, 0, At, B0); PG8_MMA(1, 1, At, B1); PG8_BAR; PG8_SCHED;
            PG8_LDB(B0, 1, 0); PG8_LDB(B1, 1, 1); PG8_SCHED; PG8_LDA(At, 1, 0); PG8_STAGE(PG8_SA(0, 1), a2 + hstep, voffA);
            PG8_WAIT_V(8); PG8_WAIT_L(0); PG8_BAR; PG8_MMA(0, 0, At, B0); PG8_MMA(0, 1, At, B1); PG8_BAR; PG8_SCHED;
            PG8_LDA(At, 1, 1); PG8_STAGE(PG8_SB(1, 0), b3, voffB); PG8_STAGE(PG8_SB(1, 1), b3 + hstep, voffB); PG8_STAGE(PG8_SA(1, 0), a3, voffA);
            PG8_WAIT_V(8); PG8_WAIT_L(0); PG8_BAR; PG8_MMA(1, 0, At, B0); PG8_MMA(1, 1, At, B1); PG8_BAR; PG8_SCHED;
            } else {
            PG8_LDB(B0, 0, 0); PG8_SCHED; PG8_LDA(At, 0, 0); PG8_STAGE(PG8_SA(1, 1), a1 + hstep, voffA);
            PG8_WAIT_L(8); PG8_BAR; PG8_WAIT_L(0); PG8_MMA(0, 0, At, B0); PG8_BAR; PG8_SCHED;
            PG8_LDB(B1, 0, 1); PG8_STAGE(PG8_SB(0, 0), b2, voffB);
            PG8_BAR; PG8_WAIT_L(0); PG8_MMA(0, 1, At, B1); PG8_BAR;
            PG8_LDA(At, 0, 1); PG8_STAGE(PG8_SA(0, 0), a2, voffA);
            PG8_BAR; PG8_WAIT_L(0); PG8_MMA(1, 0, At, B0); PG8_BAR; PG8_SCHED;
            PG8_STAGE(PG8_SB(0, 1), b2 + hstep, voffB);
            PG8_WAIT_V(6); PG8_BAR; PG8_MMA(1, 1, At, B1); PG8_BAR;
            PG8_LDB(B0, 1, 0); PG8_SCHED; PG8_LDA(At, 1, 0); PG8_STAGE(PG8_SA(0, 1), a2 + hstep, voffA);
            PG8_WAIT_L(8); PG8_BAR; PG8_WAIT_L(0); PG8_MMA(0, 0, At, B0); PG8_BAR; PG8_SCHED;
            PG8_LDB(B1, 1, 1); PG8_STAGE(PG8_SB(1, 0), b3, voffB);
            PG8_BAR; PG8_WAIT_L(0); PG8_MMA(0, 1, At, B1); PG8_BAR;
            PG8_LDA(At, 1, 1); PG8_STAGE(PG8_SA(1, 0), a3, voffA);
            PG8_BAR; PG8_WAIT_L(0); PG8_MMA(1, 0, At, B0); PG8_BAR; PG8_SCHED;
            PG8_STAGE(PG8_SB(1, 1), b3 + hstep, voffB);
            PG8_WAIT_V(6); PG8_BAR; PG8_MMA(1, 1, At, B1); PG8_BAR;
            }
        }
        if constexpr (ALIGN_EPI) { if (wr == 0) PG8_BAR; }
        if constexpr (!Epi::AFTER_DRAIN) { E(acc, cur, wr, wc, fr, fq); S.done(cur); }
        if (!has_next) break;
#pragma unroll
        for (int a = 0; a < 2; ++a)
#pragma unroll
            for (int b = 0; b < 2; ++b)
#pragma unroll
                for (int m = 0; m < 4; ++m)
#pragma unroll
                    for (int n = 0; n < 2; ++n) acc[a][b][m][n] = (f32x4){0.f, 0.f, 0.f, 0.f};
        cur = nxt; cA = nA; cB = nB; ++ui;
        if constexpr (ALIGN_EPI) { if (wr == 1) PG8_BAR; }
    }
    PG8_WAIT_V(0);
    if constexpr (!ALIGN_EPI) { if (wr == 0) PG8_BAR; }
    PG8_BAR;
    if constexpr (Epi::AFTER_DRAIN) { E.fused(acc, cur, wr, wc, fr, fq, lds, wid, lane); S.done(cur); }
#undef PG8_SA
#undef PG8_SB
#undef PG8_STAGE
#undef PG8_LDA
#undef PG8_LDB
#undef PG8_MMA
#undef PG8_WAIT_V
#undef PG8_WAIT_L
#undef PG8_BAR
#undef PG8_SCHED
}
}

#ifndef PG8_SP2
#define PG8_SP2 true
#endif
#ifndef PG8_ALIGN
#define PG8_ALIGN true
#endif

#include <hip/hip_cooperative_groups.h>
namespace cg = cooperative_groups;
#define LAS __attribute__((address_space(3)))
typedef unsigned short bf16;
typedef unsigned v4u __attribute__((ext_vector_type(4)));
typedef unsigned v2u __attribute__((ext_vector_type(2)));
typedef float f32x4 __attribute__((ext_vector_type(4)));
typedef short bf16x8 __attribute__((ext_vector_type(8)));

constexpr int D = 1024, M_P = 16384, M_S = 65536, M = M_P + M_S, T_P = 2048, T_S = 4096;
constexpr int FF = 2816, NIN = 3328, NT32 = M / 32, NT16 = M / 16;
constexpr float ALPHA = 1.189207115002721f;
constexpr float EPS = 1e-5f;
constexpr float LOG2E = 1.4426950408889634f;
constexpr float QSCALE = 0.125f * LOG2E;
constexpr int NWAVES = 8;
constexpr int LDS_BYTES = 147456;
constexpr int MISC_OFF = 131072;

constexpr size_t MiB = 1u << 20;
constexpr size_t WS_W13A = 0, WS_W13B = 11 * MiB, WS_W2A = 22 * MiB, WS_W2B = 28 * MiB, WS_WIN = 34 * MiB, WS_WOUT = 41 * MiB;
constexpr size_t WS_XB = 44 * MiB, WS_BIG = 204 * MiB;
constexpr size_t WS_H = WS_BIG;
constexpr size_t WS_QA = WS_BIG, WS_KA = WS_BIG + 80 * MiB, WS_VT = WS_BIG + 100 * MiB, WS_QH = WS_BIG + 120 * MiB, WS_GF = WS_BIG + 200 * MiB,
                 WS_GB = WS_BIG + 280 * MiB, WS_IH = WS_BIG + 360 * MiB, WS_GH = WS_BIG + 440 * MiB, WS_OF = WS_BIG + 520 * MiB, WS_OB = WS_BIG + 600 * MiB;
constexpr size_t WS_CTL = WS_BIG + 680 * MiB, WS_END = WS_CTL + 4096;

__device__ __forceinline__ unsigned f2bf(float f) { unsigned u = __builtin_bit_cast(unsigned, f); return (u + 0x7fffu + ((u >> 16) & 1u)) >> 16; }
__device__ __forceinline__ unsigned pk2(float lo, float hi) { return f2bf(lo) | (f2bf(hi) << 16); }
__device__ __forceinline__ float bf2f(unsigned short h) { return __builtin_bit_cast(float, (unsigned)h << 16); }
__device__ __forceinline__ float bflo(unsigned w) { return __builtin_bit_cast(float, w << 16); }
__device__ __forceinline__ float bfhi(unsigned w) { return __builtin_bit_cast(float, w & 0xffff0000u); }
__device__ __forceinline__ float wave_sum(float v) {
#pragma unroll
    for (int o = 1; o < 64; o <<= 1) v += __shfl_xor(v, o);
    return v;
}
__device__ __forceinline__ float silu_f(float x) { return x * __builtin_amdgcn_rcpf(1.0f + __builtin_amdgcn_exp2f(-x * LOG2E)); }

__device__ __forceinline__ size_t qk_off(int m, int head, int d0, int hh) { return ((((size_t)head * NT32 + (m >> 5)) * 4 + d0) * 32 + (m & 31)) * 16 + hh * 8; }
__device__ __forceinline__ int vt_slot(int o) { return ((o >> 2) & 1) * 8 + (o >> 3) * 4 + (o & 3); }
__device__ __forceinline__ size_t vt_off(int m, int kvh, int d) { return (((size_t)kvh * NT16 + (m >> 4)) * 64 + d) * 16 + vt_slot(m & 15); }

namespace pg8 {
struct EpiRes {
    static constexpr bool PERM = false, AFTER_DRAIN = false;
    const float* res0; const float* res1; int split; float* out; float alpha, s;
    __device__ __forceinline__ void operator()(const f32x4 (&acc)[2][2][4][2], const Unit& u, int wr, int wc, int fr, int fq) const {
        const int row0 = u.pm * BM + wr * 64 + fr, col0 = u.pn * BM + wc * 32 + 4 * fq;
        const float* rb = (u.pm * BM < split) ? res0 : res1 - (size_t)split * 1024;
#pragma unroll
        for (int ai = 0; ai < 2; ++ai)
#pragma unroll
            for (int m = 0; m < 4; ++m) { const size_t off = (size_t)(row0 + ai * HALF + m * 16) * 1024 + col0;
#pragma unroll
                for (int bj = 0; bj < 2; ++bj)
#pragma unroll
                    for (int n = 0; n < 2; ++n) { const f32x4 rv = *(const f32x4*)(rb + off + bj * HALF + n * 16);
                        *(f32x4*)(out + off + bj * HALF + n * 16) = rv * alpha + acc[ai][bj][m][n] * s; }
                if (m & 1) asm volatile("" ::: "memory"); }
    }
};
struct EpiSwiGLU {
    static constexpr bool PERM = true, AFTER_DRAIN = false;
    bf16_t* H;
    __device__ __forceinline__ void operator()(const f32x4 (&acc)[2][2][4][2], const Unit& u, int wr, int wc, int fr, int fq) const {
        const int row0 = u.pm * BM + wr * 64 + fr, col0 = u.pn * HALF + wc * 32 + 8 * fq;
#pragma unroll
        for (int ai = 0; ai < 2; ++ai)
#pragma unroll
            for (int m = 0; m < 4; ++m) {
                float h[8];
#pragma unroll
                for (int n = 0; n < 2; ++n)
#pragma unroll
                    for (int i = 0; i < 4; ++i) { const float g = acc[ai][0][m][n][i], up = acc[ai][1][m][n][i]; h[n * 4 + i] = silu_f(g) * up; }
                u32x4 w; w.x = cvt_pk_bf16(h[0], h[1]); w.y = cvt_pk_bf16(h[2], h[3]); w.z = cvt_pk_bf16(h[4], h[5]); w.w = cvt_pk_bf16(h[6], h[7]);
                *(u32x4*)(H + (size_t)(row0 + ai * HALF + m * 16) * FF + col0) = w; }
    }
};
struct EpiIn {
    static constexpr bool PERM = true, AFTER_DRAIN = false;
    unsigned char* ws; const float* lbf; const float* lbb;
    __device__ __forceinline__ void operator()(const f32x4 (&acc)[2][2][4][2], const Unit& u, int wr, int wc, int fr, int fq) const {
        bf16_t* QA = (bf16_t*)(ws + WS_QA); bf16_t* KA = (bf16_t*)(ws + WS_KA); bf16_t* VT = (bf16_t*)(ws + WS_VT);
        const int pn = u.pn; const int row0 = u.pm * BM + wr * 64 + fr; const int c8 = wc * 32 + 8 * fq;
        if (pn <= 2) {
            const int hd = wc >> 1, dim = (wc & 1) * 32 + 8 * fq, d0 = dim >> 4, hh = (dim >> 3) & 1;
#pragma unroll
            for (int ai = 0; ai < 2; ++ai)
#pragma unroll
                for (int m = 0; m < 4; ++m) { const int row = row0 + ai * HALF + m * 16;
#pragma unroll
                    for (int bj = 0; bj < 2; ++bj) { const f32x4 v0 = acc[ai][bj][m][0], v1 = acc[ai][bj][m][1];
                        if (pn < 2) { const int head = pn * 4 + bj * 2 + hd; u32x4 w; w.x = cvt_pk_bf16(v0[0] * QSCALE, v0[1] * QSCALE); w.y = cvt_pk_bf16(v0[2] * QSCALE, v0[3] * QSCALE);
                            w.z = cvt_pk_bf16(v1[0] * QSCALE, v1[1] * QSCALE); w.w = cvt_pk_bf16(v1[2] * QSCALE, v1[3] * QSCALE); *(u32x4*)(QA + qk_off(row, head, d0, hh)) = w; }
                        else if (bj == 0) { u32x4 w; w.x = cvt_pk_bf16(v0[0], v0[1]); w.y = cvt_pk_bf16(v0[2], v0[3]); w.z = cvt_pk_bf16(v1[0], v1[1]); w.w = cvt_pk_bf16(v1[2], v1[3]); *(u32x4*)(KA + qk_off(row, hd, d0, hh)) = w; }
                        else { bf16_t* vp = VT + vt_off(row, hd, dim);
#pragma unroll
                            for (int i = 0; i < 4; ++i) { vp[i * 16] = (bf16_t)f2bf(v0[i]); vp[(4 + i) * 16] = (bf16_t)f2bf(v1[i]); } } } }
        } else if (pn <= 4 || pn >= 9) {
            bf16_t* dst = (bf16_t*)(ws + (pn <= 4 ? WS_QH : (pn <= 10 ? WS_IH : WS_GH))); const int cb = ((pn <= 4 ? pn - 3 : (pn <= 10 ? pn - 9 : pn - 11)) * 256) + c8;
#pragma unroll
            for (int ai = 0; ai < 2; ++ai)
#pragma unroll
                for (int m = 0; m < 4; ++m) { const int row = row0 + ai * HALF + m * 16;
#pragma unroll
                    for (int bj = 0; bj < 2; ++bj) { const f32x4 v0 = acc[ai][bj][m][0], v1 = acc[ai][bj][m][1];
                        u32x4 w; w.x = cvt_pk_bf16(v0[0], v0[1]); w.y = cvt_pk_bf16(v0[2], v0[3]); w.z = cvt_pk_bf16(v1[0], v1[1]); w.w = cvt_pk_bf16(v1[2], v1[3]);
                        *(u32x4*)(dst + (size_t)row * 512 + cb + bj * HALF) = w; } }
        } else {
            bf16_t* dst = (bf16_t*)(ws + (pn <= 6 ? WS_GF : WS_GB)); const float* lp = pn <= 6 ? lbf : lbb; const int cb = ((pn - 5) & 1) * 256 + c8;
#pragma unroll
            for (int bj = 0; bj < 2; ++bj) { float lb[8];
#pragma unroll
                for (int i = 0; i < 8; ++i) { const float p0 = lp[cb + bj * HALF + i], p1 = lp[512 + cb + bj * HALF + i]; lb[i] = __builtin_amdgcn_rcpf(1.0f + __expf(p1 - p0)); }
#pragma unroll
                for (int ai = 0; ai < 2; ++ai)
#pragma unroll
                    for (int m = 0; m < 4; ++m) { const int row = row0 + ai * HALF + m * 16; float g[8];
#pragma unroll
                        for (int n = 0; n < 2; ++n)
#pragma unroll
                            for (int i = 0; i < 4; ++i) { const float x = acc[ai][bj][m][n][i]; const float sg = __builtin_amdgcn_rcpf(1.0f + __builtin_amdgcn_exp2f(-x * 1.4426950408889634f));
                                const float l = lb[n * 4 + i]; g[n * 4 + i] = __logf(l + (1.0f - l) * sg); }
                        u32x4 w; w.x = cvt_pk_bf16(g[0], g[1]); w.y = cvt_pk_bf16(g[2], g[3]); w.z = cvt_pk_bf16(g[4], g[5]); w.w = cvt_pk_bf16(g[6], g[7]);
                        *(u32x4*)(dst + (size_t)row * 512 + cb + bj * HALF) = w; } }
        }
    }
};
}

struct Args { const float* in[13]; float* out; unsigned char* ws; };

struct Frame {
    LAS unsigned char* lds; int tid, lane, wave, G, bid;
};

__device__ __forceinline__ void p0_transpose_item(const float* W, int K, int N, bf16* WT, int mode, LAS float* scr, int item, int lane) {
    const int nblk = N / 32, kb = item / nblk, nb = item % nblk, k0 = 64 * kb, n0 = 32 * nb;
    int rbase = n0;
    if (mode == 1) { const int h0 = n0 < FF ? n0 : n0 - FF; rbase = (h0 >> 7) * 256 + (n0 < FF ? 0 : 128) + (h0 & 127); }
#pragma unroll 8
    for (int i = 0; i < 32; ++i) { const int kk = 2 * i + (lane >> 5); scr[kk * 33 + (lane & 31)] = W[(size_t)(k0 + kk) * N + n0 + (lane & 31)]; }
    asm volatile("s_waitcnt lgkmcnt(0)" ::: "memory");
    const int c = lane & 7;
#pragma unroll
    for (int j = 0; j < 4; ++j) { const int n = (lane >> 3) + 8 * j; const LAS float* s = scr + (8 * c) * 33 + n;
        v4u o; o.x = pk2(s[0 * 33], s[1 * 33]); o.y = pk2(s[2 * 33], s[3 * 33]); o.z = pk2(s[4 * 33], s[5 * 33]); o.w = pk2(s[6 * 33], s[7 * 33]);
        *(v4u*)(WT + (size_t)(rbase + n) * K + k0 + 8 * c) = o; }
    asm volatile("s_waitcnt lgkmcnt(0)" ::: "memory");
}
__device__ __forceinline__ void p0_prologue(const Frame& F, const Args& a) {
    LAS float* scr = (LAS float*)(F.lds + F.wave * 16384);
    const int gw = F.bid * NWAVES + F.wave, NGW = F.G * NWAVES;
    unsigned char* ws = a.ws;
    constexpr int I13 = (D / 64) * (2 * FF / 32), I2 = (FF / 64) * (D / 32), IIN = (D / 64) * (NIN / 32), IOUT = (D / 64) * (D / 32);
    constexpr int NITEMS = 2 * I13 + 2 * I2 + IIN + IOUT;
    for (int it = gw; it < NITEMS; it += NGW) {
        int r = it;
        if (r < I13) { p0_transpose_item(a.in[4], D, 2 * FF, (bf16*)(ws + WS_W13A), 1, scr, r, F.lane); continue; } r -= I13;
        if (r < I13) { p0_transpose_item(a.in[4] + (size_t)D * 2 * FF, D, 2 * FF, (bf16*)(ws + WS_W13B), 1, scr, r, F.lane); continue; } r -= I13;
        if (r < I2) { p0_transpose_item(a.in[5], FF, D, (bf16*)(ws + WS_W2A), 0, scr, r, F.lane); continue; } r -= I2;
        if (r < I2) { p0_transpose_item(a.in[5] + (size_t)FF * D, FF, D, (bf16*)(ws + WS_W2B), 0, scr, r, F.lane); continue; } r -= I2;
        if (r < IIN) { p0_transpose_item(a.in[6], D, NIN, (bf16*)(ws + WS_WIN), 0, scr, r, F.lane); continue; } r -= IIN;
        p0_transpose_item(a.in[12], D, D, (bf16*)(ws + WS_WOUT), 0, scr, r, F.lane);
    }
    bf16* XB = (bf16*)(ws + WS_XB);
    for (int m = gw; m < M; m += NGW) {
        const float* xrow = m < M_P ? a.in[0] + (size_t)m * D : a.in[1] + (size_t)(m - M_P) * D;
        const f32x4* xr = (const f32x4*)xrow + F.lane; v2u* o8 = (v2u*)(XB + (size_t)m * D) + F.lane;
#pragma unroll
        for (int j = 0; j < 4; ++j) { const f32x4 v = xr[64 * j]; v2u w; w.x = pk2(v.x, v.y); w.y = pk2(v.z, v.w); o8[64 * j] = w; }
    }
}
__device__ __forceinline__ void ln_phase(const Frame& F, float* buf, bf16* xb, const float* g, const float* b) {
    const int gw = F.bid * NWAVES + F.wave, NGW = F.G * NWAVES;
    f32x4 gv[4], bv[4];
#pragma unroll
    for (int j = 0; j < 4; ++j) { gv[j] = ((const f32x4*)g)[F.lane + 64 * j]; bv[j] = ((const f32x4*)b)[F.lane + 64 * j]; }
    for (int m = gw; m < M; m += NGW) {
        f32x4* xr = (f32x4*)(buf + (size_t)m * D) + F.lane;
        f32x4 v[4]; float s = 0.f;
#pragma unroll
        for (int j = 0; j < 4; ++j) { v[j] = xr[64 * j]; s += (v[j].x + v[j].y) + (v[j].z + v[j].w); }
        const float mean = wave_sum(s) * (1.f / D); float s2 = 0.f;
#pragma unroll
        for (int j = 0; j < 4; ++j) { v[j] = v[j] - mean; s2 += (v[j].x * v[j].x + v[j].y * v[j].y) + (v[j].z * v[j].z + v[j].w * v[j].w); }
        const float rstd = 1.f / sqrtf(wave_sum(s2) * (1.f / D) + EPS);
#pragma unroll
        for (int j = 0; j < 4; ++j) { const f32x4 y = v[j] * rstd * gv[j] + bv[j]; xr[64 * j] = y;
            if (xb) { v2u w; w.x = pk2(y.x, y.y); w.y = pk2(y.z, y.w); ((v2u*)(xb + (size_t)m * D) + F.lane)[64 * j] = w; } }
    }
}
__device__ __forceinline__ void hgrn_item_naive(const Frame& F, const Args& a, int it) {
    unsigned char* ws = a.ws;
    int s0, T, head, dir;
    if (it < 128) { s0 = M_P + (it >> 3) * T_S; T = T_S; } else { s0 = ((it - 128) >> 3) * T_P; T = T_P; }
    head = (it >> 1) & 3; dir = it & 1;
    const bf16* QH = (const bf16*)(ws + WS_QH); const bf16* G = (const bf16*)(ws + (dir ? WS_GB : WS_GF)); const bf16* IH = (const bf16*)(ws + WS_IH);
    bf16* O = (bf16*)(ws + (dir ? WS_OB : WS_OF));
    LAS float* qs = (LAS float*)F.lds; LAS float* fs = qs + 1024; LAS float* ks = fs + 1024; LAS float* vs = ks + 1024; LAS float* red = vs + 1024;
    const int v = F.tid & 127, dq = F.tid >> 7;
    float S[32];
#pragma unroll
    for (int i = 0; i < 32; ++i) S[i] = 0.f;
    for (int b0 = 0; b0 < T; b0 += 8) {
        __syncthreads();
#pragma unroll
        for (int e = F.tid; e < 1024; e += 512) { const int tok = e >> 7, d = e & 127; const int j = b0 + tok; const int t = dir ? T - 1 - j : j; const size_t idx = (size_t)(s0 + t) * 512 + head * 128 + d;
            qs[e] = bf2f(QH[idx]); const float f = __expf(bf2f(G[idx])); fs[e] = f; ks[e] = 1.0f - f; vs[e] = bf2f(IH[idx]); }
        __syncthreads();
#pragma unroll 1
        for (int tok = 0; tok < 8; ++tok) { const float iv = vs[tok * 128 + v]; float o = 0.f;
#pragma unroll
            for (int dd = 0; dd < 32; ++dd) { const int d = dq * 32 + dd; S[dd] = fs[tok * 128 + d] * S[dd] + ks[tok * 128 + d] * iv; o += qs[tok * 128 + d] * S[dd]; }
            red[(dq * 8 + tok) * 128 + v] = o; }
        __syncthreads();
#pragma unroll
        for (int e = F.tid; e < 1024; e += 512) { const int tok = e >> 7, vv = e & 127; const int j = b0 + tok; const int t = dir ? T - 1 - j : j;
            const float sm = (red[(0 * 8 + tok) * 128 + vv] + red[(1 * 8 + tok) * 128 + vv]) + (red[(2 * 8 + tok) * 128 + vv] + red[(3 * 8 + tok) * 128 + vv]);
            O[(size_t)(s0 + t) * 512 + head * 128 + vv] = (bf16)f2bf(sm); }
    }
    __syncthreads();
}
__device__ __forceinline__ void attn_item_naive(const Frame& F, const Args& a, int ib) {
    unsigned char* ws = a.ws;
    const bf16* QA = (const bf16*)(ws + WS_QA); const bf16* KA = (const bf16*)(ws + WS_KA); const bf16* VT = (const bf16*)(ws + WS_VT); bf16* MIX = (bf16*)(ws + WS_XB);
    const int tok = F.tid & 63, head = F.tid >> 6, kvh = head >> 2, m = ib * 64 + tok;
    int s0, T; if (m < M_P) { T = T_P; s0 = m & ~(T_P - 1); } else { T = T_S; s0 = M_P + ((m - M_P) & ~(T_S - 1)); }
    const int t = m - s0;
    float q[64], o[64];
#pragma unroll
    for (int c = 0; c < 8; ++c) { const v4u w = *(const v4u*)(QA + qk_off(m, head, c >> 1, c & 1));
        q[c * 8 + 0] = bflo(w.x); q[c * 8 + 1] = bfhi(w.x); q[c * 8 + 2] = bflo(w.y); q[c * 8 + 3] = bfhi(w.y); q[c * 8 + 4] = bflo(w.z); q[c * 8 + 5] = bfhi(w.z); q[c * 8 + 6] = bflo(w.w); q[c * 8 + 7] = bfhi(w.w); }
#pragma unroll
    for (int d = 0; d < 64; ++d) o[d] = 0.f;
    float mx = a.in[7][head] * LOG2E, l = 1.0f;
    const float slope2 = __builtin_amdgcn_exp2f(-(float)(head + 1)) * LOG2E;
    const int lo = t - 128 < 0 ? 0 : t - 128, hi = t + 128 > T - 1 ? T - 1 : t + 128;
    for (int s = lo; s <= hi; ++s) {
        const int ms = s0 + s; float dot = 0.f;
#pragma unroll
        for (int c = 0; c < 8; ++c) { const v4u w = *(const v4u*)(KA + qk_off(ms, kvh, c >> 1, c & 1));
            dot += q[c * 8 + 0] * bflo(w.x) + q[c * 8 + 1] * bfhi(w.x) + q[c * 8 + 2] * bflo(w.y) + q[c * 8 + 3] * bfhi(w.y) + q[c * 8 + 4] * bflo(w.z) + q[c * 8 + 5] * bfhi(w.z) + q[c * 8 + 6] * bflo(w.w) + q[c * 8 + 7] * bfhi(w.w); }
        const int rel = s - t; const float lg = dot - slope2 * (float)(rel < 0 ? -rel : rel);
        const float mn = fmaxf(mx, lg), corr = __builtin_amdgcn_exp2f(mx - mn), p = __builtin_amdgcn_exp2f(lg - mn);
        l = l * corr + p; mx = mn;
        const bf16* vp = VT + vt_off(ms, kvh, 0);
#pragma unroll
        for (int d = 0; d < 64; ++d) o[d] = o[d] * corr + p * bf2f(vp[d * 16]);
    }
    const float inv = 1.0f / l; float ss = 0.f;
#pragma unroll
    for (int d = 0; d < 64; ++d) { o[d] *= inv; ss += o[d] * o[d]; }
    LAS float* red = (LAS float*)F.lds;
    red[head * 64 + tok] = ss;
    __syncthreads();
    float tot = 0.f;
#pragma unroll
    for (int h = 0; h < 8; ++h) tot += red[h * 64 + tok];
    const float rstd = 1.0f / sqrtf(tot * (1.0f / 512.0f) + EPS);
    const float* ng = a.in[8] + head * 64;
#pragma unroll
    for (int c = 0; c < 8; ++c) { v4u w; w.x = pk2(o[c * 8 + 0] * rstd * ng[c * 8 + 0], o[c * 8 + 1] * rstd * ng[c * 8 + 1]); w.y = pk2(o[c * 8 + 2] * rstd * ng[c * 8 + 2], o[c * 8 + 3] * rstd * ng[c * 8 + 3]);
        w.z = pk2(o[c * 8 + 4] * rstd * ng[c * 8 + 4], o[c * 8 + 5] * rstd * ng[c * 8 + 5]); w.w = pk2(o[c * 8 + 6] * rstd * ng[c * 8 + 6], o[c * 8 + 7] * rstd * ng[c * 8 + 7]);
        *(v4u*)(MIX + (size_t)m * D + head * 64 + c * 8) = w; }
    __syncthreads();
}
__device__ __forceinline__ void hg_finalize(const Frame& F, const Args& a) {
    unsigned char* ws = a.ws;
    const bf16* OF = (const bf16*)(ws + WS_OF); const bf16* OB = (const bf16*)(ws + WS_OB); const bf16* GH = (const bf16*)(ws + WS_GH); bf16* MIX = (bf16*)(ws + WS_XB);
    const int gw = F.bid * NWAVES + F.wave, NGW = F.G * NWAVES;
    float ng[8];
#pragma unroll
    for (int i = 0; i < 8; ++i) ng[i] = a.in[11][F.lane * 8 + i];
    for (int m = gw; m < M; m += NGW) {
        const size_t idx = (size_t)m * 512 + F.lane * 8;
        const v4u wf = *(const v4u*)(OF + idx), wb = *(const v4u*)(OB + idx), wg = *(const v4u*)(GH + idx);
        float o[8], gt[8];
        o[0] = bflo(wf.x) + bflo(wb.x); o[1] = bfhi(wf.x) + bfhi(wb.x); o[2] = bflo(wf.y) + bflo(wb.y); o[3] = bfhi(wf.y) + bfhi(wb.y);
        o[4] = bflo(wf.z) + bflo(wb.z); o[5] = bfhi(wf.z) + bfhi(wb.z); o[6] = bflo(wf.w) + bflo(wb.w); o[7] = bfhi(wf.w) + bfhi(wb.w);
        gt[0] = bflo(wg.x); gt[1] = bfhi(wg.x); gt[2] = bflo(wg.y); gt[3] = bfhi(wg.y); gt[4] = bflo(wg.z); gt[5] = bfhi(wg.z); gt[6] = bflo(wg.w); gt[7] = bfhi(wg.w);
        float ss = 0.f;
#pragma unroll
        for (int i = 0; i < 8; ++i) ss += o[i] * o[i];
        ss += __shfl_xor(ss, 1); ss += __shfl_xor(ss, 2); ss += __shfl_xor(ss, 4); ss += __shfl_xor(ss, 8);
        const float rstd = 1.0f / sqrtf(ss * (1.0f / 128.0f) + EPS);
        float y[8];
#pragma unroll
        for (int i = 0; i < 8; ++i) y[i] = o[i] * rstd * ng[i] * silu_f(gt[i]);
        v4u w; w.x = pk2(y[0], y[1]); w.y = pk2(y[2], y[3]); w.z = pk2(y[4], y[5]); w.w = pk2(y[6], y[7]);
        *(v4u*)(MIX + (size_t)m * D + 512 + F.lane * 8) = w;
    }
}

__global__ void __launch_bounds__(NWAVES * 64, 2) hymba_fwd(Args args) {
    extern __shared__ __attribute__((aligned(16))) unsigned char lds[];
    cg::grid_group grid = cg::this_grid();
    Frame F; F.lds = (LAS unsigned char*)lds; F.tid = threadIdx.x; F.lane = F.tid & 63; F.wave = __builtin_amdgcn_readfirstlane(F.tid >> 6); F.G = gridDim.x; F.bid = blockIdx.x;
    unsigned char* ws = args.ws;
    bf16* XB = (bf16*)(ws + WS_XB); bf16* HB = (bf16*)(ws + WS_H);
    const float* ln_g = args.in[2]; const float* ln_b = args.in[3];
    volatile LAS int* misc = (volatile LAS int*)(F.lds + MISC_OFF);

    p0_prologue(F, args);
    grid.sync();
#ifndef NO_P1
    { pg8::Gemm g{XB, (const bf16*)(ws + WS_W13A), M, 2 * FF, D}; pg8::StaticOrder S; S.init(M, 2 * FF, F.G, F.bid); pg8::EpiSwiGLU E{HB};
      pg8::gemm_phase<pg8::EpiSwiGLU, pg8::StaticOrder, PG8_ALIGN, PG8_SP2>(F.lds, g, S, E); }
#endif
    grid.sync();
#ifndef NO_P2
    { pg8::Gemm g{HB, (const bf16*)(ws + WS_W2A), M, D, FF}; pg8::StaticOrder S; S.init(M, D, F.G, F.bid); pg8::EpiRes E{args.in[0], args.in[1], M_P, args.out, ALPHA, 0.5f};
      pg8::gemm_phase<pg8::EpiRes, pg8::StaticOrder, PG8_ALIGN, PG8_SP2>(F.lds, g, S, E); }
#endif
    grid.sync();
#ifndef NO_P3
    ln_phase(F, args.out, XB, ln_g, ln_b);
#endif
    grid.sync();
#ifndef NO_P4
    { pg8::Gemm g{XB, (const bf16*)(ws + WS_WIN), M, NIN, D}; pg8::StaticOrder S; S.init(M, NIN, F.G, F.bid);
      pg8::EpiIn E{ws, args.in[9], args.in[10]};
      pg8::gemm_phase<pg8::EpiIn, pg8::StaticOrder, PG8_ALIGN, PG8_SP2>(F.lds, g, S, E); }
#endif
    grid.sync();
#ifndef NO_P5
#ifndef NO_P5H
    if (F.bid < 192) hgrn_item_naive(F, args, F.bid);
#endif
    { unsigned* ctr = (unsigned*)(ws + WS_CTL);
      for (;;) { if (F.tid == 0) misc[0] = (int)atomicAdd(ctr, 1u); __syncthreads(); const int ib = misc[0]; __syncthreads(); if (ib >= M / 64) break; attn_item_naive(F, args, ib); } }
#endif
    grid.sync();
#ifndef NO_P6
    hg_finalize(F, args);
#endif
    grid.sync();
#ifndef NO_P7
    { pg8::Gemm g{XB, (const bf16*)(ws + WS_WOUT), M, D, D}; pg8::StaticOrder S; S.init(M, D, F.G, F.bid); pg8::EpiRes E{args.out, args.out, 0, args.out, ALPHA, 1.0f};
      pg8::gemm_phase<pg8::EpiRes, pg8::StaticOrder, PG8_ALIGN, PG8_SP2>(F.lds, g, S, E); }
#endif
    grid.sync();
#ifndef NO_P8
    ln_phase(F, args.out, XB, ln_g + D, ln_b + D);
#endif
    grid.sync();
#ifndef NO_P9
    { pg8::Gemm g{XB, (const bf16*)(ws + WS_W13B), M, 2 * FF, D}; pg8::StaticOrder S; S.init(M, 2 * FF, F.G, F.bid); pg8::EpiSwiGLU E{HB};
      pg8::gemm_phase<pg8::EpiSwiGLU, pg8::StaticOrder, PG8_ALIGN, PG8_SP2>(F.lds, g, S, E); }
#endif
    grid.sync();
#ifndef NO_P10
    { pg8::Gemm g{HB, (const bf16*)(ws + WS_W2B), M, D, FF}; pg8::StaticOrder S; S.init(M, D, F.G, F.bid); pg8::EpiRes E{args.out, args.out, 0, args.out, ALPHA, 0.5f};
      pg8::gemm_phase<pg8::EpiRes, pg8::StaticOrder, PG8_ALIGN, PG8_SP2>(F.lds, g, S, E); }
#endif
    grid.sync();
#ifndef NO_P11
    ln_phase(F, args.out, nullptr, ln_g + 2 * D, ln_b + 2 * D);
#endif
}

extern "C" void kernel_launch(void* const* d_in, const int* in_sizes, int n_in, void* d_out, int out_size, void* d_ws, size_t ws_size, hipStream_t stream) {
    static int grid = 0;
    if (grid == 0) {
        if (n_in != 13 || out_size != M * D || ws_size < WS_END) { fprintf(stderr, "kernel_launch: unexpected shapes n_in %d out %d ws %zu\n", n_in, out_size, ws_size); grid = -1; return; }
        int dev = 0, cus = 0, per_cu = 0;
        hipGetDevice(&dev); hipDeviceGetAttribute(&cus, hipDeviceAttributeMultiprocessorCount, dev);
        hipFuncSetAttribute((const void*)hymba_fwd, hipFuncAttributeMaxDynamicSharedMemorySize, LDS_BYTES);
        hipOccupancyMaxActiveBlocksPerMultiprocessor(&per_cu, (const void*)hymba_fwd, NWAVES * 64, LDS_BYTES);
        if (per_cu < 1) { fprintf(stderr, "kernel_launch: occupancy query %d\n", per_cu); per_cu = 1; }
        (void)hipGetLastError();
        grid = cus;
    }
    if (grid < 0) return;
    hipMemsetAsync((char*)d_ws + WS_CTL, 0, 4096, stream);
    Args a{};
    for (int i = 0; i < 13; ++i) a.in[i] = (const float*)d_in[i];
    a.out = (float*)d_out; a.ws = (unsigned char*)d_ws;
    void* kargs[] = {&a};
    hipError_t e = hipLaunchCooperativeKernel((const void*)hymba_fwd, dim3(grid), dim3(NWAVES * 64), kargs, LDS_BYTES, stream);
    if (e != hipSuccess) fprintf(stderr, "cooperative launch failed: %s (grid %d)\n", hipGetErrorString(e), grid);
}
```

```cpp
#include <hip/hip_runtime.h>
#include <cstdio>
#include <cstdint>
namespace pg8 {
#define PG8_LAS __attribute__((address_space(3)))
typedef unsigned short bf16_t;
typedef short bf16x8 __attribute__((ext_vector_type(8)));
typedef float f32x4 __attribute__((ext_vector_type(4)));
typedef unsigned u32x4 __attribute__((ext_vector_type(4)));
constexpr int BM = 256, BK = 64, HALF = 128, HTB = HALF * BK * 2  , STAGE_BYTES = 8 * HTB, NXCD = 8, WGM = 8;

__host__ __device__ __forceinline__ int lds_byte(int r, int c) { const int st = (r >> 4) * 2 + (c >> 5), rr = r & 15, cc = c & 31, ob = rr * 64 + cc * 2; return st * 1024 + (ob ^ (((ob >> 9) & 1) << 5)); }
__host__ __device__ __forceinline__ void stage_rc(int b, int& R, int& C) { const int st = b / 1024, sb = b % 1024, swz = sb ^ (((sb >> 9) & 1) << 5); R = (st >> 1) * 16 + swz / 64; C = (st & 1) * 32 + (swz % 64) / 2; }
__host__ __device__ __forceinline__ int perm32(int rho) { const int n = rho >> 4, i = rho & 15; return 8 * (i >> 2) + 4 * n + (i & 3); }

struct Unit { int pm, pn; };
struct Gemm { const bf16_t* A; const bf16_t* Bt; int M, N, K; };

struct StaticOrder {
    int nM, nN, nwg, G, c;
    __host__ __device__ void init(int M, int N, int G_, int c_) { nM = M / BM; nN = N / BM; nwg = nM * nN; G = G_; c = c_; }
    __host__ __device__ bool next(int i, Unit& u) const {
        const long L = (long)i * G + c; if (L >= nwg) return false;
        int wgid = (int)L; { const int q = nwg / NXCD, r = nwg % NXCD, xcd = wgid % NXCD, off = wgid / NXCD; wgid = (xcd < r ? xcd * (q + 1) : r * (q + 1) + (xcd - r) * q) + off; }
        const int nig = WGM * nN, gid = wgid / nig, fm = gid * WGM, gsz = (nM - fm) < WGM ? (nM - fm) : WGM;
        u.pm = fm + ((wgid % nig) % gsz); u.pn = (wgid % nig) / gsz; return true;
    }
    __device__ __forceinline__ void a_ready(const Unit&) const {}
    __device__ __forceinline__ void done(const Unit&) const {}
};

__device__ __forceinline__ unsigned cvt_pk_bf16(float lo, float hi) { unsigned r; asm volatile("v_cvt_pk_bf16_f32 %0, %1, %2" : "=v"(r) : "v"(lo), "v"(hi)); return r; }
typedef float f32x2 __attribute__((ext_vector_type(2)));
__device__ __forceinline__ f32x2 gelu_pk(f32x2 v) {
    const f32x2 av = __builtin_elementwise_abs(v), d = av * 0.2316418882f + 1.0f;
    f32x2 t; t.x = __builtin_amdgcn_rcpf(d.x); t.y = __builtin_amdgcn_rcpf(d.y);
    f32x2 q = t * 0.5307027145f + (-0.7265760135f); q = q * t + 0.7107068705f; q = q * t + (-0.142248368f); q = q * t + 0.127414796f; q = q * t;
    const f32x2 s = (v * v) * (-0.72134752044f);
    f32x2 e; e.x = __builtin_amdgcn_exp2f(s.x); e.y = __builtin_amdgcn_exp2f(s.y);
    const f32x2 m = v * (q * e), r = v - m;
    f32x2 o; o.x = v.x < 0.f ? m.x : r.x; o.y = v.y < 0.f ? m.y : r.y; return o;
}

template <int ACT  > struct EpiBf16 {
    static constexpr bool PERM = true, AFTER_DRAIN = false, HAS_TAB = false; static_assert(ACT == 0 || ACT == 1, "EpiBf16: ACT is 0 (none) or 1 (gelu_pk)");
    bf16_t* O; int ldc; const float* bias; int split_cols; size_t split_stride; float scale0;
    __device__ __forceinline__ void operator()(const f32x4 (&acc)[2][2][4][2], const Unit& u, int wr, int wc, int fr, int fq) const {
        const int row0 = u.pm * BM + wr * 64 + fr; int colt = u.pn * BM; bf16_t* base = O;
        float sc = 1.f; if (split_cols) { const int t = colt / split_cols; base += (size_t)t * split_stride; colt -= t * split_cols; if (t == 0) sc = scale0; }
        const int col0 = colt + wc * 32 + 8 * fq, bcol0 = u.pn * BM + wc * 32 + 8 * fq;
        f32x4 bv[2][2];
#pragma unroll
        for (int bj = 0; bj < 2; ++bj)
#pragma unroll
            for (int n = 0; n < 2; ++n) bv[bj][n] = bias ? *(const f32x4*)(bias + bcol0 + bj * HALF + 4 * n) : (f32x4){0.f, 0.f, 0.f, 0.f};
#pragma unroll
        for (int ai = 0; ai < 2; ++ai)
#pragma unroll
            for (int m = 0; m < 4; ++m) { bf16_t* rowp = base + (size_t)(row0 + ai * HALF + m * 16) * ldc + col0;
#pragma unroll
                for (int bj = 0; bj < 2; ++bj) { f32x4 v0 = acc[ai][bj][m][0] + bv[bj][0], v1 = acc[ai][bj][m][1] + bv[bj][1];
                    if (ACT == 1) { f32x2 a = gelu_pk((f32x2){v0[0], v0[1]}), b = gelu_pk((f32x2){v0[2], v0[3]}), c = gelu_pk((f32x2){v1[0], v1[1]}), d = gelu_pk((f32x2){v1[2], v1[3]});
                        v0 = (f32x4){a.x, a.y, b.x, b.y}; v1 = (f32x4){c.x, c.y, d.x, d.y}; }
                    v0 = v0 * sc; v1 = v1 * sc; u32x4 w; w.x = cvt_pk_bf16(v0[0], v0[1]); w.y = cvt_pk_bf16(v0[2], v0[3]); w.z = cvt_pk_bf16(v1[0], v1[1]); w.w = cvt_pk_bf16(v1[2], v1[3]);
                    *(u32x4*)(rowp + bj * HALF) = w; } }
    }
};

struct PanelStats {
    unsigned* xbuf;
    unsigned* cnt;
    unsigned* tmo;
    int ntn; float eps;
    unsigned code;
    __device__ __forceinline__ bool run(const f32x4 (&v)[2][2][4][2], const Unit& u, int wr, int wc, int fr, int fq, PG8_LAS unsigned char* lds, int wid, int lane) const {
        typedef float f32x2v __attribute__((ext_vector_type(2)));
        PG8_LAS f32x2v* P = (PG8_LAS f32x2v*)lds;
        PG8_LAS f32x2v* S = (PG8_LAS f32x2v*)(lds + 8192);
        PG8_LAS unsigned* flag = (PG8_LAS unsigned*)(lds + 8192 + 2048);
#pragma unroll
        for (int ai = 0; ai < 2; ++ai)
#pragma unroll
            for (int m = 0; m < 4; ++m) {
                float s = 0.f;
#pragma unroll
                for (int bj = 0; bj < 2; ++bj)
#pragma unroll
                    for (int n = 0; n < 2; ++n) { const f32x4 x = v[ai][bj][m][n]; s += (x[0] + x[1]) + (x[2] + x[3]); }
                s += __shfl_xor(s, 16); s += __shfl_xor(s, 32);
                const float mw = s * (1.0f / 64.0f); float q = 0.f;
#pragma unroll
                for (int bj = 0; bj < 2; ++bj)
#pragma unroll
                    for (int n = 0; n < 2; ++n) { const f32x4 d = v[ai][bj][m][n] - mw; q += (d[0] * d[0] + d[1] * d[1]) + (d[2] * d[2] + d[3] * d[3]); }
                q += __shfl_xor(q, 16); q += __shfl_xor(q, 32);
                if (fq == 0) P[(ai * HALF + wr * 64 + m * 16 + fr) * 4 + wc] = (f32x2v){mw, q};
            }
        asm volatile("s_waitcnt lgkmcnt(0)" ::: "memory"); __builtin_amdgcn_s_barrier(); asm volatile("" ::: "memory");
#if defined(BROKEN_EXCHANGE_NO_WAIT)
#warning BROKEN CONTROL BUILD: the row-statistics exchange does not wait; results are wrong by design
        if (blockIdx.x >= 64) { const long long t0_ = clock64(); while (clock64() - t0_ < 60000) __builtin_amdgcn_s_sleep(8); }
#endif
        const int row = wid * 32 + (lane & 31);
        if (lane < 32) {
            const f32x2v a = P[row * 4 + 0], b = P[row * 4 + 1], c = P[row * 4 + 2], d = P[row * 4 + 3];
            const float mt = (a.x + b.x + c.x + d.x) * 0.25f;
            const float da = a.x - mt, db = b.x - mt, dc = c.x - mt, dd = d.x - mt;
            const float m2 = (a.y + b.y) + (c.y + d.y) + 64.0f * ((da * da + db * db) + (dc * dc + dd * dd));
            unsigned long long* slot = (unsigned long long*)xbuf + ((size_t)(u.pm * BM + row) * 4 + u.pn);
            __hip_atomic_store(slot, ((unsigned long long)__float_as_uint(m2) << 32) | __float_as_uint(mt), __ATOMIC_RELAXED, __HIP_MEMORY_SCOPE_AGENT);
        }
        asm volatile("s_waitcnt vmcnt(0)" ::: "memory");
        if (lane == 0) __hip_atomic_fetch_add(cnt + 64 * u.pm, 1u, __ATOMIC_RELAXED, __HIP_MEMORY_SCOPE_AGENT);
        if (wid == 0) {
            bool dead = false; const unsigned long long t0 = __builtin_amdgcn_s_memrealtime(); const unsigned want = 8u * (unsigned)ntn;
            for (;;) {
#if defined(BROKEN_EXCHANGE_NO_WAIT)
                break;
#endif
                if ((unsigned)__builtin_amdgcn_readfirstlane(__hip_atomic_load(cnt + 64 * u.pm, __ATOMIC_RELAXED, __HIP_MEMORY_SCOPE_AGENT)) >= want) break;
                if (__builtin_amdgcn_s_memrealtime() - t0 > 2000000ull) {
                    if (lane == 0) { unsigned expect = 0u; __hip_atomic_compare_exchange_strong(tmo + 1, &expect, code | (unsigned)(u.pm & 0xff), __ATOMIC_RELAXED, __ATOMIC_RELAXED, __HIP_MEMORY_SCOPE_AGENT);
                                     __hip_atomic_store(tmo, 1u, __ATOMIC_RELAXED, __HIP_MEMORY_SCOPE_AGENT); }
                    dead = true; break; }
                __builtin_amdgcn_s_sleep(2);
            }
            __builtin_amdgcn_fence(__ATOMIC_ACQUIRE, "agent");
            if (lane == 0) flag[0] = dead ? 1u : 0u;
        }
        asm volatile("s_waitcnt vmcnt(0) lgkmcnt(0)" ::: "memory"); __builtin_amdgcn_s_barrier(); asm volatile("" ::: "memory");
        const bool bad = flag[0] != 0u;
        if (lane < 32) {
            const unsigned long long* slot = (const unsigned long long*)xbuf + (size_t)(u.pm * BM + row) * 4; float mt[4], m2[4]; float ms = 0.f;
#pragma unroll
            for (int t = 0; t < 4; ++t) { if (t < ntn) { const unsigned long long w = __hip_atomic_load(slot + t, __ATOMIC_RELAXED, __HIP_MEMORY_SCOPE_AGENT); mt[t] = __uint_as_float((unsigned)w); m2[t] = __uint_as_float((unsigned)(w >> 32)); } else { mt[t] = 0.f; m2[t] = 0.f; } ms += mt[t]; }
            const float mean = ms / (float)ntn; float q = 0.f;
#pragma unroll
            for (int t = 0; t < 4; ++t) if (t < ntn) { const float dm = mt[t] - mean; q += m2[t] + 256.0f * dm * dm; }
            S[row] = (f32x2v){mean, 1.0f / sqrtf(q / (256.0f * (float)ntn) + eps)};
        }
        asm volatile("s_waitcnt lgkmcnt(0)" ::: "memory"); __builtin_amdgcn_s_barrier(); asm volatile("" ::: "memory");
        return bad;
    }
};
struct EpiLnRes {
    static constexpr bool PERM = false, AFTER_DRAIN = true, HAS_TAB = false;
    const float* base; float* out; int ldc; const float* bias; PanelStats st; unsigned poison;
    __device__ __forceinline__ void fused(f32x4 (&acc)[2][2][4][2], const Unit& u, int wr, int wc, int fr, int fq, PG8_LAS unsigned char* lds, int wid, int lane) const {
        typedef float f32x2v __attribute__((ext_vector_type(2)));
        const PG8_LAS f32x2v* S = (const PG8_LAS f32x2v*)(lds + 8192);
        const int col0 = u.pn * BM + wc * 32 + 4 * fq;
#pragma unroll
        for (int bj = 0; bj < 2; ++bj)
#pragma unroll
            for (int n = 0; n < 2; ++n) { const f32x4 bv = bias ? *(const f32x4*)(bias + col0 + bj * HALF + n * 16) : (f32x4){0.f, 0.f, 0.f, 0.f};
#pragma unroll
                for (int ai = 0; ai < 2; ++ai)
#pragma unroll
                    for (int m = 0; m < 4; ++m) acc[ai][bj][m][n] += bv; }
        f32x4 pre[4][2][2];
#pragma unroll
        for (int m = 0; m < 4; ++m) { const size_t off = (size_t)(u.pm * BM + wr * 64 + m * 16 + fr) * ldc + col0;
#pragma unroll
            for (int bj = 0; bj < 2; ++bj)
#pragma unroll
                for (int n = 0; n < 2; ++n) pre[m][bj][n] = *(const f32x4*)(base + off + bj * HALF + n * 16); }
        const bool bad = st.run(acc, u, wr, wc, fr, fq, lds, wid, lane) || poison != 0u;
        const float qnan = __builtin_nanf("");
#pragma unroll
        for (int ai = 0; ai < 2; ++ai)
#pragma unroll
            for (int m = 0; m < 4; ++m) { const int r = ai * HALF + wr * 64 + m * 16 + fr; const f32x2v sr = S[r]; const size_t off = (size_t)(u.pm * BM + r) * ldc + col0;
#pragma unroll
                for (int bj = 0; bj < 2; ++bj)
#pragma unroll
                    for (int n = 0; n < 2; ++n) { const f32x4 bs = ai == 0 ? pre[m][bj][n] : *(const f32x4*)(base + off + bj * HALF + n * 16); f32x4 o = bs + (acc[ai][bj][m][n] - sr.x) * sr.y;
                        if (bad) o = (f32x4){qnan, qnan, qnan, qnan}; *(f32x4*)(out + off + bj * HALF + n * 16) = o; }
                if (m & 1) asm volatile("" ::: "memory"); }
    }
};
struct EpiLnResLn {
    static constexpr bool PERM = false, AFTER_DRAIN = true, HAS_TAB = false;
    const float* base; float* out; bf16_t* xn; int ldc; const float* bias; PanelStats st1, st2; unsigned poison;
    __device__ __forceinline__ void fused(f32x4 (&acc)[2][2][4][2], const Unit& u, int wr, int wc, int fr, int fq, PG8_LAS unsigned char* lds, int wid, int lane) const {
        typedef float f32x2v __attribute__((ext_vector_type(2))); typedef unsigned u32x2v __attribute__((ext_vector_type(2)));
        const PG8_LAS f32x2v* S = (const PG8_LAS f32x2v*)(lds + 8192);
        const int col0 = u.pn * BM + wc * 32 + 4 * fq;
#pragma unroll
        for (int bj = 0; bj < 2; ++bj)
#pragma unroll
            for (int n = 0; n < 2; ++n) { const f32x4 bv = bias ? *(const f32x4*)(bias + col0 + bj * HALF + n * 16) : (f32x4){0.f, 0.f, 0.f, 0.f};
#pragma unroll
                for (int ai = 0; ai < 2; ++ai)
#pragma unroll
                    for (int m = 0; m < 4; ++m) acc[ai][bj][m][n] += bv; }
        bool bad = st1.run(acc, u, wr, wc, fr, fq, lds, wid, lane) || poison != 0u;
        const float qnan = __builtin_nanf("");
#pragma unroll
        for (int ai = 0; ai < 2; ++ai)
#pragma unroll
            for (int m = 0; m < 4; ++m) { const int r = ai * HALF + wr * 64 + m * 16 + fr; const f32x2v sr = S[r]; const size_t off = (size_t)(u.pm * BM + r) * ldc + col0;
#pragma unroll
                for (int bj = 0; bj < 2; ++bj)
#pragma unroll
                    for (int n = 0; n < 2; ++n) { const f32x4 bs = *(const f32x4*)(base + off + bj * HALF + n * 16); acc[ai][bj][m][n] = bs + (acc[ai][bj][m][n] - sr.x) * sr.y; }
                asm volatile("" : "+v"(acc[ai][0][m][0]), "+v"(acc[ai][0][m][1]), "+v"(acc[ai][1][m][0]), "+v"(acc[ai][1][m][1]));
                if (m & 1) asm volatile("" ::: "memory"); }
        const bool bad1 = bad;
        bad = st2.run(acc, u, wr, wc, fr, fq, lds, wid, lane) || bad;
#pragma unroll
        for (int ai = 0; ai < 2; ++ai)
#pragma unroll
            for (int m = 0; m < 4; ++m) { const int r = ai * HALF + wr * 64 + m * 16 + fr; const f32x2v sr = S[r]; const size_t off = (size_t)(u.pm * BM + r) * ldc + col0;
#pragma unroll
                for (int bj = 0; bj < 2; ++bj)
#pragma unroll
                    for (int n = 0; n < 2; ++n) { const f32x4 x1 = acc[ai][bj][m][n]; *(f32x4*)(out + off + bj * HALF + n * 16) = bad1 ? (f32x4){qnan, qnan, qnan, qnan} : x1;
                        const f32x4 o = (x1 - sr.x) * sr.y; u32x2v w; w.x = cvt_pk_bf16(o[0], o[1]); w.y = cvt_pk_bf16(o[2], o[3]);
                        if (bad) { w.x = 0x7fc07fc0u; w.y = 0x7fc07fc0u; } *(u32x2v*)(xn + off + bj * HALF + n * 16) = w; }
                asm volatile("" ::: "memory"); }
    }
};

template <class Epi, class Sched, bool ALIGN_EPI = false, bool SP2 = false>
__device__ __forceinline__ void gemm_phase(PG8_LAS unsigned char* lds, const Gemm g, const Sched& S, const Epi& E) {
    int tid_ = threadIdx.x; asm volatile("" : "+v"(tid_));
    const int tid = tid_, wid = __builtin_amdgcn_readfirstlane(tid >> 6), lane = tid & 63, wr = wid >> 2, wc = wid & 3, fr = lane & 15, fq = lane >> 4;
    const int K = g.K, nt = K / BK;
    unsigned voffA[2], voffB[2];
#pragma unroll
    for (int i = 0; i < 2; ++i) { int R, C; stage_rc(tid * 16 + i * 8192, R, C); const int Rb = Epi::PERM ? ((R & ~31) + perm32(R & 31)) : R;
        voffA[i] = (unsigned)(R * K + C) * 2u; voffB[i] = (unsigned)(Rb * K + C) * 2u; }
    const size_t kstep = (size_t)(BK * 2);
    const size_t hstep = (size_t)HALF * K * 2;
    const size_t tstep = 2 * hstep;
    const unsigned ldsw = (unsigned)wid * 1024u;
    const int aoff = lds_byte(wr * 64 + fr, fq * 8), boff = lds_byte(wc * 32 + fr, fq * 8);
#define PG8_SA(b, h) (((b) * 2 + (h)) * HTB)
#define PG8_SB(b, h) ((4 + (b) * 2 + (h)) * HTB)
#define PG8_STAGE(bufoff, gbase, voff) do { _Pragma("unroll") for (int _i = 0; _i < 2; ++_i) \
        __builtin_amdgcn_global_load_lds((const unsigned*)((const char*)(gbase) + (voff)[_i]), (PG8_LAS unsigned*)(lds + (bufoff) + ldsw + _i * 8192), 16, 0, 0); } while (0)
#define PG8_LDA(dst, b, h) do { _Pragma("unroll") for (int m = 0; m < 4; ++m) _Pragma("unroll") for (int k = 0; k < 2; ++k) dst[m][k] = *(const PG8_LAS bf16x8*)(lds + PG8_SA(b, h) + aoff + m * 2048 + k * 1024); } while (0)
#define PG8_LDB(dst, b, h) do { _Pragma("unroll") for (int n = 0; n < 2; ++n) _Pragma("unroll") for (int k = 0; k < 2; ++k) dst[n][k] = *(const PG8_LAS bf16x8*)(lds + PG8_SB(b, h) + boff + n * 2048 + k * 1024); } while (0)
#define PG8_MMA(ai, bj, At, Bt) do { __builtin_amdgcn_s_setprio(1); _Pragma("unroll") for (int m = 0; m < 4; ++m) _Pragma("unroll") for (int n = 0; n < 2; ++n) _Pragma("unroll") for (int k = 0; k < 2; ++k) \
        acc[ai][bj][m][n] = __builtin_amdgcn_mfma_f32_16x16x32_bf16(Bt[n][k], At[m][k], acc[ai][bj][m][n], 0, 0, 0); __builtin_amdgcn_s_setprio(0); } while (0)
#define PG8_WAIT_V(n) asm volatile("s_waitcnt vmcnt(" #n ")" ::: "memory")
#define PG8_WAIT_L(n) asm volatile("s_waitcnt lgkmcnt(" #n ")" ::: "memory")
#define PG8_BAR __builtin_amdgcn_s_barrier()
#define PG8_SCHED __builtin_amdgcn_sched_barrier(0)
    Unit cur, nxt; int ui = 0;
    if (!S.next(0, cur)) return;
    f32x4 acc[2][2][4][2];
#pragma unroll
    for (int a = 0; a < 2; ++a)
#pragma unroll
        for (int b = 0; b < 2; ++b)
#pragma unroll
            for (int m = 0; m < 4; ++m)
#pragma unroll
                for (int n = 0; n < 2; ++n) acc[a][b][m][n] = (f32x4){0.f, 0.f, 0.f, 0.f};
    bf16x8 At[4][2], B0[2][2], B1[2][2];
    const char* cA = (const char*)g.A + (size_t)cur.pm * tstep; const char* cB = (const char*)g.Bt + (size_t)cur.pn * tstep;
    S.a_ready(cur);
    if constexpr (Epi::HAS_TAB) { typename Epi::Pre pre0; E.tab_load(pre0, cur.pm); E.tab_store(pre0, 0); }
    if constexpr (SP2) {
        PG8_STAGE(PG8_SB(0, 0), cB, voffB); PG8_STAGE(PG8_SB(0, 1), cB + hstep, voffB); PG8_STAGE(PG8_SA(0, 0), cA, voffA); PG8_STAGE(PG8_SA(0, 1), cA + hstep, voffA);
        if (wr == 1) PG8_BAR;
        PG8_WAIT_V(2); PG8_BAR;
        PG8_STAGE(PG8_SB(1, 0), cB + kstep, voffB); PG8_STAGE(PG8_SA(1, 0), cA + kstep, voffA); PG8_STAGE(PG8_SB(1, 1), cB + hstep + kstep, voffB);
        PG8_WAIT_V(6); PG8_BAR;
    } else {
        PG8_STAGE(PG8_SB(0, 0), cB, voffB); PG8_STAGE(PG8_SA(0, 0), cA, voffA); PG8_STAGE(PG8_SB(0, 1), cB + hstep, voffB); PG8_STAGE(PG8_SA(0, 1), cA + hstep, voffA);
        if (wr == 1) PG8_BAR;
        PG8_WAIT_V(4); PG8_BAR;
        PG8_STAGE(PG8_SB(1, 0), cB + kstep, voffB); PG8_STAGE(PG8_SA(1, 0), cA + kstep, voffA); PG8_STAGE(PG8_SB(1, 1), cB + hstep + kstep, voffB);
        PG8_WAIT_V(6); PG8_BAR;
    }
    for (;;) {
        const bool has_next = S.next(ui + 1, nxt);
        const char* nA = has_next ? (const char*)g.A + (size_t)nxt.pm * tstep : cA; const char* nB = has_next ? (const char*)g.Bt + (size_t)nxt.pn * tstep : cB;
        for (int t = 0; t < nt; t += 2) {
            const bool last = (t == nt - 2);
            const char* a1 = cA + (size_t)(t + 1) * kstep;
            const char* a2 = last ? nA : cA + (size_t)(t + 2) * kstep; const char* b2 = last ? nB : cB + (size_t)(t + 2) * kstep;
            const char* a3 = a2 + kstep; const char* b3 = b2 + kstep;
            if (last && has_next) S.a_ready(nxt);
            if constexpr (SP2) {
            PG8_LDB(B0, 0, 0); PG8_LDB(B1, 0, 1); PG8_SCHED; PG8_LDA(At, 0, 0); PG8_STAGE(PG8_SA(1, 1), a1 + hstep, voffA);
            PG8_WAIT_V(8); PG8_WAIT_L(0); PG8_BAR; PG8_MMA(0, 0, At, B0); PG8_MMA(0, 1, At, B1); PG8_BAR; PG8_SCHED;
            PG8_LDA(At, 0, 1); PG8_STAGE(PG8_SB(0, 0), b2, voffB); PG8_STAGE(PG8_SB(0, 1), b2 + hstep, voffB); PG8_STAGE(PG8_SA(0, 0), a2, voffA);
            PG8_WAIT_V(8); PG8_WAIT_L(0); PG8_BAR; PG8_MMA(1, 0, At, B0); PG8_MMA(1, 1, At, B1); PG8_BAR; PG8_SCHED;
            PG8_LDB(B0, 1, 0); PG8_LDB(B1, 1, 1); PG8_SCHED; PG8_LDA(At, 1, 0); PG8_STAGE(PG8_SA(0, 1), a2 + hstep, voffA);
            PG8_WAIT_V(8); PG8_WAIT_L(0); PG8_BAR; PG8_MMA(0, 0, At, B0); PG8_MMA(0, 1, At, B1); PG8_BAR; PG8_SCHED;
            PG8_LDA(At, 1, 1); PG8_STAGE(PG8_SB(1, 0), b3, voffB); PG8_STAGE(PG8_SB(1, 1), b3 + hstep, voffB); PG8_STAGE(PG8_SA(1, 0), a3, voffA);
            PG8_WAIT_V(8); PG8_WAIT_L(0); PG8_BAR; PG8_MMA(1, 0, At, B0); PG8_MMA(1, 1, At, B1); PG8_BAR; PG8_SCHED;
            } else {
            PG8_LDB(B0, 0, 0); PG8_SCHED; PG8_LDA(At, 0, 0); PG8_STAGE(PG8_SA(1, 1), a1 + hstep, voffA);
            PG8_WAIT_L(8); PG8_BAR; PG8_WAIT_L(0); PG8_MMA(0, 0, At, B0); PG8_BAR; PG8_SCHED;
            PG8_LDB(B1, 0, 1); PG8_STAGE(PG8_SB(0, 0), b2, voffB);
            PG8_BAR; PG8_WAIT_L(0); PG8_MMA(0, 1, At, B1); PG8_BAR;
            PG8_LDA(At, 0, 1); PG8_STAGE(PG8_SA(0, 0), a2, voffA);
            PG8_BAR; PG8_WAIT_L(0); PG8_MMA(1, 0, At, B0); PG8_BAR; PG8_SCHED;
            PG8_STAGE(PG8_SB(0, 1), b2 + hstep, voffB);
            PG8_WAIT_V(6); PG8_BAR; PG8_MMA(1, 1, At, B1); PG8_BAR;
            PG8_LDB(B0, 1, 0); PG8_SCHED; PG8_LDA(At, 1, 0); PG8_STAGE(PG8_SA(0, 1), a2 + hstep, voffA);
            PG8_WAIT_L(8); PG8_BAR; PG8_WAIT_L(0); PG8_MMA(0, 0, At, B0); PG8_BAR; PG8_SCHED;
            PG8_LDB(B1, 1, 1); PG8_STAGE(PG8_SB(1, 0), b3, voffB);
            PG8_BAR; PG8_WAIT_L(0); PG8_MMA(0, 1, At, B1); PG8_BAR;
            PG8_LDA(At, 1, 1); PG8_STAGE(PG8_SA(1, 0), a3, voffA);
            PG8_BAR; PG8_WAIT_L(0); PG8_MMA(1, 0, At, B0); PG8_BAR; PG8_SCHED;
            PG8_STAGE(PG8_SB(1, 1), b3 + hstep, voffB);
            PG8_WAIT_V(6); PG8_BAR; PG8_MMA(1, 1, At, B1); PG8_BAR;
            }
        }
        if constexpr (ALIGN_EPI) { if (wr == 0) PG8_BAR; }
        if constexpr (!Epi::AFTER_DRAIN) {
            if constexpr (Epi::HAS_TAB) { typename Epi::Pre pre; E.tab_load(pre, has_next ? nxt.pm : cur.pm); E(acc, cur, wr, wc, fr, fq, ui & 1); E.tab_store(pre, (ui + 1) & 1); }
            else E(acc, cur, wr, wc, fr, fq);
            S.done(cur); }
        if (!has_next) break;
#pragma unroll
        for (int a = 0; a < 2; ++a)
#pragma unroll
            for (int b = 0; b < 2; ++b)
#pragma unroll
                for (int m = 0; m < 4; ++m)
#pragma unroll
                    for (int n = 0; n < 2; ++n) acc[a][b][m][n] = (f32x4){0.f, 0.f, 0.f, 0.f};
        cur = nxt; cA = nA; cB = nB; ++ui;
        if constexpr (ALIGN_EPI) { if (wr == 1) PG8_BAR; }
    }
    PG8_WAIT_V(0);
    if constexpr (!ALIGN_EPI) { if (wr == 0) PG8_BAR; }
    PG8_BAR;
    if constexpr (Epi::AFTER_DRAIN) { E.fused(acc, cur, wr, wc, fr, fq, lds, wid, lane); S.done(cur); }
#undef PG8_SA
#undef PG8_SB
#undef PG8_STAGE
#undef PG8_LDA
#undef PG8_LDB
#undef PG8_MMA
#undef PG8_WAIT_V
#undef PG8_WAIT_L
#undef PG8_BAR
#undef PG8_SCHED
}
}

#ifndef PG8_SP2
#define PG8_SP2 true
#endif
#ifndef PG8_ALIGN
#define PG8_ALIGN true
#endif

#include <hip/hip_cooperative_groups.h>
namespace cg = cooperative_groups;
#define LAS __attribute__((address_space(3)))
typedef unsigned short bf16;
typedef unsigned v4u __attribute__((ext_vector_type(4)));
typedef unsigned v2u __attribute__((ext_vector_type(2)));
typedef float f32x4 __attribute__((ext_vector_type(4)));
typedef short bf16x8 __attribute__((ext_vector_type(8)));

constexpr int D = 1024, M_P = 16384, M_S = 65536, M = M_P + M_S, T_P = 2048, T_S = 4096;
constexpr int FF = 2816, NIN = 3328, NT32 = M / 32, NT16 = M / 16;
constexpr float ALPHA = 1.189207115002721f;
constexpr float EPS = 1e-5f;
constexpr float LOG2E = 1.4426950408889634f;
constexpr float QSCALE = 0.125f * LOG2E;
constexpr int NWAVES = 8;
constexpr int LDS_BYTES = 155648;
constexpr int MISC_OFF = 151552;

constexpr size_t MiB = 1u << 20;
constexpr size_t WS_W13A = 0, WS_W13B = 11 * MiB, WS_W2A = 22 * MiB, WS_W2B = 28 * MiB, WS_WIN = 34 * MiB, WS_WOUT = 41 * MiB;
constexpr size_t WS_XB = 44 * MiB, WS_BIG = 204 * MiB;
constexpr size_t WS_H = WS_BIG;
constexpr size_t WS_QA = WS_BIG, WS_KA = WS_BIG + 80 * MiB, WS_VT = WS_BIG + 100 * MiB, WS_QH = WS_BIG + 120 * MiB, WS_GF = WS_BIG + 200 * MiB,
                 WS_GB = WS_BIG + 280 * MiB, WS_IH = WS_BIG + 360 * MiB, WS_GH = WS_BIG + 440 * MiB, WS_OF = WS_GF, WS_OB = WS_GB, WS_MIX = WS_BIG + 520 * MiB;
constexpr size_t WS_CTL = WS_BIG + 680 * MiB, WS_BAR = WS_CTL + 4096, WS_END = WS_BAR + 16384;

__device__ __forceinline__ unsigned f2bf(float f) { unsigned u = __builtin_bit_cast(unsigned, f); return (u + 0x7fffu + ((u >> 16) & 1u)) >> 16; }
__device__ __forceinline__ unsigned pk2(float lo, float hi) { return f2bf(lo) | (f2bf(hi) << 16); }
__device__ __forceinline__ float bf2f(unsigned short h) { return __builtin_bit_cast(float, (unsigned)h << 16); }
__device__ __forceinline__ float bflo(unsigned w) { return __builtin_bit_cast(float, w << 16); }
__device__ __forceinline__ float bfhi(unsigned w) { return __builtin_bit_cast(float, w & 0xffff0000u); }
__device__ __forceinline__ float wave_sum(float v) {
#pragma unroll
    for (int o = 1; o < 64; o <<= 1) v += __shfl_xor(v, o);
    return v;
}
__device__ __forceinline__ float silu_f(float x) { return x * __builtin_amdgcn_rcpf(1.0f + __builtin_amdgcn_exp2f(-x * LOG2E)); }

__device__ __forceinline__ size_t qk_off(int m, int head, int d0, int hh) { return ((((size_t)head * NT32 + (m >> 5)) * 4 + d0) * 32 + (m & 31)) * 16 + hh * 8; }
__device__ __forceinline__ int vt_slot(int o) { return ((o >> 2) & 1) * 8 + (o >> 3) * 4 + (o & 3); }
__device__ __forceinline__ size_t vt_off(int m, int kvh, int d) { return (((size_t)kvh * NT16 + (m >> 4)) * 64 + d) * 16 + vt_slot(m & 15); }

namespace pg8 {
struct EpiRes {
    static constexpr bool PERM = false, AFTER_DRAIN = false, HAS_TAB = false;
    const float* res0; const float* res1; int split; float* out; float alpha, s;
    __device__ __forceinline__ void operator()(const f32x4 (&acc)[2][2][4][2], const Unit& u, int wr, int wc, int fr, int fq) const {
        const int row0 = u.pm * BM + wr * 64 + fr, col0 = u.pn * BM + wc * 32 + 4 * fq;
        const float* rb = (u.pm * BM < split) ? res0 : res1 - (size_t)split * 1024;
#pragma unroll
        for (int ai = 0; ai < 2; ++ai)
#pragma unroll
            for (int m = 0; m < 4; ++m) { const size_t off = (size_t)(row0 + ai * HALF + m * 16) * 1024 + col0;
#pragma unroll
                for (int bj = 0; bj < 2; ++bj)
#pragma unroll
                    for (int n = 0; n < 2; ++n) { const f32x4 rv = *(const f32x4*)(rb + off + bj * HALF + n * 16);
                        *(f32x4*)(out + off + bj * HALF + n * 16) = rv * alpha + acc[ai][bj][m][n] * s; }
                if (m & 1) asm volatile("" ::: "memory"); }
    }
};
struct EpiResB {
    static constexpr bool PERM = false, AFTER_DRAIN = false, HAS_TAB = false;
    const bf16_t* res; bf16_t* vout; float alpha, s;
    __device__ __forceinline__ void operator()(const f32x4 (&acc)[2][2][4][2], const Unit& u, int wr, int wc, int fr, int fq) const {
        typedef unsigned u32x2e __attribute__((ext_vector_type(2)));
        const int row0 = u.pm * BM + wr * 64 + fr, col0 = u.pn * BM + wc * 32 + 4 * fq;
#pragma unroll
        for (int ai = 0; ai < 2; ++ai)
#pragma unroll
            for (int m = 0; m < 4; ++m) { const size_t off = (size_t)(row0 + ai * HALF + m * 16) * 1024 + col0;
#pragma unroll
                for (int bj = 0; bj < 2; ++bj)
#pragma unroll
                    for (int n = 0; n < 2; ++n) { const u32x2e rw = *(const u32x2e*)(res + off + bj * HALF + n * 16);
                        const f32x4 rv = (f32x4){__builtin_bit_cast(float, rw[0] << 16), __builtin_bit_cast(float, rw[0] & 0xffff0000u), __builtin_bit_cast(float, rw[1] << 16), __builtin_bit_cast(float, rw[1] & 0xffff0000u)};
                        const f32x4 o = rv * alpha + acc[ai][bj][m][n] * s;
                        u32x2e w; w[0] = cvt_pk_bf16(o[0], o[1]); w[1] = cvt_pk_bf16(o[2], o[3]); *(u32x2e*)(vout + off + bj * HALF + n * 16) = w; }
                if (m & 1) asm volatile("" ::: "memory"); }
    }
};
struct EpiSwiGLU {
    static constexpr bool PERM = true, AFTER_DRAIN = false, HAS_TAB = false;
    bf16_t* H;
    __device__ __forceinline__ void operator()(const f32x4 (&acc)[2][2][4][2], const Unit& u, int wr, int wc, int fr, int fq) const {
        const int row0 = u.pm * BM + wr * 64 + fr, col0 = u.pn * HALF + wc * 32 + 8 * fq;
#pragma unroll
        for (int ai = 0; ai < 2; ++ai)
#pragma unroll
            for (int m = 0; m < 4; ++m) {
                float h[8];
#pragma unroll
                for (int n = 0; n < 2; ++n)
#pragma unroll
                    for (int i = 0; i < 4; ++i) { const float g = acc[ai][0][m][n][i], up = acc[ai][1][m][n][i]; h[n * 4 + i] = silu_f(g) * up; }
                u32x4 w; w.x = cvt_pk_bf16(h[0], h[1]); w.y = cvt_pk_bf16(h[2], h[3]); w.z = cvt_pk_bf16(h[4], h[5]); w.w = cvt_pk_bf16(h[6], h[7]);
                __builtin_nontemporal_store(w, (u32x4*)(H + (size_t)(row0 + ai * HALF + m * 16) * FF + col0)); }
    }
};
struct EpiIn {
    static constexpr bool PERM = true, AFTER_DRAIN = false, HAS_TAB = false;
    unsigned char* ws; const float* lbf; const float* lbb;
    __device__ __forceinline__ void operator()(const f32x4 (&acc)[2][2][4][2], const Unit& u, int wr, int wc, int fr, int fq) const {
        bf16_t* QA = (bf16_t*)(ws + WS_QA); bf16_t* KA = (bf16_t*)(ws + WS_KA); bf16_t* VT = (bf16_t*)(ws + WS_VT);
        const int pn = u.pn; const int row0 = u.pm * BM + wr * 64 + fr; const int c8 = wc * 32 + 8 * fq;
        if (pn <= 2) {
            const int hd = wc >> 1, dim = (wc & 1) * 32 + 8 * fq, d0 = dim >> 4, hh = (dim >> 3) & 1;
#pragma unroll
            for (int ai = 0; ai < 2; ++ai)
#pragma unroll
                for (int m = 0; m < 4; ++m) { const int row = row0 + ai * HALF + m * 16;
#pragma unroll
                    for (int bj = 0; bj < 2; ++bj) { const f32x4 v0 = acc[ai][bj][m][0], v1 = acc[ai][bj][m][1];
                        if (pn < 2) { const int head = pn * 4 + bj * 2 + hd; u32x4 w; w.x = cvt_pk_bf16(v0[0] * QSCALE, v0[1] * QSCALE); w.y = cvt_pk_bf16(v0[2] * QSCALE, v0[3] * QSCALE);
                            w.z = cvt_pk_bf16(v1[0] * QSCALE, v1[1] * QSCALE); w.w = cvt_pk_bf16(v1[2] * QSCALE, v1[3] * QSCALE); *(u32x4*)(QA + qk_off(row, head, d0, hh)) = w; }
                        else if (bj == 0) { u32x4 w; w.x = cvt_pk_bf16(v0[0], v0[1]); w.y = cvt_pk_bf16(v0[2], v0[3]); w.z = cvt_pk_bf16(v1[0], v1[1]); w.w = cvt_pk_bf16(v1[2], v1[3]); *(u32x4*)(KA + qk_off(row, hd, d0, hh)) = w; }
                        else { bf16_t* vp = VT + vt_off(row, hd, dim);
#pragma unroll
                            for (int i = 0; i < 4; ++i) { vp[i * 16] = (bf16_t)f2bf(v0[i]); vp[(4 + i) * 16] = (bf16_t)f2bf(v1[i]); } } } }
        } else if (pn <= 4 || pn >= 9) {
            bf16_t* dst = (bf16_t*)(ws + (pn <= 4 ? WS_QH : (pn <= 10 ? WS_IH : WS_GH))); const int cb = ((pn <= 4 ? pn - 3 : (pn <= 10 ? pn - 9 : pn - 11)) * 256) + c8;
#pragma unroll
            for (int ai = 0; ai < 2; ++ai)
#pragma unroll
                for (int m = 0; m < 4; ++m) { const int row = row0 + ai * HALF + m * 16;
#pragma unroll
                    for (int bj = 0; bj < 2; ++bj) { const f32x4 v0 = acc[ai][bj][m][0], v1 = acc[ai][bj][m][1];
                        u32x4 w; w.x = cvt_pk_bf16(v0[0], v0[1]); w.y = cvt_pk_bf16(v0[2], v0[3]); w.z = cvt_pk_bf16(v1[0], v1[1]); w.w = cvt_pk_bf16(v1[2], v1[3]);
                        *(u32x4*)(dst + (size_t)row * 512 + cb + bj * HALF) = w; } }
        } else {
            bf16_t* dst = (bf16_t*)(ws + (pn <= 6 ? WS_GF : WS_GB)); const float* lp = pn <= 6 ? lbf : lbb; const int cb = ((pn - 5) & 1) * 256 + c8;
#pragma unroll
            for (int bj = 0; bj < 2; ++bj) { float lb[8];
#pragma unroll
                for (int i = 0; i < 8; ++i) { const float p0 = lp[cb + bj * HALF + i], p1 = lp[512 + cb + bj * HALF + i]; lb[i] = __builtin_amdgcn_rcpf(1.0f + __expf(p1 - p0)); }
#pragma unroll
                for (int ai = 0; ai < 2; ++ai)
#pragma unroll
                    for (int m = 0; m < 4; ++m) { const int row = row0 + ai * HALF + m * 16; float g[8];
#pragma unroll
                        for (int n = 0; n < 2; ++n)
#pragma unroll
                            for (int i = 0; i < 4; ++i) { const float x = acc[ai][bj][m][n][i]; const float sg = __builtin_amdgcn_rcpf(1.0f + __builtin_amdgcn_exp2f(-x * 1.4426950408889634f));
                                const float l = lb[n * 4 + i]; g[n * 4 + i] = __logf(l + (1.0f - l) * sg); }
                        u32x4 w; w.x = cvt_pk_bf16(g[0], g[1]); w.y = cvt_pk_bf16(g[2], g[3]); w.z = cvt_pk_bf16(g[4], g[5]); w.w = cvt_pk_bf16(g[6], g[7]);
                        *(u32x4*)(dst + (size_t)row * 512 + cb + bj * HALF) = w; } }
        }
    }
};
}

struct Args { const float* in[13]; float* out; unsigned char* ws; };

struct Frame {
    LAS unsigned char* lds; int tid, lane, wave, G, bid;
};

struct TrItem { const float* W; bf16* WT; int K, N, mode, r; };
constexpr int TR_I13 = (D / 64) * (2 * FF / 32), TR_I2 = (FF / 64) * (D / 32), TR_IIN = (D / 64) * (NIN / 32), TR_IOUT = (D / 64) * (D / 32);
constexpr int TR_EARLY = TR_I13 + TR_I2 + TR_IIN, TR_LATE = TR_I13 + TR_I2 + TR_IOUT;
__device__ __forceinline__ void p0_decode(const Args& a, unsigned char* ws, int it, bool late, TrItem& t) {
    int r = it;
    if (!late) {
        if (r < TR_I13) { t = TrItem{a.in[4], (bf16*)(ws + WS_W13A), D, 2 * FF, 1, r}; return; } r -= TR_I13;
        if (r < TR_I2) { t = TrItem{a.in[5], (bf16*)(ws + WS_W2A), FF, D, 0, r}; return; } r -= TR_I2;
        t = TrItem{a.in[6], (bf16*)(ws + WS_WIN), D, NIN, 0, r};
    } else {
        if (r < TR_I13) { t = TrItem{a.in[4] + (size_t)D * 2 * FF, (bf16*)(ws + WS_W13B), D, 2 * FF, 1, r}; return; } r -= TR_I13;
        if (r < TR_I2) { t = TrItem{a.in[5] + (size_t)FF * D, (bf16*)(ws + WS_W2B), FF, D, 0, r}; return; } r -= TR_I2;
        t = TrItem{a.in[12], (bf16*)(ws + WS_WOUT), D, D, 0, r};
    }
}
__device__ __forceinline__ void p0_load(const TrItem& t, int lane, float (&wv)[32]) {
    const int nblk = t.N / 32, kb = t.r / nblk, nb = t.r % nblk, k0 = 64 * kb, n0 = 32 * nb;
    const float* p = t.W + (size_t)(k0 + (lane >> 5)) * t.N + n0 + (lane & 31);
#pragma unroll
    for (int i = 0; i < 32; ++i) wv[i] = p[(size_t)(2 * i) * t.N];
}
__device__ __forceinline__ void p0_store(const TrItem& t, LAS float* scr, int lane, const float (&wv)[32]) {
    const int nblk = t.N / 32, kb = t.r / nblk, nb = t.r % nblk, k0 = 64 * kb, n0 = 32 * nb;
    int rbase = n0;
    if (t.mode == 1) { const int h0 = n0 < FF ? n0 : n0 - FF; rbase = (h0 >> 7) * 256 + (n0 < FF ? 0 : 128) + (h0 & 127); }
#pragma unroll
    for (int i = 0; i < 32; ++i) scr[(2 * i + (lane >> 5)) * 33 + (lane & 31)] = wv[i];
    asm volatile("s_waitcnt lgkmcnt(0)" ::: "memory");
    const int c = lane & 7;
#pragma unroll
    for (int j = 0; j < 4; ++j) { const int n = (lane >> 3) + 8 * j; const LAS float* s = scr + (8 * c) * 33 + n;
        v4u o; o.x = pk2(s[0 * 33], s[1 * 33]); o.y = pk2(s[2 * 33], s[3 * 33]); o.z = pk2(s[4 * 33], s[5 * 33]); o.w = pk2(s[6 * 33], s[7 * 33]);
        *(v4u*)(t.WT + (size_t)(rbase + n) * t.K + k0 + 8 * c) = o; }
    asm volatile("s_waitcnt lgkmcnt(0)" ::: "memory");
}
__device__ __forceinline__ void p0_transposes(const Frame& F, const Args& a, bool late, int gw, int NGW, int nitems) {
    LAS float* scr = (LAS float*)(F.lds + F.wave * 16384); unsigned char* ws = a.ws;
    TrItem cur, nxt; float wv[32], wn[32]; int it = gw;
    if (it < nitems) { p0_decode(a, ws, it, late, cur); p0_load(cur, F.lane, wv); }
    while (it < nitems) { const int itn = it + NGW; const bool hn = itn < nitems;
        if (hn) { p0_decode(a, ws, itn, late, nxt); p0_load(nxt, F.lane, wn); }
        p0_store(cur, scr, F.lane, wv);
        if (hn) { cur = nxt;
#pragma unroll
            for (int i = 0; i < 32; ++i) wv[i] = wn[i]; }
        it = itn; }
}
__device__ __forceinline__ void p0_prologue(const Frame& F, const Args& a, int part) {
    LAS float* scr = (LAS float*)(F.lds + F.wave * 16384);
    const int gw = F.bid * NWAVES + F.wave, NGW = F.G * NWAVES;
    unsigned char* ws = a.ws;
    constexpr int NITEMS = 2 * (D / 64) * (2 * FF / 32) + 2 * (FF / 64) * (D / 32) + (D / 64) * (NIN / 32) + (D / 64) * (D / 32);
    if (part == 0) p0_transposes(F, a, false, gw, NGW, TR_EARLY);
    bf16* XB = (bf16*)(ws + WS_XB);
    if (part == 1) for (int m4 = gw * 4; m4 < M; m4 += NGW * 4) {
        f32x4 v[4][4];
#pragma unroll
        for (int rr = 0; rr < 4; ++rr) { const int m = m4 + rr; const float* xrow = m < M_P ? a.in[0] + (size_t)m * D : a.in[1] + (size_t)(m - M_P) * D; const f32x4* xr = (const f32x4*)xrow + F.lane;
#pragma unroll
            for (int j = 0; j < 4; ++j) v[rr][j] = __builtin_nontemporal_load(xr + 64 * j); }
#pragma unroll
        for (int rr = 0; rr < 4; ++rr) { v2u* o8 = (v2u*)(XB + (size_t)(m4 + rr) * D) + F.lane;
#pragma unroll
            for (int j = 0; j < 4; ++j) { v2u w; w.x = pk2(v[rr][j].x, v[rr][j].y); w.y = pk2(v[rr][j].z, v[rr][j].w); o8[64 * j] = w; } }
    }
}
__device__ __forceinline__ void ln_phase(const Frame& F, const bf16* vin, bf16* xb, float* fout, const float* g, const float* b) {
    const int gw = F.bid * NWAVES + F.wave, NGW = F.G * NWAVES;
    f32x4 gv[4], bv[4];
#pragma unroll
    for (int j = 0; j < 4; ++j) { gv[j] = ((const f32x4*)g)[F.lane + 64 * j]; bv[j] = ((const f32x4*)b)[F.lane + 64 * j]; }
    for (int m2 = gw * 2; m2 < M; m2 += NGW * 2) {
        f32x4 v[2][4]; float s[2], s2[2], mean[2], rstd[2];
#pragma unroll
        for (int rr = 0; rr < 2; ++rr) { const v2u* xr = (const v2u*)(vin + (size_t)(m2 + rr) * D) + F.lane; s[rr] = 0.f;
#pragma unroll
            for (int j = 0; j < 4; ++j) { const v2u w = __builtin_nontemporal_load(xr + 64 * j); v[rr][j] = (f32x4){bflo(w.x), bfhi(w.x), bflo(w.y), bfhi(w.y)}; } }
#pragma unroll
        for (int rr = 0; rr < 2; ++rr) {
#pragma unroll
            for (int j = 0; j < 4; ++j) s[rr] += (v[rr][j].x + v[rr][j].y) + (v[rr][j].z + v[rr][j].w); }
#pragma unroll
        for (int rr = 0; rr < 2; ++rr) { mean[rr] = wave_sum(s[rr]) * (1.f / D); s2[rr] = 0.f;
#pragma unroll
            for (int j = 0; j < 4; ++j) { v[rr][j] = v[rr][j] - mean[rr]; s2[rr] += (v[rr][j].x * v[rr][j].x + v[rr][j].y * v[rr][j].y) + (v[rr][j].z * v[rr][j].z + v[rr][j].w * v[rr][j].w); } }
#pragma unroll
        for (int rr = 0; rr < 2; ++rr) { rstd[rr] = 1.f / sqrtf(wave_sum(s2[rr]) * (1.f / D) + EPS);
#pragma unroll
            for (int j = 0; j < 4; ++j) { const f32x4 y = v[rr][j] * rstd[rr] * gv[j] + bv[j];
                if (fout) __builtin_nontemporal_store(y, (f32x4*)(fout + (size_t)(m2 + rr) * D) + F.lane + 64 * j);
                else { v2u w; w.x = pk2(y.x, y.y); w.y = pk2(y.z, y.w); ((v2u*)(xb + (size_t)(m2 + rr) * D) + F.lane)[64 * j] = w; } } }
    }
}
__device__ __forceinline__ void hgrn_item_naive(const Frame& F, const Args& a, int it) {
    unsigned char* ws = a.ws;
    int s0, T, head, dir;
    if (it < 128) { s0 = M_P + (it >> 3) * T_S; T = T_S; } else { s0 = ((it - 128) >> 3) * T_P; T = T_P; }
    head = (it >> 1) & 3; dir = it & 1;
    const bf16* QH = (const bf16*)(ws + WS_QH); const bf16* G = (const bf16*)(ws + (dir ? WS_GB : WS_GF)); const bf16* IH = (const bf16*)(ws + WS_IH);
    bf16* O = (bf16*)a.out + (dir ? (size_t)M * 512 : 0);
    LAS float* qs = (LAS float*)F.lds; LAS float* fs = qs + 1024; LAS float* ks = fs + 1024; LAS float* vs = ks + 1024; LAS float* red = vs + 1024;
    const int v = F.tid & 127, dq = F.tid >> 7;
    float S[32];
#pragma unroll
    for (int i = 0; i < 32; ++i) S[i] = 0.f;
    for (int b0 = 0; b0 < T; b0 += 8) {
        __syncthreads();
#pragma unroll
        for (int e = F.tid; e < 1024; e += 512) { const int tok = e >> 7, d = e & 127; const int j = b0 + tok; const int t = dir ? T - 1 - j : j; const size_t idx = (size_t)(s0 + t) * 512 + head * 128 + d;
            qs[e] = bf2f(QH[idx]); const float f = __expf(bf2f(G[idx])); fs[e] = f; ks[e] = 1.0f - f; vs[e] = bf2f(IH[idx]); }
        __syncthreads();
#pragma unroll 1
        for (int tok = 0; tok < 8; ++tok) { const float iv = vs[tok * 128 + v]; float o = 0.f;
#pragma unroll
            for (int dd = 0; dd < 32; ++dd) { const int d = dq * 32 + dd; S[dd] = fs[tok * 128 + d] * S[dd] + ks[tok * 128 + d] * iv; o += qs[tok * 128 + d] * S[dd]; }
            red[(dq * 8 + tok) * 128 + v] = o; }
        __syncthreads();
#pragma unroll
        for (int e = F.tid; e < 1024; e += 512) { const int tok = e >> 7, vv = e & 127; const int j = b0 + tok; const int t = dir ? T - 1 - j : j;
            const float sm = (red[(0 * 8 + tok) * 128 + vv] + red[(1 * 8 + tok) * 128 + vv]) + (red[(2 * 8 + tok) * 128 + vv] + red[(3 * 8 + tok) * 128 + vv]);
            O[(size_t)(s0 + t) * 512 + head * 128 + vv] = (bf16)f2bf(sm); }
    }
    __syncthreads();
}

__device__ __forceinline__ float exp_c(float x) { return __builtin_amdgcn_exp2f(fminf(x, 80.0f) * LOG2E); }
__device__ __forceinline__ int dperm(int d) { return (d & ~31) | (((d >> 2) & 3) << 3) | (((d >> 4) & 1) << 2) | (d & 3); }
#define LDS_BAR() do { asm volatile("s_waitcnt lgkmcnt(0)" ::: "memory"); __builtin_amdgcn_s_barrier(); asm volatile("" ::: "memory"); } while (0)
constexpr int HO_QS = 0, HO_KS = 17408, HO_KT = 34816, HO_VT = 53248, HO_AS = 71680, HO_E1 = 80896, HO_E2 = HO_E1 + 512, HO_E3 = HO_E1 + 1024, HO_TOT = 82432, HO_OS = 86528;
#define LDSP(T_, base_, off_) ((LAS T_*)(uintptr_t)(unsigned)((base_) + (unsigned)(off_)))
__device__ __forceinline__ void hgrn_item_mfma(const Frame& F, const Args& a, int it) {
    unsigned char* ws = a.ws;
    int s0, T;
    if (it < 128) { s0 = M_P + (it >> 3) * T_S; T = T_S; } else { s0 = ((it - 128) >> 3) * T_P; T = T_P; }
    const int head = (it >> 1) & 3, dir = it & 1;
    const bf16* QH = (const bf16*)(ws + WS_QH); const bf16* G = (const bf16*)(ws + (dir ? WS_GB : WS_GF)); const bf16* IH = (const bf16*)(ws + WS_IH);
    bf16* O = (bf16*)a.out + (dir ? (size_t)M * 512 : 0);
    const int dp = F.tid & 63, w = F.wave, part = w, r = F.lane & 15, q4 = F.lane >> 4;
    const int d0 = 2 * dp, pd0 = dperm(d0);
    const unsigned L0 = (unsigned)(uintptr_t)F.lds;
    unsigned pA = L0 + d0 * 4 + part * 512, pA0 = L0 + d0 * 4, pQ = L0 + pd0 * 2 + part * 2176, pK = L0 + d0 * 144 + part * 16;
    unsigned rA = L0 + r * 272 + q4 * 16, rB = L0 + r * 144 + q4 * 16, rBv = L0 + r * 144 + q4 * 16 + w * 2304, pE = L0 + q4 * 16;
    unsigned pO = L0 + q4 * 1088 + (16 * w + r) * 2, pF = L0 + (F.tid >> 4) * 272 + (F.tid & 15) * 16;
    unsigned rAc = L0 + r * 272 + q4 * 16 + (w >> 1) * 4352, rKc = L0 + r * 272 + q4 * 16 + ((w & 1) * 2) * 4352, pAs = L0 + q4 * 576 + r * 2 + (w >> 1) * 2304 + (w & 1) * 64;
    asm volatile("" : "+v"(pA), "+v"(pA0), "+v"(pQ), "+v"(pK), "+v"(rA), "+v"(rB), "+v"(rBv), "+v"(pE));
    asm volatile("" : "+v"(pO), "+v"(pF), "+v"(rAc), "+v"(rKc), "+v"(pAs));
    const int nch = T / 64;
    pg8::f32x4 S[8];
#pragma unroll
    for (int i = 0; i < 8; ++i) S[i] = (pg8::f32x4){0.f, 0.f, 0.f, 0.f};
    unsigned g2[8], q2[8], v2[8];
    const bf16* Gb = G + (size_t)s0 * 512 + head * 128; const bf16* Qb = QH + (size_t)s0 * 512 + head * 128; const bf16* Vb = IH + (size_t)s0 * 512 + head * 128;
    bf16* Ob = O + (size_t)s0 * 512 + head * 128;
    const int rstep = dir ? -512 : 512; const int roff0 = (dir ? (T - 1 - part * 8) : part * 8) * 512 + d0;
#define HG_LOAD(c) do { const int o0_ = roff0 + (c) * 64 * rstep; _Pragma("unroll") for (int ii = 0; ii < 8; ++ii) { const unsigned o_ = (unsigned)(o0_ + ii * rstep); \
        g2[ii] = *(const unsigned*)(Gb + o_); q2[ii] = *(const unsigned*)(Qb + o_); v2[ii] = *(const unsigned*)(Vb + o_); } } while (0)
#define HG_FLUSH(c) do { _Pragma("unroll") for (int k_ = 0; k_ < 2; ++k_) { const int row_ = (F.tid >> 4) + 32 * k_; const int tk_ = (c) * 64 + row_; const int t_ = dir ? T - 1 - tk_ : tk_; \
        *(v4u*)(Ob + (size_t)t_ * 512 + (F.tid & 15) * 8) = *LDSP(v4u, pF, HO_OS + k_ * 8704); } } while (0)
    HG_LOAD(0);
    const int ti_c = w >> 1, tj0_c = (w & 1) * 2;
    for (int c = 0; c < nch; ++c) {
        typedef float f32x2_ __attribute__((ext_vector_type(2))); typedef unsigned u32x2_ __attribute__((ext_vector_type(2)));
        float pa[8], pb[8]; float ra = 0.f, rb = 0.f;
#pragma unroll
        for (int ii = 0; ii < 8; ++ii) { ra += bflo(g2[ii]) * LOG2E; rb += bfhi(g2[ii]) * LOG2E; pa[ii] = ra; pb[ii] = rb; }
        *LDSP(f32x2_, pA, HO_TOT) = (f32x2_){ra, rb};
        LDS_BAR();
        if (c > 0) HG_FLUSH(c - 1);
        float offA = 0.f, offB = 0.f, brefA = 0.f, brefB = 0.f, blastA = 0.f, blastB = 0.f;
#pragma unroll
        for (int p_ = 0; p_ < 8; ++p_) { const f32x2_ tt = *LDSP(f32x2_, pA0, HO_TOT + p_ * 512); if (p_ < part) { offA += tt.x; offB += tt.y; } if (p_ < 4) { brefA += tt.x; brefB += tt.y; } blastA += tt.x; blastB += tt.y; }
        offA -= brefA; offB -= brefB;
        float ka[8], kb[8];
#pragma unroll
        for (int ii = 0; ii < 8; ++ii) { const float xa = offA + pa[ii], xb = offB + pb[ii];
            const float fa = __builtin_amdgcn_exp2f(bflo(g2[ii]) * LOG2E), fb = __builtin_amdgcn_exp2f(bfhi(g2[ii]) * LOG2E);
            const float qa = bflo(q2[ii]) * __builtin_amdgcn_exp2f(fminf(xa, 115.0f)), qb = bfhi(q2[ii]) * __builtin_amdgcn_exp2f(fminf(xb, 115.0f));
            ka[ii] = (1.0f - fa) * __builtin_amdgcn_exp2f(fminf(-xa, 115.0f)); kb[ii] = (1.0f - fb) * __builtin_amdgcn_exp2f(fminf(-xb, 115.0f));
            *LDSP(unsigned, pQ, HO_QS + ii * 272) = pg8::cvt_pk_bf16(qa, qb); *LDSP(unsigned, pQ, HO_KS + ii * 272) = pg8::cvt_pk_bf16(ka[ii], kb[ii]); }
        *LDSP(v4u, pK, HO_KT) = (v4u){pg8::cvt_pk_bf16(ka[0], ka[1]), pg8::cvt_pk_bf16(ka[2], ka[3]), pg8::cvt_pk_bf16(ka[4], ka[5]), pg8::cvt_pk_bf16(ka[6], ka[7])};
        *LDSP(v4u, pK, HO_KT + 144) = (v4u){pg8::cvt_pk_bf16(kb[0], kb[1]), pg8::cvt_pk_bf16(kb[2], kb[3]), pg8::cvt_pk_bf16(kb[4], kb[5]), pg8::cvt_pk_bf16(kb[6], kb[7])};
        *LDSP(v4u, pK, HO_VT) = (v4u){(v2[0] & 0xffffu) | (v2[1] << 16), (v2[2] & 0xffffu) | (v2[3] << 16), (v2[4] & 0xffffu) | (v2[5] << 16), (v2[6] & 0xffffu) | (v2[7] << 16)};
        *LDSP(v4u, pK, HO_VT + 144) = (v4u){(v2[0] >> 16) | (v2[1] & 0xffff0000u), (v2[2] >> 16) | (v2[3] & 0xffff0000u), (v2[4] >> 16) | (v2[5] & 0xffff0000u), (v2[6] >> 16) | (v2[7] & 0xffff0000u)};
        if (part == 0) { *LDSP(f32x2_, pA0, HO_E1) = (f32x2_){__builtin_amdgcn_exp2f(fminf(blastA, 115.0f)), __builtin_amdgcn_exp2f(fminf(blastB, 115.0f))};
            *LDSP(f32x2_, pA0, HO_E2) = (f32x2_){__builtin_amdgcn_exp2f(fminf(blastA - brefA, 115.0f)), __builtin_amdgcn_exp2f(fminf(blastB - brefB, 115.0f))};
            *LDSP(f32x2_, pA0, HO_E3) = (f32x2_){__builtin_amdgcn_exp2f(fminf(brefA, 115.0f)), __builtin_amdgcn_exp2f(fminf(brefB, 115.0f))}; }
        if (c + 1 < nch) HG_LOAD(c + 1);
        LDS_BAR();
#pragma unroll
        for (int tjj = 0; tjj < 2; ++tjj) { const int tj = tj0_c + tjj; pg8::f32x4 acc = (pg8::f32x4){0.f, 0.f, 0.f, 0.f};
            if (tj <= ti_c) { bf16x8 af[4], bfr[4];
#pragma unroll
                for (int ks = 0; ks < 4; ++ks) { af[ks] = *LDSP(bf16x8, rAc, HO_QS + ks * 64); bfr[ks] = *LDSP(bf16x8, rKc, HO_KS + tjj * 4352 + ks * 64); }
#pragma unroll
                for (int ks = 0; ks < 4; ++ks) acc = __builtin_amdgcn_mfma_f32_16x16x32_bf16(af[ks], bfr[ks], acc, 0, 0, 0); }
#pragma unroll
            for (int rg = 0; rg < 4; ++rg) { const int i = 16 * ti_c + 4 * q4 + rg, j = 16 * tj + r; *LDSP(bf16, pAs, HO_AS + tjj * 32 + rg * 144) = (bf16)f2bf(j <= i ? acc[rg] : 0.f); } }
        LDS_BAR();
        { bf16x8 vB[2], sB[4]; pg8::f32x4 o[4];
          { pg8::f32x4 e3a[4], e3b[4];
#pragma unroll
            for (int ks = 0; ks < 2; ++ks) vB[ks] = *LDSP(bf16x8, rBv, HO_VT + ks * 64);
#pragma unroll
            for (int ks = 0; ks < 4; ++ks) { e3a[ks] = *LDSP(pg8::f32x4, pE, HO_E3 + ks * 128); e3b[ks] = *LDSP(pg8::f32x4, pE, HO_E3 + ks * 128 + 64); }
            __builtin_amdgcn_sched_barrier(0);
#pragma unroll
            for (int ks = 0; ks < 4; ++ks) { const pg8::f32x4 sa = S[2 * ks] * e3a[ks], sb = S[2 * ks + 1] * e3b[ks];
                v4u pw; pw.x = pk2(sa[0], sa[1]); pw.y = pk2(sa[2], sa[3]); pw.z = pk2(sb[0], sb[1]); pw.w = pk2(sb[2], sb[3]); sB[ks] = __builtin_bit_cast(bf16x8, pw); } }
#pragma unroll
          for (int tp = 0; tp < 2; ++tp) { bf16x8 aA[2][2], aQ[2][4];
#pragma unroll
              for (int tt = 0; tt < 2; ++tt) { const int ti = tp * 2 + tt;
#pragma unroll
                  for (int ks = 0; ks < 2; ++ks) aA[tt][ks] = *LDSP(bf16x8, rB, HO_AS + ti * 2304 + ks * 64);
#pragma unroll
                  for (int ks = 0; ks < 4; ++ks) aQ[tt][ks] = *LDSP(bf16x8, rA, HO_QS + ti * 4352 + ks * 64); }
              __builtin_amdgcn_sched_barrier(0);
#pragma unroll
              for (int tt = 0; tt < 2; ++tt) o[tp * 2 + tt] = (pg8::f32x4){0.f, 0.f, 0.f, 0.f};
#pragma unroll
              for (int ks = 0; ks < 2; ++ks)
#pragma unroll
                  for (int tt = 0; tt < 2; ++tt) o[tp * 2 + tt] = __builtin_amdgcn_mfma_f32_16x16x32_bf16(aA[tt][ks], vB[ks], o[tp * 2 + tt], 0, 0, 0);
#pragma unroll
              for (int ks = 0; ks < 4; ++ks)
#pragma unroll
                  for (int tt = 0; tt < 2; ++tt) o[tp * 2 + tt] = __builtin_amdgcn_mfma_f32_16x16x32_bf16(aQ[tt][ks], sB[ks], o[tp * 2 + tt], 0, 0, 0);
              __builtin_amdgcn_sched_barrier(0); }
#pragma unroll
          for (int hf = 0; hf < 2; ++hf) { bf16x8 aK[4][2]; pg8::f32x4 e1v[4], e2v[4];
#pragma unroll
              for (int dd = 0; dd < 4; ++dd) { const int dt = hf * 4 + dd;
#pragma unroll
                  for (int ks = 0; ks < 2; ++ks) aK[dd][ks] = *LDSP(bf16x8, rB, HO_KT + dt * 2304 + ks * 64);
                  e1v[dd] = *LDSP(pg8::f32x4, pE, HO_E1 + dt * 64); e2v[dd] = *LDSP(pg8::f32x4, pE, HO_E2 + dt * 64); }
              if (hf == 0) {
#pragma unroll
                  for (int ti = 0; ti < 4; ++ti)
#pragma unroll
                      for (int rg = 0; rg < 4; ++rg) *LDSP(bf16, pO, HO_OS + ti * 4352 + rg * 272) = (bf16)f2bf(o[ti][rg]); }
              __builtin_amdgcn_sched_barrier(0);
              pg8::f32x4 u[4];
#pragma unroll
              for (int dd = 0; dd < 4; ++dd) u[dd] = (pg8::f32x4){0.f, 0.f, 0.f, 0.f};
#pragma unroll
              for (int ks = 0; ks < 2; ++ks)
#pragma unroll
                  for (int dd = 0; dd < 4; ++dd) u[dd] = __builtin_amdgcn_mfma_f32_16x16x32_bf16(aK[dd][ks], vB[ks], u[dd], 0, 0, 0);
#pragma unroll
              for (int dd = 0; dd < 4; ++dd) S[hf * 4 + dd] = S[hf * 4 + dd] * e1v[dd] + u[dd] * e2v[dd];
              __builtin_amdgcn_sched_barrier(0); } }
    }
    LDS_BAR();
    HG_FLUSH(nch - 1);
    LDS_BAR();
#undef HG_LOAD
#undef HG_FLUSH
}

typedef float f32x16 __attribute__((ext_vector_type(16)));
constexpr int H2_QS = 0, H2_KT = 17408, H2_VT = 35840, H2_AS = 54272, H2_E1 = 63488, H2_E2 = 64000, H2_E3 = 64512, H2_BUF = 65024, H2_KS = 2 * H2_BUF;
__device__ __forceinline__ int dperm16(int d) { return (d & ~15) | (((d >> 2) & 1) << 3) | (((d >> 3) & 1) << 2) | (d & 3); }
__device__ __forceinline__ void hgrn_item_ws(const Frame& F, const Args& a, int it) {
    unsigned char* ws = a.ws;
    int s0, T;
    if (it < 128) { s0 = M_P + (it >> 3) * T_S; T = T_S; } else { s0 = ((it - 128) >> 3) * T_P; T = T_P; }
    const int head = (it >> 1) & 3, dir = it & 1;
    const bf16* QH = (const bf16*)(ws + WS_QH); const bf16* G = (const bf16*)(ws + (dir ? WS_GB : WS_GF)); const bf16* IH = (const bf16*)(ws + WS_IH);
    bf16* O = (bf16*)a.out + (dir ? (size_t)M * 512 : 0);
    const int w = F.wave, nch = T / 64;
    const unsigned L0 = (unsigned)(uintptr_t)F.lds;
    const bf16* Gb = G + (size_t)s0 * 512 + head * 128; const bf16* Qb = QH + (size_t)s0 * 512 + head * 128; const bf16* Vb = IH + (size_t)s0 * 512 + head * 128;
    bf16* Ob = O + (size_t)s0 * 512 + head * 128;
    const int rstep = dir ? -512 : 512;
    const int pw = w & 3, cp = F.lane & 15, rq = F.lane >> 4, d0 = 32 * pw + 2 * cp, pd0 = dperm16(d0);
    const int r = F.lane & 15, q4 = F.lane >> 4, r32 = F.lane & 31, hi = F.lane >> 5;
    const bool prod = w >= 4;
    unsigned R0 = prod ? L0 + pd0 * 2 + rq * 4352 : L0 + (32 * w + r32) * 144 + hi * 16;
    unsigned R1 = prod ? L0 + d0 * 144 + rq * 32 : L0 + r32 * 144 + hi * 16;
    unsigned R2 = prod ? L0 + d0 * 4 : L0 + r32 * 272 + hi * 16;
    unsigned R3 = prod ? L0 + r * 272 + q4 * 16 + pw * 4352 : L0 + hi * 16;
    unsigned R4 = L0 + H2_KS + r * 272 + q4 * 16, R5 = L0 + q4 * 576 + r * 2 + pw * 2304;
    asm volatile("" : "+v"(R0), "+v"(R1), "+v"(R2), "+v"(R3), "+v"(R4), "+v"(R5));
#define pQ R0
#define cV R0
#define pK R1
#define cA R1
#define pE R2
#define cQ R2
#define rAc R3
#define cE R3
#define rKc R4
#define pAs R5
    const int roff0 = (dir ? (T - 1 - rq * 16) : rq * 16) * 512 + d0;
    typedef unsigned u32x16_ __attribute__((ext_vector_type(16)));
#define g2(i_) SU[0][i_]
#define q2(i_) SU[1][i_]
#define v2(i_) SU[2][i_]
    u32x16_ SU[4];
#pragma unroll
    for (int i = 0; i < 4; ++i)
#pragma unroll
        for (int k = 0; k < 16; ++k) SU[i][k] = 0u;
#define H2_LOAD(c) do { const int o0_ = roff0 + (c) * 64 * rstep; _Pragma("unroll") for (int ii = 0; ii < 16; ++ii) { const unsigned o_ = (unsigned)(o0_ + ii * rstep); \
        SU[0][ii] = *(const unsigned*)(Gb + o_); SU[1][ii] = *(const unsigned*)(Qb + o_); SU[2][ii] = *(const unsigned*)(Vb + o_); } } while (0)
#define H2_PROD_B(bo) do { \
        float ra = 0.f, rb = 0.f; \
        _Pragma("unroll") for (int ii = 0; ii < 16; ++ii) { ra += bflo(g2(ii)) * LOG2E; rb += bfhi(g2(ii)) * LOG2E; } \
        const float ta0 = __shfl(ra, cp), ta1 = __shfl(ra, 16 + cp), ta2 = __shfl(ra, 32 + cp), ta3 = __shfl(ra, 48 + cp); \
        const float tb0 = __shfl(rb, cp), tb1 = __shfl(rb, 16 + cp), tb2 = __shfl(rb, 32 + cp), tb3 = __shfl(rb, 48 + cp); \
        const float brefA = ta0 + ta1, brefB = tb0 + tb1, blastA = brefA + (ta2 + ta3), blastB = brefB + (tb2 + tb3); \
        const float offA = (rq == 0 ? 0.f : (rq == 1 ? ta0 : (rq == 2 ? ta0 + ta1 : ta0 + ta1 + ta2))) - brefA; \
        const float offB = (rq == 0 ? 0.f : (rq == 1 ? tb0 : (rq == 2 ? tb0 + tb1 : tb0 + tb1 + tb2))) - brefB; \
        unsigned ktA[8], ktB[8], vtA[8], vtB[8]; float kpa = 0.f, kpb = 0.f; \
        float xa = offA, xb = offB; \
        _Pragma("unroll") for (int ii = 0; ii < 16; ++ii) { xa += bflo(g2(ii)) * LOG2E; xb += bfhi(g2(ii)) * LOG2E; \
            const float fa = __builtin_amdgcn_exp2f(bflo(g2(ii)) * LOG2E), fb = __builtin_amdgcn_exp2f(bfhi(g2(ii)) * LOG2E); \
            const float qa = bflo(q2(ii)) * __builtin_amdgcn_exp2f(fminf(xa, 115.0f)), qb = bfhi(q2(ii)) * __builtin_amdgcn_exp2f(fminf(xb, 115.0f)); \
            const float ka = (1.0f - fa) * __builtin_amdgcn_exp2f(fminf(-xa, 115.0f)), kb = (1.0f - fb) * __builtin_amdgcn_exp2f(fminf(-xb, 115.0f)); \
            *LDSP(unsigned, pQ, (bo) + H2_QS + ii * 272) = pg8::cvt_pk_bf16(qa, qb); *LDSP(unsigned, pQ, H2_KS + ii * 272) = pg8::cvt_pk_bf16(ka, kb); \
            if (ii & 1) { ktA[ii >> 1] = pg8::cvt_pk_bf16(kpa, ka); ktB[ii >> 1] = pg8::cvt_pk_bf16(kpb, kb); vtA[ii >> 1] = (v2(ii - 1) & 0xffffu) | (v2(ii) << 16); vtB[ii >> 1] = (v2(ii - 1) >> 16) | (v2(ii) & 0xffff0000u); } \
            else { kpa = ka; kpb = kb; } } \
        *LDSP(v4u, pK, (bo) + H2_KT) = (v4u){ktA[0], ktA[1], ktA[2], ktA[3]}; *LDSP(v4u, pK, (bo) + H2_KT + 16) = (v4u){ktA[4], ktA[5], ktA[6], ktA[7]}; \
        *LDSP(v4u, pK, (bo) + H2_KT + 144) = (v4u){ktB[0], ktB[1], ktB[2], ktB[3]}; *LDSP(v4u, pK, (bo) + H2_KT + 160) = (v4u){ktB[4], ktB[5], ktB[6], ktB[7]}; \
        *LDSP(v4u, pK, (bo) + H2_VT) = (v4u){vtA[0], vtA[1], vtA[2], vtA[3]}; *LDSP(v4u, pK, (bo) + H2_VT + 16) = (v4u){vtA[4], vtA[5], vtA[6], vtA[7]}; \
        *LDSP(v4u, pK, (bo) + H2_VT + 144) = (v4u){vtB[0], vtB[1], vtB[2], vtB[3]}; *LDSP(v4u, pK, (bo) + H2_VT + 160) = (v4u){vtB[4], vtB[5], vtB[6], vtB[7]}; \
        if (rq == 0) { typedef float f32x2_ __attribute__((ext_vector_type(2))); \
            *LDSP(f32x2_, pE, (bo) + H2_E1) = (f32x2_){__builtin_amdgcn_exp2f(fminf(blastA, 115.0f)), __builtin_amdgcn_exp2f(fminf(blastB, 115.0f))}; \
            *LDSP(f32x2_, pE, (bo) + H2_E2) = (f32x2_){__builtin_amdgcn_exp2f(fminf(blastA - brefA, 115.0f)), __builtin_amdgcn_exp2f(fminf(blastB - brefB, 115.0f))}; \
            *LDSP(f32x2_, pE, (bo) + H2_E3) = (f32x2_){__builtin_amdgcn_exp2f(fminf(brefA, 115.0f)), __builtin_amdgcn_exp2f(fminf(brefB, 115.0f))}; } } while (0)
#define H2_PROD_A(bo) do { _Pragma("unroll") for (int tj = 0; tj < 4; ++tj) { pg8::f32x4 acc = (pg8::f32x4){0.f, 0.f, 0.f, 0.f}; \
        if (tj <= pw) { bf16x8 af[4], bfr[4]; \
            _Pragma("unroll") for (int ks = 0; ks < 4; ++ks) { af[ks] = *LDSP(bf16x8, rAc, (bo) + H2_QS + ks * 64); bfr[ks] = *LDSP(bf16x8, rKc, tj * 4352 + ks * 64); } \
            _Pragma("unroll") for (int ks = 0; ks < 4; ++ks) acc = __builtin_amdgcn_mfma_f32_16x16x32_bf16(af[ks], bfr[ks], acc, 0, 0, 0); } \
        _Pragma("unroll") for (int rg = 0; rg < 4; ++rg) { const int i_ = 16 * pw + 4 * q4 + rg, j_ = 16 * tj + r; *LDSP(bf16, pAs, (bo) + H2_AS + tj * 32 + rg * 144) = (bf16)f2bf(j_ <= i_ ? acc[rg] : 0.f); } } } while (0)
    if (prod) { H2_LOAD(0); H2_PROD_B(0); if (nch > 1) H2_LOAD(1); }
    LDS_BAR();
    if (prod) { H2_PROD_A(0); }
    LDS_BAR();
    for (int c = 0; c < nch; ++c) {
        const int bo = (c & 1) * H2_BUF, bn = H2_BUF - bo;
        if (prod) { if (c + 1 < nch) { H2_PROD_B(bn); if (c + 2 < nch) H2_LOAD(c + 2); } }
        else {
            bf16x8 sB[8];
#pragma unroll
            for (int dt = 0; dt < 4; ++dt) { pg8::f32x4 e[4]; const f32x16 Sd = __builtin_bit_cast(f32x16, SU[dt]);
#pragma unroll
                for (int g = 0; g < 4; ++g) e[g] = *LDSP(pg8::f32x4, cE, bo + H2_E3 + (32 * dt + 8 * g) * 4);
#pragma unroll
                for (int s = 0; s < 2; ++s) { v4u pw_;
                    pw_.x = pg8::cvt_pk_bf16(Sd[8 * s + 0] * e[2 * s][0], Sd[8 * s + 1] * e[2 * s][1]); pw_.y = pg8::cvt_pk_bf16(Sd[8 * s + 2] * e[2 * s][2], Sd[8 * s + 3] * e[2 * s][3]);
                    pw_.z = pg8::cvt_pk_bf16(Sd[8 * s + 4] * e[2 * s + 1][0], Sd[8 * s + 5] * e[2 * s + 1][1]); pw_.w = pg8::cvt_pk_bf16(Sd[8 * s + 6] * e[2 * s + 1][2], Sd[8 * s + 7] * e[2 * s + 1][3]);
                    sB[dt * 2 + s] = __builtin_bit_cast(bf16x8, pw_); } }
#pragma unroll
            for (int tt = 0; tt < 2; ++tt) { f32x16 o;
#pragma unroll
                for (int k = 0; k < 16; ++k) o[k] = 0.f;
                { bf16x8 aA[4], vB[4];
#pragma unroll
                  for (int ks = 0; ks < 4; ++ks) { vB[ks] = *LDSP(bf16x8, cV, bo + H2_VT + ks * 32); aA[ks] = *LDSP(bf16x8, cA, bo + H2_AS + tt * 4608 + ks * 32); }
#pragma unroll
                  for (int ks = 0; ks < 4; ++ks) o = __builtin_amdgcn_mfma_f32_32x32x16_bf16(vB[ks], aA[ks], o, 0, 0, 0); }
#pragma unroll
                for (int hf = 0; hf < 2; ++hf) { bf16x8 aQ[4];
#pragma unroll
                    for (int k4 = 0; k4 < 4; ++k4) aQ[k4] = *LDSP(bf16x8, cQ, bo + H2_QS + tt * 8704 + (hf * 4 + k4) * 32);
#pragma unroll
                    for (int k4 = 0; k4 < 4; ++k4) o = __builtin_amdgcn_mfma_f32_32x32x16_bf16(sB[hf * 4 + k4], aQ[k4], o, 0, 0, 0); }
                { const int tk = c * 64 + 32 * tt + r32; const int t_ = dir ? T - 1 - tk : tk; bf16* orow = Ob + (size_t)t_ * 512 + 32 * w + 4 * hi;
#pragma unroll
                  for (int g = 0; g < 4; ++g) { v2u w2; w2.x = pk2(o[4 * g + 0], o[4 * g + 1]); w2.y = pk2(o[4 * g + 2], o[4 * g + 3]); *(v2u*)(orow + 8 * g) = w2; } } }
        }
        LDS_BAR();
        if (prod) { if (c + 1 < nch) { H2_PROD_A(bn); } }
        else { bf16x8 vB[4];
#pragma unroll
            for (int ks = 0; ks < 4; ++ks) vB[ks] = *LDSP(bf16x8, cV, bo + H2_VT + ks * 32);
#pragma unroll
            for (int dt = 0; dt < 4; ++dt) { bf16x8 aK[4]; pg8::f32x4 e1v[4], e2v[4];
#pragma unroll
                for (int ks = 0; ks < 4; ++ks) aK[ks] = *LDSP(bf16x8, cA, bo + H2_KT + dt * 4608 + ks * 32);
#pragma unroll
                for (int g = 0; g < 4; ++g) { e1v[g] = *LDSP(pg8::f32x4, cE, bo + H2_E1 + (32 * dt + 8 * g) * 4); e2v[g] = *LDSP(pg8::f32x4, cE, bo + H2_E2 + (32 * dt + 8 * g) * 4); }
                f32x16 u;
#pragma unroll
                for (int k = 0; k < 16; ++k) u[k] = 0.f;
#pragma unroll
                for (int ks = 0; ks < 4; ++ks) u = __builtin_amdgcn_mfma_f32_32x32x16_bf16(aK[ks], vB[ks], u, 0, 0, 0);
                f32x16 Sd = __builtin_bit_cast(f32x16, SU[dt]);
#pragma unroll
                for (int k = 0; k < 16; ++k) Sd[k] = Sd[k] * e1v[k >> 2][k & 3] + u[k] * e2v[k >> 2][k & 3];
                SU[dt] = __builtin_bit_cast(u32x16_, Sd);
                __builtin_amdgcn_sched_barrier(0); }
        }
        LDS_BAR();
    }
#undef H2_LOAD
#undef H2_PROD_B
#undef H2_PROD_A
#undef pQ
#undef cV
#undef pK
#undef cA
#undef pE
#undef cQ
#undef rAc
#undef cE
#undef rKc
#undef pAs
#undef g2
#undef q2
#undef v2
}
__device__ __forceinline__ void attn_item_naive(const Frame& F, const Args& a, int ib) {
    unsigned char* ws = a.ws;
    const bf16* QA = (const bf16*)(ws + WS_QA); const bf16* KA = (const bf16*)(ws + WS_KA); const bf16* VT = (const bf16*)(ws + WS_VT); bf16* MIX = (bf16*)(ws + WS_MIX);
    const int tok = F.tid & 63, head = F.tid >> 6, kvh = head >> 2, m = ib * 64 + tok;
    int s0, T; if (m < M_P) { T = T_P; s0 = m & ~(T_P - 1); } else { T = T_S; s0 = M_P + ((m - M_P) & ~(T_S - 1)); }
    const int t = m - s0;
    float q[64], o[64];
#pragma unroll
    for (int c = 0; c < 8; ++c) { const v4u w = *(const v4u*)(QA + qk_off(m, head, c >> 1, c & 1));
        q[c * 8 + 0] = bflo(w.x); q[c * 8 + 1] = bfhi(w.x); q[c * 8 + 2] = bflo(w.y); q[c * 8 + 3] = bfhi(w.y); q[c * 8 + 4] = bflo(w.z); q[c * 8 + 5] = bfhi(w.z); q[c * 8 + 6] = bflo(w.w); q[c * 8 + 7] = bfhi(w.w); }
#pragma unroll
    for (int d = 0; d < 64; ++d) o[d] = 0.f;
    float mx = a.in[7][head] * LOG2E, l = 1.0f;
    const float slope2 = __builtin_amdgcn_exp2f(-(float)(head + 1)) * LOG2E;
    const int lo = t - 128 < 0 ? 0 : t - 128, hi = t + 128 > T - 1 ? T - 1 : t + 128;
    for (int s = lo; s <= hi; ++s) {
        const int ms = s0 + s; float dot = 0.f;
#pragma unroll
        for (int c = 0; c < 8; ++c) { const v4u w = *(const v4u*)(KA + qk_off(ms, kvh, c >> 1, c & 1));
            dot += q[c * 8 + 0] * bflo(w.x) + q[c * 8 + 1] * bfhi(w.x) + q[c * 8 + 2] * bflo(w.y) + q[c * 8 + 3] * bfhi(w.y) + q[c * 8 + 4] * bflo(w.z) + q[c * 8 + 5] * bfhi(w.z) + q[c * 8 + 6] * bflo(w.w) + q[c * 8 + 7] * bfhi(w.w); }
        const int rel = s - t; const float lg = dot - slope2 * (float)(rel < 0 ? -rel : rel);
        const float mn = fmaxf(mx, lg), corr = __builtin_amdgcn_exp2f(mx - mn), p = __builtin_amdgcn_exp2f(lg - mn);
        l = l * corr + p; mx = mn;
        const bf16* vp = VT + vt_off(ms, kvh, 0);
#pragma unroll
        for (int d = 0; d < 64; ++d) o[d] = o[d] * corr + p * bf2f(vp[d * 16]);
    }
    const float inv = 1.0f / l; float ss = 0.f;
#pragma unroll
    for (int d = 0; d < 64; ++d) { o[d] *= inv; ss += o[d] * o[d]; }
    LAS float* red = (LAS float*)F.lds;
    red[head * 64 + tok] = ss;
    __syncthreads();
    float tot = 0.f;
#pragma unroll
    for (int h = 0; h < 8; ++h) tot += red[h * 64 + tok];
    const float rstd = 1.0f / sqrtf(tot * (1.0f / 512.0f) + EPS);
    const float* ng = a.in[8] + head * 64;
#pragma unroll
    for (int c = 0; c < 8; ++c) { v4u w; w.x = pk2(o[c * 8 + 0] * rstd * ng[c * 8 + 0], o[c * 8 + 1] * rstd * ng[c * 8 + 1]); w.y = pk2(o[c * 8 + 2] * rstd * ng[c * 8 + 2], o[c * 8 + 3] * rstd * ng[c * 8 + 3]);
        w.z = pk2(o[c * 8 + 4] * rstd * ng[c * 8 + 4], o[c * 8 + 5] * rstd * ng[c * 8 + 5]); w.w = pk2(o[c * 8 + 6] * rstd * ng[c * 8 + 6], o[c * 8 + 7] * rstd * ng[c * 8 + 7]);
        *(v4u*)(MIX + (size_t)m * D + head * 64 + c * 8) = w; }
    __syncthreads();
}

typedef float f32x16 __attribute__((ext_vector_type(16)));
__device__ __forceinline__ void attn_item_mfma(const Frame& F, const Args& a, int ib) {
    unsigned char* ws = a.ws;
    const bf16* QA = (const bf16*)(ws + WS_QA); const bf16* KA = (const bf16*)(ws + WS_KA); const bf16* VT = (const bf16*)(ws + WS_VT); bf16* MIX = (bf16*)(ws + WS_MIX);
    const int head = F.wave, kvh = head >> 2, r32 = F.lane & 31, hi = F.lane >> 5, m0 = ib * 32;
    int s0, T; if (m0 < M_P) { T = T_P; s0 = m0 & ~(T_P - 1); } else { T = T_S; s0 = M_P + ((m0 - M_P) & ~(T_S - 1)); }
    const int t0 = m0 - s0;
    const bf16* qb = QA + (((size_t)head * NT32 + ib) * 4) * 512 + r32 * 16 + hi * 8;
    bf16x8 qr[4];
#pragma unroll
    for (int d0 = 0; d0 < 4; ++d0) qr[d0] = *(const bf16x8*)(qb + d0 * 512);
    f32x16 o0, o1;
#pragma unroll
    for (int r = 0; r < 16; ++r) { o0[r] = 0.f; o1[r] = 0.f; }
    float mrun = a.in[7][head] * LOG2E, l = hi == 0 ? 1.0f : 0.0f;
    const float slope2 = __builtin_amdgcn_exp2f(-(float)(head + 1)) * LOG2E;
    const int i_lo = t0 >= 128 ? 0 : (128 - t0) >> 5; int i_hi = (T - t0 + 96) >> 5; i_hi = i_hi > 8 ? 8 : i_hi;
    for (int i = i_lo; i <= i_hi; ++i) {
        const int kt = ib - 4 + i;
        const bf16* kb = KA + (((size_t)kvh * NT32 + kt) * 4) * 512 + r32 * 16 + hi * 8;
        f32x16 s;
#pragma unroll
        for (int r = 0; r < 16; ++r) s[r] = 0.f;
#pragma unroll
        for (int d0 = 0; d0 < 4; ++d0) { const bf16x8 kf = *(const bf16x8*)(kb + d0 * 512); s = __builtin_amdgcn_mfma_f32_32x32x16_bf16(kf, qr[d0], s, 0, 0, 0); }
        const int relb = 32 * (i - 4) - r32 + 4 * hi;
        float mx = -1e30f;
#pragma unroll
        for (int r = 0; r < 16; ++r) { const int rel = relb + (r & 3) + 8 * (r >> 2); const int ar = rel < 0 ? -rel : rel; float lg = s[r] - slope2 * (float)ar; lg = ar <= 128 ? lg : -1e30f; s[r] = lg; mx = fmaxf(mx, lg); }
        mx = fmaxf(mx, __shfl_xor(mx, 32));
        const float mnew = fmaxf(mrun, mx), corr = __builtin_amdgcn_exp2f(mrun - mnew); mrun = mnew;
        float ps = 0.f;
#pragma unroll
        for (int r = 0; r < 16; ++r) { s[r] = __builtin_amdgcn_exp2f(s[r] - mnew); ps += s[r]; }
        l = l * corr + ps;
#pragma unroll
        for (int r = 0; r < 16; ++r) { o0[r] *= corr; o1[r] *= corr; }
#pragma unroll
        for (int ks = 0; ks < 2; ++ks) {
            v4u pw; pw.x = pg8::cvt_pk_bf16(s[8 * ks + 0], s[8 * ks + 1]); pw.y = pg8::cvt_pk_bf16(s[8 * ks + 2], s[8 * ks + 3]); pw.z = pg8::cvt_pk_bf16(s[8 * ks + 4], s[8 * ks + 5]); pw.w = pg8::cvt_pk_bf16(s[8 * ks + 6], s[8 * ks + 7]);
            const bf16x8 pb = __builtin_bit_cast(bf16x8, pw);
            const bf16* vb = VT + (((size_t)kvh * NT16 + kt * 2 + ks) * 64 + r32) * 16 + hi * 8;
            const bf16x8 v0 = *(const bf16x8*)(vb), v1 = *(const bf16x8*)(vb + 32 * 16);
            o0 = __builtin_amdgcn_mfma_f32_32x32x16_bf16(v0, pb, o0, 0, 0, 0);
            o1 = __builtin_amdgcn_mfma_f32_32x32x16_bf16(v1, pb, o1, 0, 0, 0);
        }
    }
    l += __shfl_xor(l, 32);
    const float inv = 1.0f / l; float ss = 0.f;
#pragma unroll
    for (int r = 0; r < 16; ++r) { o0[r] *= inv; o1[r] *= inv; ss += o0[r] * o0[r] + o1[r] * o1[r]; }
    ss += __shfl_xor(ss, 32);
    LAS float* red = (LAS float*)F.lds;
    if (hi == 0) red[head * 32 + r32] = ss;
    __syncthreads();
    float tot = 0.f;
#pragma unroll
    for (int h = 0; h < 8; ++h) tot += red[h * 32 + r32];
    const float rstd = 1.0f / sqrtf(tot * (1.0f / 512.0f) + EPS);
    const float* ng = a.in[8] + head * 64 + 4 * hi;
    bf16* orow = MIX + (size_t)(m0 + r32) * D + head * 64 + 4 * hi;
#pragma unroll
    for (int g = 0; g < 4; ++g) {
        const f32x4 g0 = *(const f32x4*)(ng + 8 * g), g1 = *(const f32x4*)(ng + 32 + 8 * g);
        v2u w0, w1; w0.x = pk2(o0[4 * g + 0] * rstd * g0.x, o0[4 * g + 1] * rstd * g0.y); w0.y = pk2(o0[4 * g + 2] * rstd * g0.z, o0[4 * g + 3] * rstd * g0.w);
        w1.x = pk2(o1[4 * g + 0] * rstd * g1.x, o1[4 * g + 1] * rstd * g1.y); w1.y = pk2(o1[4 * g + 2] * rstd * g1.z, o1[4 * g + 3] * rstd * g1.w);
        *(v2u*)(orow + 8 * g) = w0; *(v2u*)(orow + 32 + 8 * g) = w1;
    }
    __syncthreads();
}

__device__ __forceinline__ void attn_qblock(const bf16x8 (&kf)[4], const bf16x8 (&vf)[4], const bf16x8 (&qr)[4], int dtile, int dl, float slope2, const float (&cs)[16], f32x16& o0, f32x16& o1, float& mrun, float& l) {
    f32x16 s; const float dlf = (float)dl;
    if (dtile < 0) { const float base = slope2 * ((float)(32 * dtile) + dlf);
#pragma unroll
        for (int r = 0; r < 16; ++r) s[r] = base + cs[r]; }
    else if (dtile > 0) { const float base = -slope2 * ((float)(32 * dtile) + dlf);
#pragma unroll
        for (int r = 0; r < 16; ++r) s[r] = base - cs[r]; }
    else { const float base = slope2 * dlf;
#pragma unroll
        for (int r = 0; r < 16; ++r) s[r] = -__builtin_fabsf(base + cs[r]); }
#pragma unroll
    for (int d0 = 0; d0 < 4; ++d0) s = __builtin_amdgcn_mfma_f32_32x32x16_bf16(kf[d0], qr[d0], s, 0, 0, 0);
    if (dtile == -4) {
#pragma unroll
        for (int r = 0; r < 16; ++r) s[r] = ((r & 3) + 8 * (r >> 2) + dl >= 0) ? s[r] : -1e30f; }
    if (dtile == 4) {
#pragma unroll
        for (int r = 0; r < 16; ++r) s[r] = ((r & 3) + 8 * (r >> 2) + dl <= 0) ? s[r] : -1e30f; }
    float mx = __builtin_fmaxf(__builtin_fmaxf(s[0], s[1]), s[2]);
#pragma unroll
    for (int r = 3; r < 15; r += 2) mx = __builtin_fmaxf(__builtin_fmaxf(mx, s[r]), s[r + 1]);
    mx = __builtin_fmaxf(mx, s[15]);
    mx = __builtin_fmaxf(mx, __shfl_xor(mx, 32));
    if (__builtin_amdgcn_ballot_w64(mx > mrun) != 0ull) {
        const float mnew = __builtin_fmaxf(mrun, mx), corr = __builtin_amdgcn_exp2f(mrun - mnew); mrun = mnew; l *= corr;
#pragma unroll
        for (int r = 0; r < 16; ++r) { o0[r] *= corr; o1[r] *= corr; } }
    float ps = 0.f;
#pragma unroll
    for (int r = 0; r < 16; ++r) { s[r] = __builtin_amdgcn_exp2f(s[r] - mrun); ps += s[r]; }
    l += ps;
#pragma unroll
    for (int ks = 0; ks < 2; ++ks) {
        v4u pw; pw.x = pg8::cvt_pk_bf16(s[8 * ks + 0], s[8 * ks + 1]); pw.y = pg8::cvt_pk_bf16(s[8 * ks + 2], s[8 * ks + 3]); pw.z = pg8::cvt_pk_bf16(s[8 * ks + 4], s[8 * ks + 5]); pw.w = pg8::cvt_pk_bf16(s[8 * ks + 6], s[8 * ks + 7]);
        const bf16x8 pb = __builtin_bit_cast(bf16x8, pw);
        o0 = __builtin_amdgcn_mfma_f32_32x32x16_bf16(vf[ks * 2 + 0], pb, o0, 0, 0, 0);
        o1 = __builtin_amdgcn_mfma_f32_32x32x16_bf16(vf[ks * 2 + 1], pb, o1, 0, 0, 0);
    }
}
__device__ __forceinline__ void attn_item_mfma2(const Frame& F, const Args& a, int ib) {
    unsigned char* ws = a.ws;
    const bf16* QA = (const bf16*)(ws + WS_QA); const bf16* KA = (const bf16*)(ws + WS_KA); const bf16* VT = (const bf16*)(ws + WS_VT); bf16* MIX = (bf16*)(ws + WS_MIX);
    const int head = F.wave, kvh = head >> 2, r32 = F.lane & 31, hi = F.lane >> 5, m0 = ib * 64;
    int s0, T; if (m0 < M_P) { T = T_P; s0 = m0 & ~(T_P - 1); } else { T = T_S; s0 = M_P + ((m0 - M_P) & ~(T_S - 1)); }
    const int t0 = m0 - s0;
    const int lofs = r32 * 16 + hi * 8;
    bf16x8 qa[4], qb[4];
    { const bf16* q0 = QA + (((size_t)head * NT32 + 2 * ib) * 4) * 512 + lofs;
#pragma unroll
      for (int d0 = 0; d0 < 4; ++d0) { qa[d0] = *(const bf16x8*)(q0 + d0 * 512); qb[d0] = *(const bf16x8*)(q0 + 2048 + d0 * 512); } }
    f32x16 oa0, oa1, ob0, ob1;
#pragma unroll
    for (int r = 0; r < 16; ++r) { oa0[r] = 0.f; oa1[r] = 0.f; ob0[r] = 0.f; ob1[r] = 0.f; }
    const float sink2 = a.in[7][head] * LOG2E;
    float ma = sink2, mb = sink2, la = hi == 0 ? 1.0f : 0.0f, lb = la;
    const float slope2 = __builtin_amdgcn_exp2f(-(float)(head + 1)) * LOG2E;
    const int i_lo = t0 >= 128 ? 0 : (128 - t0) >> 5; int i_hi = (T - t0 + 96) >> 5; i_hi = i_hi > 9 ? 9 : i_hi;
    const bf16* kbase = KA + (((size_t)kvh * NT32 + (2 * ib - 4)) * 4) * 512 + lofs;
    const bf16* vbase = VT + (((size_t)kvh * NT16 + (size_t)(2 * ib - 4) * 2) * 64) * 16 + lofs;
    bf16x8 kf[4], vf[4];
    LAS unsigned char* ring = F.lds + F.wave * 16384;
#define AT_DMA(slot_, i_) do { const bf16* kp_ = kbase + (ptrdiff_t)(i_) * 2048; const bf16* vp_ = vbase + (ptrdiff_t)(i_) * 2048; \
        _Pragma("unroll") for (int d0 = 0; d0 < 4; ++d0) { \
            __builtin_amdgcn_global_load_lds((const unsigned*)(kp_ + d0 * 512), (LAS unsigned*)(ring + (slot_) * 8192 + d0 * 1024), 16, 0, 0); \
            __builtin_amdgcn_global_load_lds((const unsigned*)(vp_ + d0 * 512), (LAS unsigned*)(ring + (slot_) * 8192 + 4096 + d0 * 1024), 16, 0, 0); } } while (0)
    AT_DMA(0, i_lo);
    if (i_lo + 1 <= i_hi) AT_DMA(1, i_lo + 1);
    const int relq = -r32 + 4 * hi;
    float cs[16];
#pragma unroll
    for (int r = 0; r < 16; ++r) cs[r] = slope2 * (float)((r & 3) + 8 * (r >> 2));
    for (int i = i_lo; i <= i_hi; ++i) {
        const int sl = (i - i_lo) & 1;
        if (i < i_hi) asm volatile("s_waitcnt vmcnt(8)" ::: "memory"); else asm volatile("s_waitcnt vmcnt(0)" ::: "memory");
        { const LAS unsigned char* sp = ring + sl * 8192 + F.lane * 16;
#pragma unroll
          for (int d0 = 0; d0 < 4; ++d0) { kf[d0] = *(const LAS bf16x8*)(sp + d0 * 1024); vf[d0] = *(const LAS bf16x8*)(sp + 4096 + d0 * 1024); } }
        asm volatile("s_waitcnt lgkmcnt(0)" ::: "memory");
        if (i + 2 <= i_hi) AT_DMA(sl, i + 2);
        if (i <= 8) attn_qblock(kf, vf, qa, i - 4, relq, slope2, cs, oa0, oa1, ma, la);
        if (i >= 1) attn_qblock(kf, vf, qb, i - 5, relq, slope2, cs, ob0, ob1, mb, lb);
    }
#undef AT_DMA
    la += __shfl_xor(la, 32); lb += __shfl_xor(lb, 32);
    const float ia = 1.0f / la, ibv = 1.0f / lb; float ssa = 0.f, ssb = 0.f;
#pragma unroll
    for (int r = 0; r < 16; ++r) { oa0[r] *= ia; oa1[r] *= ia; ob0[r] *= ibv; ob1[r] *= ibv; ssa += oa0[r] * oa0[r] + oa1[r] * oa1[r]; ssb += ob0[r] * ob0[r] + ob1[r] * ob1[r]; }
    ssa += __shfl_xor(ssa, 32); ssb += __shfl_xor(ssb, 32);
    LAS float* red = (LAS float*)(F.lds + 131072);
    if (hi == 0) { red[head * 64 + r32] = ssa; red[head * 64 + 32 + r32] = ssb; }
    __syncthreads();
    float ta = 0.f, tb = 0.f;
#pragma unroll
    for (int h = 0; h < 8; ++h) { ta += red[h * 64 + r32]; tb += red[h * 64 + 32 + r32]; }
    const float ra = 1.0f / sqrtf(ta * (1.0f / 512.0f) + EPS), rb = 1.0f / sqrtf(tb * (1.0f / 512.0f) + EPS);
    const float* ng = a.in[8] + head * 64 + 4 * hi;
    bf16* orow = MIX + (size_t)(m0 + r32) * D + head * 64 + 4 * hi;
#pragma unroll
    for (int g = 0; g < 4; ++g) {
        const f32x4 g0 = *(const f32x4*)(ng + 8 * g), g1 = *(const f32x4*)(ng + 32 + 8 * g);
        v2u w0, w1; w0.x = pk2(oa0[4 * g + 0] * ra * g0.x, oa0[4 * g + 1] * ra * g0.y); w0.y = pk2(oa0[4 * g + 2] * ra * g0.z, oa0[4 * g + 3] * ra * g0.w);
        w1.x = pk2(oa1[4 * g + 0] * ra * g1.x, oa1[4 * g + 1] * ra * g1.y); w1.y = pk2(oa1[4 * g + 2] * ra * g1.z, oa1[4 * g + 3] * ra * g1.w);
        *(v2u*)(orow + 8 * g) = w0; *(v2u*)(orow + 32 + 8 * g) = w1;
        w0.x = pk2(ob0[4 * g + 0] * rb * g0.x, ob0[4 * g + 1] * rb * g0.y); w0.y = pk2(ob0[4 * g + 2] * rb * g0.z, ob0[4 * g + 3] * rb * g0.w);
        w1.x = pk2(ob1[4 * g + 0] * rb * g1.x, ob1[4 * g + 1] * rb * g1.y); w1.y = pk2(ob1[4 * g + 2] * rb * g1.z, ob1[4 * g + 3] * rb * g1.w);
        *(v2u*)(orow + 32 * D + 8 * g) = w0; *(v2u*)(orow + 32 * D + 32 + 8 * g) = w1;
    }
    __syncthreads();
}
__device__ __forceinline__ void hg_finalize(const Frame& F, const Args& a) {
    unsigned char* ws = a.ws;
    const bf16* OF = (const bf16*)a.out; const bf16* OB = OF + (size_t)M * 512; const bf16* GH = (const bf16*)(ws + WS_GH); bf16* MIX = (bf16*)(ws + WS_MIX);
    const int gw = F.bid * NWAVES + F.wave, NGW = F.G * NWAVES;
    float ng[8];
#pragma unroll
    for (int i = 0; i < 8; ++i) ng[i] = a.in[11][F.lane * 8 + i];
    for (int m2 = gw * 2; m2 < M; m2 += NGW * 2) {
        v4u wf[2], wb[2], wg[2];
#pragma unroll
        for (int rr = 0; rr < 2; ++rr) { const size_t idx = (size_t)(m2 + rr) * 512 + F.lane * 8; wf[rr] = __builtin_nontemporal_load((const v4u*)(OF + idx)); wb[rr] = __builtin_nontemporal_load((const v4u*)(OB + idx)); wg[rr] = __builtin_nontemporal_load((const v4u*)(GH + idx)); }
#pragma unroll
        for (int rr = 0; rr < 2; ++rr) {
            float o[8], gt[8];
            o[0] = bflo(wf[rr].x) + bflo(wb[rr].x); o[1] = bfhi(wf[rr].x) + bfhi(wb[rr].x); o[2] = bflo(wf[rr].y) + bflo(wb[rr].y); o[3] = bfhi(wf[rr].y) + bfhi(wb[rr].y);
            o[4] = bflo(wf[rr].z) + bflo(wb[rr].z); o[5] = bfhi(wf[rr].z) + bfhi(wb[rr].z); o[6] = bflo(wf[rr].w) + bflo(wb[rr].w); o[7] = bfhi(wf[rr].w) + bfhi(wb[rr].w);
            gt[0] = bflo(wg[rr].x); gt[1] = bfhi(wg[rr].x); gt[2] = bflo(wg[rr].y); gt[3] = bfhi(wg[rr].y); gt[4] = bflo(wg[rr].z); gt[5] = bfhi(wg[rr].z); gt[6] = bflo(wg[rr].w); gt[7] = bfhi(wg[rr].w);
            float ss = 0.f;
#pragma unroll
            for (int i = 0; i < 8; ++i) ss += o[i] * o[i];
            ss += __shfl_xor(ss, 1); ss += __shfl_xor(ss, 2); ss += __shfl_xor(ss, 4); ss += __shfl_xor(ss, 8);
            const float rstd = 1.0f / sqrtf(ss * (1.0f / 128.0f) + EPS);
            float y[8];
#pragma unroll
            for (int i = 0; i < 8; ++i) y[i] = o[i] * rstd * ng[i] * silu_f(gt[i]);
            v4u w; w.x = pk2(y[0], y[1]); w.y = pk2(y[2], y[3]); w.z = pk2(y[4], y[5]); w.w = pk2(y[6], y[7]);
            *(v4u*)(MIX + (size_t)(m2 + rr) * D + 512 + F.lane * 8) = w; }
    }
}

#define XB_TMO      128
#define XB_XCNT(j)  (256  + 64 * (j))
#define XB_XSUB(j)  (1280 + 64 * (j))
#define XB_XGEN(j)  (2304 + 64 * (j))
#define XB_TOP      3328
#define XB_TOPGEN   3392
#define XCD_BAR_WORDS 3456
#define XB_SPIN_CAP (1u << 18)

__device__ __forceinline__ unsigned xb_ld(unsigned* p)              { return __hip_atomic_load(p, __ATOMIC_RELAXED, __HIP_MEMORY_SCOPE_AGENT); }
__device__ __forceinline__ unsigned xb_add(unsigned* p, unsigned v) { return __hip_atomic_fetch_add(p, v, __ATOMIC_RELAXED, __HIP_MEMORY_SCOPE_AGENT); }
__device__ __forceinline__ unsigned xb_xcc_id() { return (unsigned)__builtin_amdgcn_s_getreg((3 << 11) | 20) & 0xFu; }
#define XB_SPIN(cond, bar) do { unsigned _sp = 0; while (cond) { __builtin_amdgcn_s_sleep(1); \
    if ((++_sp & 255u) == 0u) { if (xb_ld(&(bar)[XB_TMO])) break; if (_sp > XB_SPIN_CAP) { atomicAdd(&(bar)[XB_TMO], 1u); break; } } } } while (0)

struct XcdBarrier {
    unsigned* bar; unsigned x;
    volatile LAS unsigned* st;
};

__device__ __forceinline__ XcdBarrier xcd_barrier_post(unsigned* bar, volatile LAS unsigned* st) {
    XcdBarrier b; b.bar = bar; b.x = xb_xcc_id(); b.st = st;
    if (threadIdx.x == 0) (void)xb_add(&bar[XB_XCNT(b.x)], 1u);
    return b;
}
__device__ __forceinline__ void xcd_barrier_complete(unsigned* bar, unsigned x, unsigned& nloc, unsigned& nx) {
    const unsigned G = gridDim.x * gridDim.y * gridDim.z;
    unsigned sum, cnt, mine, sp = 0u;
    for (;;) {
        sum = 0u; cnt = 0u; mine = 0u;
#pragma unroll
        for (unsigned j = 0; j < 16; ++j) { const unsigned c = xb_ld(&bar[XB_XCNT(j)]); sum += c; cnt += (c > 0u) ? 1u : 0u; mine = (j == x) ? c : mine; }
        if (sum == G) break;
        __builtin_amdgcn_s_sleep(1);
        if ((++sp & 255u) == 0u) { if (xb_ld(&bar[XB_TMO])) break; if (sp > XB_SPIN_CAP) { atomicAdd(&bar[XB_TMO], 1u); break; } }
    }
    nloc = mine > 0u ? mine : 1u; nx = cnt > 0u ? cnt : 1u;
}

__device__ __forceinline__ void xcd_barrier(const XcdBarrier& b) {
    asm volatile("s_waitcnt vmcnt(0)" ::: "memory");
    __syncthreads();
    if (threadIdx.x == 0) {
        unsigned* bar = b.bar;
        __builtin_amdgcn_s_waitcnt(0);
        unsigned nloc = b.st[0], nx = b.st[1];
        if (nloc == 0u) { xcd_barrier_complete(bar, b.x, nloc, nx); b.st[0] = nloc; b.st[1] = nx; }
        const unsigned old = xb_add(&bar[XB_XSUB(b.x)], 1u);
        const unsigned gen = old / nloc;
        if (old + 1u == (gen + 1u) * nloc) {
            __builtin_amdgcn_fence(__ATOMIC_RELEASE, "agent");
            asm volatile("s_waitcnt vmcnt(0)" ::: "memory");
            const unsigned og = xb_add(&bar[XB_TOP], 1u);
            const unsigned tg = og / nx;
            if (og + 1u == (tg + 1u) * nx) xb_add(&bar[XB_TOPGEN], 1u);
            else XB_SPIN(xb_ld(&bar[XB_TOPGEN]) == tg, bar);
            __builtin_amdgcn_fence(__ATOMIC_ACQUIRE, "agent");
            xb_add(&bar[XB_XGEN(b.x)], 1u);
            asm volatile("s_waitcnt vmcnt(0)" ::: "memory");
        } else {
            XB_SPIN(xb_ld(&bar[XB_XGEN(b.x)]) == gen, bar);
            __builtin_amdgcn_fence(__ATOMIC_ACQUIRE, "agent");
            asm volatile("s_waitcnt vmcnt(0)" ::: "memory");
        }
    }
    __syncthreads();
}

#ifndef PROBE_MASK
#define PROBE_MASK 0
#endif
#if PROBE_MASK
#define PSTAMP(k) do { const unsigned long long now_ = __builtin_amdgcn_s_memrealtime(); if ((PROBE_MASK >> (k)) & 1) tacc += now_ - tprev; tprev = now_; } while (0)
#else
#define PSTAMP(k) do {} while (0)
#endif
__global__ void __launch_bounds__(NWAVES * 64, 2) hymba_fwd(Args args) {
    extern __shared__ __attribute__((aligned(16))) unsigned char lds[];
    cg::grid_group grid = cg::this_grid();
    Frame F; F.lds = (LAS unsigned char*)lds; F.tid = threadIdx.x; F.lane = F.tid & 63; F.wave = __builtin_amdgcn_readfirstlane(F.tid >> 6); F.G = gridDim.x; F.bid = blockIdx.x;
    unsigned char* ws = args.ws;
    bf16* XB = (bf16*)(ws + WS_XB); bf16* HB = (bf16*)(ws + WS_H);
    const float* ln_g = args.in[2]; const float* ln_b = args.in[3];
    volatile LAS int* misc = (volatile LAS int*)(F.lds + MISC_OFF);
    bf16* VHI = (bf16*)(ws + WS_GH); bf16* VLO = (bf16*)(ws + WS_BIG);

#if PROBE_MASK
    unsigned long long tacc = 0, tprev = __builtin_amdgcn_s_memrealtime();
#endif
    if (F.tid < 2) misc[8 + F.tid] = 0;
    __syncthreads();
    XcdBarrier xbar = xcd_barrier_post((unsigned*)(ws + WS_BAR), (volatile LAS unsigned*)(misc + 8));
    if (args.ws == nullptr) grid.sync();
    p0_prologue(F, args, 0);
    PSTAMP(12);
    p0_prologue(F, args, 1);
    PSTAMP(13);
    xcd_barrier(xbar); PSTAMP(0);
#ifndef NO_P1
    { pg8::Gemm g{XB, (const bf16*)(ws + WS_W13A), M, 2 * FF, D}; pg8::StaticOrder S; S.init(M, 2 * FF, F.G, F.bid); pg8::EpiSwiGLU E{HB};
      pg8::gemm_phase<pg8::EpiSwiGLU, pg8::StaticOrder, false, PG8_SP2>(F.lds, g, S, E); }
#endif
    xcd_barrier(xbar); PSTAMP(1);
#ifndef NO_P2
    { pg8::Gemm g{HB, (const bf16*)(ws + WS_W2A), M, D, FF}; pg8::StaticOrder S; S.init(M, D, F.G, F.bid); pg8::EpiResB E{XB, VHI, ALPHA, 0.5f};
      pg8::gemm_phase<pg8::EpiResB, pg8::StaticOrder, PG8_ALIGN, PG8_SP2>(F.lds, g, S, E); }
#endif
    xcd_barrier(xbar); PSTAMP(2);
#ifndef NO_P3
    ln_phase(F, VHI, XB, nullptr, ln_g, ln_b);
#endif
    xcd_barrier(xbar); PSTAMP(3);
#ifndef NO_P4
    { pg8::Gemm g{XB, (const bf16*)(ws + WS_WIN), M, NIN, D}; pg8::StaticOrder S; S.init(M, NIN, F.G, F.bid);
      pg8::EpiIn E{ws, args.in[9], args.in[10]};
      pg8::gemm_phase<pg8::EpiIn, pg8::StaticOrder, PG8_ALIGN, PG8_SP2>(F.lds, g, S, E); }
#endif
    xcd_barrier(xbar); PSTAMP(4);
#ifndef NO_P5
#ifndef NO_P5H
    if (F.bid < 192) { Frame F1 = F; int t1 = threadIdx.x; asm volatile("" : "+v"(t1)); F1.tid = t1; F1.lane = t1 & 63; F1.wave = __builtin_amdgcn_readfirstlane(t1 >> 6); hgrn_item_ws(F1, args, F.bid); }
    PSTAMP(11);
#endif
#ifndef NO_P5A
    { unsigned* ctr = (unsigned*)(ws + WS_CTL); Frame F2 = F; int t2 = threadIdx.x; asm volatile("" : "+v"(t2)); F2.tid = t2; F2.lane = t2 & 63; F2.wave = __builtin_amdgcn_readfirstlane(t2 >> 6);
      constexpr int NIT = M / 64, PER = NIT / 8;
      for (int gg = 0; gg < 8; ++gg) { const int grp = (F.bid + gg) & 7; unsigned* cg_ = ctr + grp * 64;
          for (;;) { if (F2.tid == 0) misc[0] = (int)atomicAdd(cg_, 1u); __syncthreads(); const int k = misc[0]; __syncthreads(); if (k >= PER) break; attn_item_mfma2(F2, args, grp * PER + k); } }
      if (F.bid >= 128) p0_transposes(F2, args, true, (F.bid - 128) * NWAVES + F2.wave, 128 * NWAVES, TR_LATE); }
#endif
#endif
    xcd_barrier(xbar); PSTAMP(5);
#ifndef NO_P6
    hg_finalize(F, args);
#endif
    xcd_barrier(xbar); PSTAMP(6);
#ifndef NO_P7
    { pg8::Gemm g{(const bf16*)(ws + WS_MIX), (const bf16*)(ws + WS_WOUT), M, D, D}; pg8::StaticOrder S; S.init(M, D, F.G, F.bid); pg8::EpiResB E{XB, VLO, ALPHA, 1.0f};
      pg8::gemm_phase<pg8::EpiResB, pg8::StaticOrder, PG8_ALIGN, PG8_SP2>(F.lds, g, S, E); }
#endif
    xcd_barrier(xbar); PSTAMP(7);
#ifndef NO_P8
    ln_phase(F, VLO, XB, nullptr, ln_g + D, ln_b + D);
#endif
    xcd_barrier(xbar); PSTAMP(8);
#ifndef NO_P9
#ifdef COOL_TEST
    { const unsigned long long t0_ = __builtin_amdgcn_s_memrealtime(); while (__builtin_amdgcn_s_memrealtime() - t0_ < 100000ull) __builtin_amdgcn_s_sleep(32); PSTAMP(14); }
#endif
    { pg8::Gemm g{XB, (const bf16*)(ws + WS_W13B), M, 2 * FF, D}; pg8::StaticOrder S; S.init(M, 2 * FF, F.G, F.bid); pg8::EpiSwiGLU E{HB};
      pg8::gemm_phase<pg8::EpiSwiGLU, pg8::StaticOrder, false, PG8_SP2>(F.lds, g, S, E); }
#endif
    xcd_barrier(xbar); PSTAMP(9);
#ifndef NO_P10
    { pg8::Gemm g{HB, (const bf16*)(ws + WS_W2B), M, D, FF}; pg8::StaticOrder S; S.init(M, D, F.G, F.bid); pg8::EpiResB E{XB, VHI, ALPHA, 0.5f};
      pg8::gemm_phase<pg8::EpiResB, pg8::StaticOrder, PG8_ALIGN, PG8_SP2>(F.lds, g, S, E); }
#endif
    xcd_barrier(xbar); PSTAMP(10);
#ifndef NO_P11
#if PROBE_MASK
    if (F.bid == 0 && F.tid == 0) *(volatile unsigned long long*)(ws + WS_CTL + 3072) = tacc;
    grid.sync();
    { const unsigned long long dl = *(volatile unsigned long long*)(ws + WS_CTL + 3072); const unsigned long long t0_ = __builtin_amdgcn_s_memrealtime();
      while (__builtin_amdgcn_s_memrealtime() - t0_ < dl) __builtin_amdgcn_s_sleep(8); }
#endif
#ifdef SYNC_TEST
    for (int q_ = 0; q_ < 10; ++q_) grid.sync();
#endif
    ln_phase(F, VHI, nullptr, args.out, ln_g + 2 * D, ln_b + 2 * D);
#ifdef DUP_P11
    xcd_barrier(xbar);
    ln_phase(F, VHI, nullptr, args.out, ln_g + 2 * D, ln_b + 2 * D);
#endif
#endif
}

extern "C" void kernel_launch(void* const* d_in, const int* in_sizes, int n_in, void* d_out, int out_size, void* d_ws, size_t ws_size, hipStream_t stream) {
    static int grid = 0;
    if (grid == 0) {
        if (n_in != 13 || out_size != M * D || ws_size < WS_END) { fprintf(stderr, "kernel_launch: unexpected shapes n_in %d out %d ws %zu\n", n_in, out_size, ws_size); grid = -1; return; }
        int dev = 0, cus = 0, per_cu = 0;
        hipGetDevice(&dev); hipDeviceGetAttribute(&cus, hipDeviceAttributeMultiprocessorCount, dev);
        hipFuncSetAttribute((const void*)hymba_fwd, hipFuncAttributeMaxDynamicSharedMemorySize, LDS_BYTES);
        hipOccupancyMaxActiveBlocksPerMultiprocessor(&per_cu, (const void*)hymba_fwd, NWAVES * 64, LDS_BYTES);
        if (per_cu < 1) { fprintf(stderr, "kernel_launch: occupancy query %d\n", per_cu); per_cu = 1; }
        (void)hipGetLastError();
        grid = cus;
    }
    if (grid < 0) return;
    hipMemsetAsync((char*)d_ws + WS_CTL, 0, 4096 + 16384, stream);
    Args a{};
    for (int i = 0; i < 13; ++i) a.in[i] = (const float*)d_in[i];
    a.out = (float*)d_out; a.ws = (unsigned char*)d_ws;
    void* kargs[] = {&a};
    hipError_t e = hipLaunchCooperativeKernel((const void*)hymba_fwd, dim3(grid), dim3(NWAVES * 64), kargs, LDS_BYTES, stream);
    if (e != hipSuccess) fprintf(stderr, "cooperative launch failed: %s (grid %d)\n", hipGetErrorString(e), grid);
}
```

```cpp
#include <hip/hip_runtime.h>
#include <cstdio>
#include <cstdint>
namespace pg8 {
#define PG8_LAS __attribute__((address_space(3)))
typedef unsigned short bf16_t;
typedef short bf16x8 __attribute__((ext_vector_type(8)));
typedef float f32x4 __attribute__((ext_vector_type(4)));
typedef unsigned u32x4 __attribute__((ext_vector_type(4)));
constexpr int BM = 256, BK = 64, HALF = 128, HTB = HALF * BK * 2  , STAGE_BYTES = 8 * HTB, NXCD = 8, WGM = 8;

__host__ __device__ __forceinline__ int lds_byte(int r, int c) { const int st = (r >> 4) * 2 + (c >> 5), rr = r & 15, cc = c & 31, ob = rr * 64 + cc * 2; return st * 1024 + (ob ^ (((ob >> 9) & 1) << 5)); }
__host__ __device__ __forceinline__ void stage_rc(int b, int& R, int& C) { const int st = b / 1024, sb = b % 1024, swz = sb ^ (((sb >> 9) & 1) << 5); R = (st >> 1) * 16 + swz / 64; C = (st & 1) * 32 + (swz % 64) / 2; }
__host__ __device__ __forceinline__ int perm32(int rho) { const int n = rho >> 4, i = rho & 15; return 8 * (i >> 2) + 4 * n + (i & 3); }

struct Unit { int pm, pn; };
struct Gemm { const bf16_t* A; const bf16_t* Bt; int M, N, K; };

struct StaticOrder {
    int nM, nN, nwg, G, c;
    __host__ __device__ void init(int M, int N, int G_, int c_) { nM = M / BM; nN = N / BM; nwg = nM * nN; G = G_; c = c_; }
    __host__ __device__ bool next(int i, Unit& u) const {
        const long L = (long)i * G + c; if (L >= nwg) return false;
        int wgid = (int)L; { const int q = nwg / NXCD, r = nwg % NXCD, xcd = wgid % NXCD, off = wgid / NXCD; wgid = (xcd < r ? xcd * (q + 1) : r * (q + 1) + (xcd - r) * q) + off; }
        const int nig = WGM * nN, gid = wgid / nig, fm = gid * WGM, gsz = (nM - fm) < WGM ? (nM - fm) : WGM;
        u.pm = fm + ((wgid % nig) % gsz); u.pn = (wgid % nig) / gsz; return true;
    }
    __device__ __forceinline__ void a_ready(const Unit&) const {}
    __device__ __forceinline__ void done(const Unit&) const {}
};

__device__ __forceinline__ unsigned cvt_pk_bf16(float lo, float hi) { unsigned r; asm volatile("v_cvt_pk_bf16_f32 %0, %1, %2" : "=v"(r) : "v"(lo), "v"(hi)); return r; }
typedef float f32x2 __attribute__((ext_vector_type(2)));
__device__ __forceinline__ f32x2 gelu_pk(f32x2 v) {
    const f32x2 av = __builtin_elementwise_abs(v), d = av * 0.2316418882f + 1.0f;
    f32x2 t; t.x = __builtin_amdgcn_rcpf(d.x); t.y = __builtin_amdgcn_rcpf(d.y);
    f32x2 q = t * 0.5307027145f + (-0.7265760135f); q = q * t + 0.7107068705f; q = q * t + (-0.142248368f); q = q * t + 0.127414796f; q = q * t;
    const f32x2 s = (v * v) * (-0.72134752044f);
    f32x2 e; e.x = __builtin_amdgcn_exp2f(s.x); e.y = __builtin_amdgcn_exp2f(s.y);
    const f32x2 m = v * (q * e), r = v - m;
    f32x2 o; o.x = v.x < 0.f ? m.x : r.x; o.y = v.y < 0.f ? m.y : r.y; return o;
}

template <int ACT  > struct EpiBf16 {
    static constexpr bool PERM = true, AFTER_DRAIN = false, HAS_TAB = false; static_assert(ACT == 0 || ACT == 1, "EpiBf16: ACT is 0 (none) or 1 (gelu_pk)");
    bf16_t* O; int ldc; const float* bias; int split_cols; size_t split_stride; float scale0;
    __device__ __forceinline__ void operator()(const f32x4 (&acc)[2][2][4][2], const Unit& u, int wr, int wc, int fr, int fq) const {
        const int row0 = u.pm * BM + wr * 64 + fr; int colt = u.pn * BM; bf16_t* base = O;
        float sc = 1.f; if (split_cols) { const int t = colt / split_cols; base += (size_t)t * split_stride; colt -= t * split_cols; if (t == 0) sc = scale0; }
        const int col0 = colt + wc * 32 + 8 * fq, bcol0 = u.pn * BM + wc * 32 + 8 * fq;
        f32x4 bv[2][2];
#pragma unroll
        for (int bj = 0; bj < 2; ++bj)
#pragma unroll
            for (int n = 0; n < 2; ++n) bv[bj][n] = bias ? *(const f32x4*)(bias + bcol0 + bj * HALF + 4 * n) : (f32x4){0.f, 0.f, 0.f, 0.f};
#pragma unroll
        for (int ai = 0; ai < 2; ++ai)
#pragma unroll
            for (int m = 0; m < 4; ++m) { bf16_t* rowp = base + (size_t)(row0 + ai * HALF + m * 16) * ldc + col0;
#pragma unroll
                for (int bj = 0; bj < 2; ++bj) { f32x4 v0 = acc[ai][bj][m][0] + bv[bj][0], v1 = acc[ai][bj][m][1] + bv[bj][1];
                    if (ACT == 1) { f32x2 a = gelu_pk((f32x2){v0[0], v0[1]}), b = gelu_pk((f32x2){v0[2], v0[3]}), c = gelu_pk((f32x2){v1[0], v1[1]}), d = gelu_pk((f32x2){v1[2], v1[3]});
                        v0 = (f32x4){a.x, a.y, b.x, b.y}; v1 = (f32x4){c.x, c.y, d.x, d.y}; }
                    v0 = v0 * sc; v1 = v1 * sc; u32x4 w; w.x = cvt_pk_bf16(v0[0], v0[1]); w.y = cvt_pk_bf16(v0[2], v0[3]); w.z = cvt_pk_bf16(v1[0], v1[1]); w.w = cvt_pk_bf16(v1[2], v1[3]);
                    *(u32x4*)(rowp + bj * HALF) = w; } }
    }
};

struct PanelStats {
    unsigned* xbuf;
    unsigned* cnt;
    unsigned* tmo;
    int ntn; float eps;
    unsigned code;
    __device__ __forceinline__ bool run(const f32x4 (&v)[2][2][4][2], const Unit& u, int wr, int wc, int fr, int fq, PG8_LAS unsigned char* lds, int wid, int lane) const {
        typedef float f32x2v __attribute__((ext_vector_type(2)));
        PG8_LAS f32x2v* P = (PG8_LAS f32x2v*)lds;
        PG8_LAS f32x2v* S = (PG8_LAS f32x2v*)(lds + 8192);
        PG8_LAS unsigned* flag = (PG8_LAS unsigned*)(lds + 8192 + 2048);
#pragma unroll
        for (int ai = 0; ai < 2; ++ai)
#pragma unroll
            for (int m = 0; m < 4; ++m) {
                float s = 0.f;
#pragma unroll
                for (int bj = 0; bj < 2; ++bj)
#pragma unroll
                    for (int n = 0; n < 2; ++n) { const f32x4 x = v[ai][bj][m][n]; s += (x[0] + x[1]) + (x[2] + x[3]); }
                s += __shfl_xor(s, 16); s += __shfl_xor(s, 32);
                const float mw = s * (1.0f / 64.0f); float q = 0.f;
#pragma unroll
                for (int bj = 0; bj < 2; ++bj)
#pragma unroll
                    for (int n = 0; n < 2; ++n) { const f32x4 d = v[ai][bj][m][n] - mw; q += (d[0] * d[0] + d[1] * d[1]) + (d[2] * d[2] + d[3] * d[3]); }
                q += __shfl_xor(q, 16); q += __shfl_xor(q, 32);
                if (fq == 0) P[(ai * HALF + wr * 64 + m * 16 + fr) * 4 + wc] = (f32x2v){mw, q};
            }
        asm volatile("s_waitcnt lgkmcnt(0)" ::: "memory"); __builtin_amdgcn_s_barrier(); asm volatile("" ::: "memory");
#if defined(BROKEN_EXCHANGE_NO_WAIT)
#warning BROKEN CONTROL BUILD: the row-statistics exchange does not wait; results are wrong by design
        if (blockIdx.x >= 64) { const long long t0_ = clock64(); while (clock64() - t0_ < 60000) __builtin_amdgcn_s_sleep(8); }
#endif
        const int row = wid * 32 + (lane & 31);
        if (lane < 32) {
            const f32x2v a = P[row * 4 + 0], b = P[row * 4 + 1], c = P[row * 4 + 2], d = P[row * 4 + 3];
            const float mt = (a.x + b.x + c.x + d.x) * 0.25f;
            const float da = a.x - mt, db = b.x - mt, dc = c.x - mt, dd = d.x - mt;
            const float m2 = (a.y + b.y) + (c.y + d.y) + 64.0f * ((da * da + db * db) + (dc * dc + dd * dd));
            unsigned long long* slot = (unsigned long long*)xbuf + ((size_t)(u.pm * BM + row) * 4 + u.pn);
            __hip_atomic_store(slot, ((unsigned long long)__float_as_uint(m2) << 32) | __float_as_uint(mt), __ATOMIC_RELAXED, __HIP_MEMORY_SCOPE_AGENT);
        }
        asm volatile("s_waitcnt vmcnt(0)" ::: "memory");
        if (lane == 0) __hip_atomic_fetch_add(cnt + 64 * u.pm, 1u, __ATOMIC_RELAXED, __HIP_MEMORY_SCOPE_AGENT);
        if (wid == 0) {
            bool dead = false; const unsigned long long t0 = __builtin_amdgcn_s_memrealtime(); const unsigned want = 8u * (unsigned)ntn;
            for (;;) {
#if defined(BROKEN_EXCHANGE_NO_WAIT)
                break;
#endif
                if ((unsigned)__builtin_amdgcn_readfirstlane(__hip_atomic_load(cnt + 64 * u.pm, __ATOMIC_RELAXED, __HIP_MEMORY_SCOPE_AGENT)) >= want) break;
                if (__builtin_amdgcn_s_memrealtime() - t0 > 2000000ull) {
                    if (lane == 0) { unsigned expect = 0u; __hip_atomic_compare_exchange_strong(tmo + 1, &expect, code | (unsigned)(u.pm & 0xff), __ATOMIC_RELAXED, __ATOMIC_RELAXED, __HIP_MEMORY_SCOPE_AGENT);
                                     __hip_atomic_store(tmo, 1u, __ATOMIC_RELAXED, __HIP_MEMORY_SCOPE_AGENT); }
                    dead = true; break; }
                __builtin_amdgcn_s_sleep(2);
            }
            __builtin_amdgcn_fence(__ATOMIC_ACQUIRE, "agent");
            if (lane == 0) flag[0] = dead ? 1u : 0u;
        }
        asm volatile("s_waitcnt vmcnt(0) lgkmcnt(0)" ::: "memory"); __builtin_amdgcn_s_barrier(); asm volatile("" ::: "memory");
        const bool bad = flag[0] != 0u;
        if (lane < 32) {
            const unsigned long long* slot = (const unsigned long long*)xbuf + (size_t)(u.pm * BM + row) * 4; float mt[4], m2[4]; float ms = 0.f;
#pragma unroll
            for (int t = 0; t < 4; ++t) { if (t < ntn) { const unsigned long long w = __hip_atomic_load(slot + t, __ATOMIC_RELAXED, __HIP_MEMORY_SCOPE_AGENT); mt[t] = __uint_as_float((unsigned)w); m2[t] = __uint_as_float((unsigned)(w >> 32)); } else { mt[t] = 0.f; m2[t] = 0.f; } ms += mt[t]; }
            const float mean = ms / (float)ntn; float q = 0.f;
#pragma unroll
            for (int t = 0; t < 4; ++t) if (t < ntn) { const float dm = mt[t] - mean; q += m2[t] + 256.0f * dm * dm; }
            S[row] = (f32x2v){mean, 1.0f / sqrtf(q / (256.0f * (float)ntn) + eps)};
        }
        asm volatile("s_waitcnt lgkmcnt(0)" ::: "memory"); __builtin_amdgcn_s_barrier(); asm volatile("" ::: "memory");
        return bad;
    }
};
struct EpiLnRes {
    static constexpr bool PERM = false, AFTER_DRAIN = true, HAS_TAB = false;
    const float* base; float* out; int ldc; const float* bias; PanelStats st; unsigned poison;
    __device__ __forceinline__ void fused(f32x4 (&acc)[2][2][4][2], const Unit& u, int wr, int wc, int fr, int fq, PG8_LAS unsigned char* lds, int wid, int lane) const {
        typedef float f32x2v __attribute__((ext_vector_type(2)));
        const PG8_LAS f32x2v* S = (const PG8_LAS f32x2v*)(lds + 8192);
        const int col0 = u.pn * BM + wc * 32 + 4 * fq;
#pragma unroll
        for (int bj = 0; bj < 2; ++bj)
#pragma unroll
            for (int n = 0; n < 2; ++n) { const f32x4 bv = bias ? *(const f32x4*)(bias + col0 + bj * HALF + n * 16) : (f32x4){0.f, 0.f, 0.f, 0.f};
#pragma unroll
                for (int ai = 0; ai < 2; ++ai)
#pragma unroll
                    for (int m = 0; m < 4; ++m) acc[ai][bj][m][n] += bv; }
        f32x4 pre[4][2][2];
#pragma unroll
        for (int m = 0; m < 4; ++m) { const size_t off = (size_t)(u.pm * BM + wr * 64 + m * 16 + fr) * ldc + col0;
#pragma unroll
            for (int bj = 0; bj < 2; ++bj)
#pragma unroll
                for (int n = 0; n < 2; ++n) pre[m][bj][n] = *(const f32x4*)(base + off + bj * HALF + n * 16); }
        const bool bad = st.run(acc, u, wr, wc, fr, fq, lds, wid, lane) || poison != 0u;
        const float qnan = __builtin_nanf("");
#pragma unroll
        for (int ai = 0; ai < 2; ++ai)
#pragma unroll
            for (int m = 0; m < 4; ++m) { const int r = ai * HALF + wr * 64 + m * 16 + fr; const f32x2v sr = S[r]; const size_t off = (size_t)(u.pm * BM + r) * ldc + col0;
#pragma unroll
                for (int bj = 0; bj < 2; ++bj)
#pragma unroll
                    for (int n = 0; n < 2; ++n) { const f32x4 bs = ai == 0 ? pre[m][bj][n] : *(const f32x4*)(base + off + bj * HALF + n * 16); f32x4 o = bs + (acc[ai][bj][m][n] - sr.x) * sr.y;
                        if (bad) o = (f32x4){qnan, qnan, qnan, qnan}; *(f32x4*)(out + off + bj * HALF + n * 16) = o; }
                if (m & 1) asm volatile("" ::: "memory"); }
    }
};
struct EpiLnResLn {
    static constexpr bool PERM = false, AFTER_DRAIN = true, HAS_TAB = false;
    const float* base; float* out; bf16_t* xn; int ldc; const float* bias; PanelStats st1, st2; unsigned poison;
    __device__ __forceinline__ void fused(f32x4 (&acc)[2][2][4][2], const Unit& u, int wr, int wc, int fr, int fq, PG8_LAS unsigned char* lds, int wid, int lane) const {
        typedef float f32x2v __attribute__((ext_vector_type(2))); typedef unsigned u32x2v __attribute__((ext_vector_type(2)));
        const PG8_LAS f32x2v* S = (const PG8_LAS f32x2v*)(lds + 8192);
        const int col0 = u.pn * BM + wc * 32 + 4 * fq;
#pragma unroll
        for (int bj = 0; bj < 2; ++bj)
#pragma unroll
            for (int n = 0; n < 2; ++n) { const f32x4 bv = bias ? *(const f32x4*)(bias + col0 + bj * HALF + n * 16) : (f32x4){0.f, 0.f, 0.f, 0.f};
#pragma unroll
                for (int ai = 0; ai < 2; ++ai)
#pragma unroll
                    for (int m = 0; m < 4; ++m) acc[ai][bj][m][n] += bv; }
        bool bad = st1.run(acc, u, wr, wc, fr, fq, lds, wid, lane) || poison != 0u;
        const float qnan = __builtin_nanf("");
#pragma unroll
        for (int ai = 0; ai < 2; ++ai)
#pragma unroll
            for (int m = 0; m < 4; ++m) { const int r = ai * HALF + wr * 64 + m * 16 + fr; const f32x2v sr = S[r]; const size_t off = (size_t)(u.pm * BM + r) * ldc + col0;
#pragma unroll
                for (int bj = 0; bj < 2; ++bj)
#pragma unroll
                    for (int n = 0; n < 2; ++n) { const f32x4 bs = *(const f32x4*)(base + off + bj * HALF + n * 16); acc[ai][bj][m][n] = bs + (acc[ai][bj][m][n] - sr.x) * sr.y; }
                asm volatile("" : "+v"(acc[ai][0][m][0]), "+v"(acc[ai][0][m][1]), "+v"(acc[ai][1][m][0]), "+v"(acc[ai][1][m][1]));
                if (m & 1) asm volatile("" ::: "memory"); }
        const bool bad1 = bad;
        bad = st2.run(acc, u, wr, wc, fr, fq, lds, wid, lane) || bad;
#pragma unroll
        for (int ai = 0; ai < 2; ++ai)
#pragma unroll
            for (int m = 0; m < 4; ++m) { const int r = ai * HALF + wr * 64 + m * 16 + fr; const f32x2v sr = S[r]; const size_t off = (size_t)(u.pm * BM + r) * ldc + col0;
#pragma unroll
                for (int bj = 0; bj < 2; ++bj)
#pragma unroll
                    for (int n = 0; n < 2; ++n) { const f32x4 x1 = acc[ai][bj][m][n]; *(f32x4*)(out + off + bj * HALF + n * 16) = bad1 ? (f32x4){qnan, qnan, qnan, qnan} : x1;
                        const f32x4 o = (x1 - sr.x) * sr.y; u32x2v w; w.x = cvt_pk_bf16(o[0], o[1]); w.y = cvt_pk_bf16(o[2], o[3]);
                        if (bad) { w.x = 0x7fc07fc0u; w.y = 0x7fc07fc0u; } *(u32x2v*)(xn + off + bj * HALF + n * 16) = w; }
                asm volatile("" ::: "memory"); }
    }
};

template <class Epi, class Sched, bool ALIGN_EPI = false, bool SP2 = false>
__device__ __forceinline__ void gemm_phase(PG8_LAS unsigned char* lds, const Gemm g, const Sched& S, const Epi& E) {
    int tid_ = threadIdx.x; asm volatile("" : "+v"(tid_));
    const int tid = tid_, wid = __builtin_amdgcn_readfirstlane(tid >> 6), lane = tid & 63, wr = wid >> 2, wc = wid & 3, fr = lane & 15, fq = lane >> 4;
    const int K = g.K, nt = K / BK;
    unsigned voffA[2], voffB[2];
#pragma unroll
    for (int i = 0; i < 2; ++i) { int R, C; stage_rc(tid * 16 + i * 8192, R, C); const int Rb = Epi::PERM ? ((R & ~31) + perm32(R & 31)) : R;
        voffA[i] = (unsigned)(R * K + C) * 2u; voffB[i] = (unsigned)(Rb * K + C) * 2u; }
    const size_t kstep = (size_t)(BK * 2);
    const size_t hstep = (size_t)HALF * K * 2;
    const size_t tstep = 2 * hstep;
    const unsigned ldsw = (unsigned)wid * 1024u;
    const int aoff = lds_byte(wr * 64 + fr, fq * 8), boff = lds_byte(wc * 32 + fr, fq * 8);
#define PG8_SA(b, h) (((b) * 2 + (h)) * HTB)
#define PG8_SB(b, h) ((4 + (b) * 2 + (h)) * HTB)
#define PG8_STAGE(bufoff, gbase, voff) do { _Pragma("unroll") for (int _i = 0; _i < 2; ++_i) \
        __builtin_amdgcn_global_load_lds((const unsigned*)((const char*)(gbase) + (voff)[_i]), (PG8_LAS unsigned*)(lds + (bufoff) + ldsw + _i * 8192), 16, 0, 0); } while (0)
#define PG8_LDA(dst, b, h) do { _Pragma("unroll") for (int m = 0; m < 4; ++m) _Pragma("unroll") for (int k = 0; k < 2; ++k) dst[m][k] = *(const PG8_LAS bf16x8*)(lds + PG8_SA(b, h) + aoff + m * 2048 + k * 1024); } while (0)
#define PG8_LDB(dst, b, h) do { _Pragma("unroll") for (int n = 0; n < 2; ++n) _Pragma("unroll") for (int k = 0; k < 2; ++k) dst[n][k] = *(const PG8_LAS bf16x8*)(lds + PG8_SB(b, h) + boff + n * 2048 + k * 1024); } while (0)
#define PG8_MMA(ai, bj, At, Bt) do { __builtin_amdgcn_s_setprio(1); _Pragma("unroll") for (int m = 0; m < 4; ++m) _Pragma("unroll") for (int n = 0; n < 2; ++n) _Pragma("unroll") for (int k = 0; k < 2; ++k) \
        acc[ai][bj][m][n] = __builtin_amdgcn_mfma_f32_16x16x32_bf16(Bt[n][k], At[m][k], acc[ai][bj][m][n], 0, 0, 0); __builtin_amdgcn_s_setprio(0); } while (0)
#define PG8_WAIT_V(n) asm volatile("s_waitcnt vmcnt(" #n ")" ::: "memory")
#define PG8_WAIT_L(n) asm volatile("s_waitcnt lgkmcnt(" #n ")" ::: "memory")
#define PG8_BAR __builtin_amdgcn_s_barrier()
#define PG8_SCHED __builtin_amdgcn_sched_barrier(0)
    Unit cur, nxt; int ui = 0;
    if (!S.next(0, cur)) return;
    f32x4 acc[2][2][4][2];
#pragma unroll
    for (int a = 0; a < 2; ++a)
#pragma unroll
        for (int b = 0; b < 2; ++b)
#pragma unroll
            for (int m = 0; m < 4; ++m)
#pragma unroll
                for (int n = 0; n < 2; ++n) acc[a][b][m][n] = (f32x4){0.f, 0.f, 0.f, 0.f};
    bf16x8 At[4][2], B0[2][2], B1[2][2];
    const char* cA = (const char*)g.A + (size_t)cur.pm * tstep; const char* cB = (const char*)g.Bt + (size_t)cur.pn * tstep;
    S.a_ready(cur);
    if constexpr (Epi::HAS_TAB) { typename Epi::Pre pre0; E.tab_load(pre0, cur.pm); E.tab_store(pre0, 0); }
    if constexpr (SP2) {
        PG8_STAGE(PG8_SB(0, 0), cB, voffB); PG8_STAGE(PG8_SB(0, 1), cB + hstep, voffB); PG8_STAGE(PG8_SA(0, 0), cA, voffA); PG8_STAGE(PG8_SA(0, 1), cA + hstep, voffA);
        if (wr == 1) PG8_BAR;
        PG8_WAIT_V(2); PG8_BAR;
        PG8_STAGE(PG8_SB(1, 0), cB + kstep, voffB); PG8_STAGE(PG8_SA(1, 0), cA + kstep, voffA); PG8_STAGE(PG8_SB(1, 1), cB + hstep + kstep, voffB);
        PG8_WAIT_V(6); PG8_BAR;
    } else {
        PG8_STAGE(PG8_SB(0, 0), cB, voffB); PG8_STAGE(PG8_SA(0, 0), cA, voffA); PG8_STAGE(PG8_SB(0, 1), cB + hstep, voffB); PG8_STAGE(PG8_SA(0, 1), cA + hstep, voffA);
        if (wr == 1) PG8_BAR;
        PG8_WAIT_V(4); PG8_BAR;
        PG8_STAGE(PG8_SB(1, 0), cB + kstep, voffB); PG8_STAGE(PG8_SA(1, 0), cA + kstep, voffA); PG8_STAGE(PG8_SB(1, 1), cB + hstep + kstep, voffB);
        PG8_WAIT_V(6); PG8_BAR;
    }
    for (;;) {
        const bool has_next = S.next(ui + 1, nxt);
        const char* nA = has_next ? (const char*)g.A + (size_t)nxt.pm * tstep : cA; const char* nB = has_next ? (const char*)g.Bt + (size_t)nxt.pn * tstep : cB;
        for (int t = 0; t < nt; t += 2) {
            const bool last = (t == nt - 2);
            const char* a1 = cA + (size_t)(t + 1) * kstep;
            const char* a2 = last ? nA : cA + (size_t)(t + 2) * kstep; const char* b2 = last ? nB : cB + (size_t)(t + 2) * kstep;
            const char* a3 = a2 + kstep; const char* b3 = b2 + kstep;
            if (last && has_next) S.a_ready(nxt);
            if constexpr (SP2) {
            PG8_LDB(B0, 0, 0); PG8_LDB(B1, 0, 1); PG8_SCHED; PG8_LDA(At, 0, 0); PG8_STAGE(PG8_SA(1, 1), a1 + hstep, voffA);
            PG8_WAIT_V(8); PG8_WAIT_L(0); PG8_BAR; PG8_MMA(0, 0, At, B0); PG8_MMA(0, 1, At, B1); PG8_BAR; PG8_SCHED;
            PG8_LDA(At, 0, 1); PG8_STAGE(PG8_SB(0, 0), b2, voffB); PG8_STAGE(PG8_SB(0, 1), b2 + hstep, voffB); PG8_STAGE(PG8_SA(0, 0), a2, voffA);
            PG8_WAIT_V(8); PG8_WAIT_L(0); PG8_BAR; PG8_MMA(1, 0, At, B0); PG8_MMA(1, 1, At, B1); PG8_BAR; PG8_SCHED;
            PG8_LDB(B0, 1, 0); PG8_LDB(B1, 1, 1); PG8_SCHED; PG8_LDA(At, 1, 0); PG8_STAGE(PG8_SA(0, 1), a2 + hstep, voffA);
            PG8_WAIT_V(8); PG8_WAIT_L(0); PG8_BAR; PG8_MMA(0, 0, At, B0); PG8_MMA(0, 1, At, B1); PG8_BAR; PG8_SCHED;
            PG8_LDA(At, 1, 1); PG8_STAGE(PG8_SB(1, 0), b3, voffB); PG8_STAGE(PG8_SB(1, 1), b3 + hstep, voffB); PG8_STAGE(PG8_SA(1, 0), a3, voffA);
            PG8_WAIT_V(8); PG8_WAIT_L(0); PG8_BAR; PG8_MMA(1, 0, At, B0); PG8_MMA(1, 1, At, B1); PG8_BAR; PG8_SCHED;
            } else {
            PG8_LDB(B0, 0, 0); PG8_SCHED; PG8_LDA(At, 0, 0); PG8_STAGE(PG8_SA(1, 1), a1 + hstep, voffA);
            PG8_WAIT_L(8); PG8_BAR; PG8_WAIT_L(0); PG8_MMA(0, 0, At, B0); PG8_BAR; PG8_SCHED;
            PG8_LDB(B1, 0, 1); PG8_STAGE(PG8_SB(0, 0), b2, voffB);
            PG8_BAR; PG8_WAIT_L(0); PG8_MMA(0, 1, At, B1); PG8_BAR;
            PG8_LDA(At, 0, 1); PG8_STAGE(PG8_SA(0, 0), a2, voffA);
            PG8_BAR; PG8_WAIT_L(0); PG8_MMA(1, 0, At, B0); PG8_BAR; PG8_SCHED;
            PG8_STAGE(PG8_SB(0, 1), b2 + hstep, voffB);
            PG8_WAIT_V(6); PG8_BAR; PG8_MMA(1, 1, At, B1); PG8_BAR;
            PG8_LDB(B0, 1, 0); PG8_SCHED; PG8_LDA(At, 1, 0); PG8_STAGE(PG8_SA(0, 1), a2 + hstep, voffA);
            PG8_WAIT_L(8); PG8_BAR; PG8_WAIT_L(0); PG8_MMA(0, 0, At, B0); PG8_BAR; PG8_SCHED;
            PG8_LDB(B1, 1, 1); PG8_STAGE(PG8_SB(1, 0), b3, voffB);
            PG8_BAR; PG8_WAIT_L(0); PG8_MMA(0, 1, At, B1); PG8_BAR;
            PG8_LDA(At, 1, 1); PG8_STAGE(PG8_SA(1, 0), a3, voffA);
            PG8_BAR; PG8_WAIT_L(0); PG8_MMA(1, 0, At, B0); PG8_BAR; PG8_SCHED;
            PG8_STAGE(PG8_SB(1, 1), b3 + hstep, voffB);
            PG8_WAIT_V(6); PG8_BAR; PG8_MMA(1, 1, At, B1); PG8_BAR;
            }
        }
        if constexpr (ALIGN_EPI) { if (wr == 0) PG8_BAR; }
        if constexpr (!Epi::AFTER_DRAIN) {
            if constexpr (Epi::HAS_TAB) { typename Epi::Pre pre; E.tab_load(pre, has_next ? nxt.pm : cur.pm); E(acc, cur, wr, wc, fr, fq, ui & 1); E.tab_store(pre, (ui + 1) & 1); }
            else E(acc, cur, wr, wc, fr, fq);
            S.done(cur); }
        if (!has_next) break;
#pragma unroll
        for (int a = 0; a < 2; ++a)
#pragma unroll
            for (int b = 0; b < 2; ++b)
#pragma unroll
                for (int m = 0; m < 4; ++m)
#pragma unroll
                    for (int n = 0; n < 2; ++n) acc[a][b][m][n] = (f32x4){0.f, 0.f, 0.f, 0.f};
        cur = nxt; cA = nA; cB = nB; ++ui;
        if constexpr (ALIGN_EPI) { if (wr == 1) PG8_BAR; }
    }
    PG8_WAIT_V(0);
    if constexpr (!ALIGN_EPI) { if (wr == 0) PG8_BAR; }
    PG8_BAR;
    if constexpr (Epi::AFTER_DRAIN) { E.fused(acc, cur, wr, wc, fr, fq, lds, wid, lane); S.done(cur); }
#undef PG8_SA
#undef PG8_SB
#undef PG8_STAGE
#undef PG8_LDA
#undef PG8_LDB
#undef PG8_MMA
#undef PG8_WAIT_V
#undef PG8_WAIT_L
#undef PG8_BAR
#undef PG8_SCHED
}
}

#ifndef PG8_SP2
#define PG8_SP2 true
#endif
#ifndef PG8_ALIGN
#define PG8_ALIGN true
#endif

#include <hip/hip_cooperative_groups.h>
namespace cg = cooperative_groups;
#define LAS __attribute__((address_space(3)))
typedef unsigned short bf16;
typedef unsigned v4u __attribute__((ext_vector_type(4)));
typedef unsigned v2u __attribute__((ext_vector_type(2)));
typedef float f32x4 __attribute__((ext_vector_type(4)));
typedef short bf16x8 __attribute__((ext_vector_type(8)));

constexpr int D = 1024, M_P = 16384, M_S = 65536, M = M_P + M_S, T_P = 2048, T_S = 4096;
constexpr int FF = 2816, NIN = 3328, NT32 = M / 32, NT16 = M / 16;
constexpr float ALPHA = 1.189207115002721f;
constexpr float EPS = 1e-5f;
constexpr float LOG2E = 1.4426950408889634f;
constexpr float QSCALE = 0.125f * LOG2E;
constexpr int NWAVES = 8;
constexpr int LDS_BYTES = 155648;
constexpr int MISC_OFF = 151552;

constexpr size_t MiB = 1u << 20;
constexpr size_t WS_W13A = 0, WS_W13B = 11 * MiB, WS_W2A = 22 * MiB, WS_W2B = 28 * MiB, WS_WIN = 34 * MiB, WS_WOUT = 41 * MiB;
constexpr size_t WS_XB = 44 * MiB, WS_BIG = 204 * MiB;
constexpr size_t WS_H = WS_BIG;
constexpr size_t WS_QA = WS_BIG, WS_KA = WS_BIG + 80 * MiB, WS_VT = WS_BIG + 100 * MiB, WS_QH = WS_BIG + 120 * MiB, WS_GF = WS_BIG + 200 * MiB,
                 WS_GB = WS_BIG + 280 * MiB, WS_IH = WS_BIG + 360 * MiB, WS_GH = WS_BIG + 440 * MiB, WS_OF = WS_GF, WS_OB = WS_GB, WS_MIX = WS_BIG + 520 * MiB;
constexpr size_t WS_CTL = WS_BIG + 680 * MiB, WS_BAR = WS_CTL + 4096, WS_END = WS_BAR + 16384;

__device__ __forceinline__ unsigned f2bf(float f) { unsigned u = __builtin_bit_cast(unsigned, f); return (u + 0x7fffu + ((u >> 16) & 1u)) >> 16; }
__device__ __forceinline__ unsigned pk2(float lo, float hi) { return f2bf(lo) | (f2bf(hi) << 16); }
__device__ __forceinline__ unsigned pk2v(float lo, float hi) { unsigned r; asm volatile("v_cvt_pk_bf16_f32 %0, %1, %2" : "=v"(r) : "v"(lo), "v"(hi)); return r; }
__device__ __forceinline__ float bf2f(unsigned short h) { return __builtin_bit_cast(float, (unsigned)h << 16); }
__device__ __forceinline__ float bflo(unsigned w) { return __builtin_bit_cast(float, w << 16); }
__device__ __forceinline__ float bfhi(unsigned w) { return __builtin_bit_cast(float, w & 0xffff0000u); }
__device__ __forceinline__ float wave_sum(float v) {
#pragma unroll
    for (int o = 1; o < 64; o <<= 1) v += __shfl_xor(v, o);
    return v;
}
__device__ __forceinline__ float silu_f(float x) { return x * __builtin_amdgcn_rcpf(1.0f + __builtin_amdgcn_exp2f(-x * LOG2E)); }

__device__ __forceinline__ size_t qk_off(int m, int head, int d0, int hh) { return ((((size_t)head * NT32 + (m >> 5)) * 4 + d0) * 32 + (m & 31)) * 16 + hh * 8; }
__device__ __forceinline__ int vt_slot(int o) { return ((o >> 2) & 1) * 8 + (o >> 3) * 4 + (o & 3); }
__device__ __forceinline__ size_t vt_off(int m, int kvh, int d) { return (((size_t)kvh * NT16 + (m >> 4)) * 64 + d) * 16 + vt_slot(m & 15); }

namespace pg8 {
struct EpiRes {
    static constexpr bool PERM = false, AFTER_DRAIN = false, HAS_TAB = false;
    const float* res0; const float* res1; int split; float* out; float alpha, s;
    __device__ __forceinline__ void operator()(const f32x4 (&acc)[2][2][4][2], const Unit& u, int wr, int wc, int fr, int fq) const {
        const int row0 = u.pm * BM + wr * 64 + fr, col0 = u.pn * BM + wc * 32 + 4 * fq;
        const float* rb = (u.pm * BM < split) ? res0 : res1 - (size_t)split * 1024;
#pragma unroll
        for (int ai = 0; ai < 2; ++ai)
#pragma unroll
            for (int m = 0; m < 4; ++m) { const size_t off = (size_t)(row0 + ai * HALF + m * 16) * 1024 + col0;
#pragma unroll
                for (int bj = 0; bj < 2; ++bj)
#pragma unroll
                    for (int n = 0; n < 2; ++n) { const f32x4 rv = *(const f32x4*)(rb + off + bj * HALF + n * 16);
                        *(f32x4*)(out + off + bj * HALF + n * 16) = rv * alpha + acc[ai][bj][m][n] * s; }
                if (m & 1) asm volatile("" ::: "memory"); }
    }
};
struct EpiResB {
    static constexpr bool PERM = false, AFTER_DRAIN = false, HAS_TAB = false;
    const bf16_t* res; bf16_t* vout; float alpha, s;
    __device__ __forceinline__ void operator()(const f32x4 (&acc)[2][2][4][2], const Unit& u, int wr, int wc, int fr, int fq) const {
        typedef unsigned u32x2e __attribute__((ext_vector_type(2)));
        const int row0 = u.pm * BM + wr * 64 + fr, col0 = u.pn * BM + wc * 32 + 4 * fq;
#pragma unroll
        for (int ai = 0; ai < 2; ++ai)
#pragma unroll
            for (int m = 0; m < 4; ++m) { const size_t off = (size_t)(row0 + ai * HALF + m * 16) * 1024 + col0;
#pragma unroll
                for (int bj = 0; bj < 2; ++bj)
#pragma unroll
                    for (int n = 0; n < 2; ++n) { const u32x2e rw = *(const u32x2e*)(res + off + bj * HALF + n * 16);
                        const f32x4 rv = (f32x4){__builtin_bit_cast(float, rw[0] << 16), __builtin_bit_cast(float, rw[0] & 0xffff0000u), __builtin_bit_cast(float, rw[1] << 16), __builtin_bit_cast(float, rw[1] & 0xffff0000u)};
                        const f32x4 o = rv * alpha + acc[ai][bj][m][n] * s;
                        u32x2e w; w[0] = cvt_pk_bf16(o[0], o[1]); w[1] = cvt_pk_bf16(o[2], o[3]); *(u32x2e*)(vout + off + bj * HALF + n * 16) = w; }
                if (m & 1) asm volatile("" ::: "memory"); }
    }
};
struct EpiSwiGLU {
    static constexpr bool PERM = true, AFTER_DRAIN = false, HAS_TAB = false;
    bf16_t* H;
    __device__ __forceinline__ void operator()(const f32x4 (&acc)[2][2][4][2], const Unit& u, int wr, int wc, int fr, int fq) const {
        const int row0 = u.pm * BM + wr * 64 + fr, col0 = u.pn * HALF + wc * 32 + 8 * fq;
#pragma unroll
        for (int ai = 0; ai < 2; ++ai)
#pragma unroll
            for (int m = 0; m < 4; ++m) {
                float h[8];
#pragma unroll
                for (int n = 0; n < 2; ++n)
#pragma unroll
                    for (int i = 0; i < 4; ++i) { const float g = acc[ai][0][m][n][i], up = acc[ai][1][m][n][i]; h[n * 4 + i] = silu_f(g) * up; }
                u32x4 w; w.x = cvt_pk_bf16(h[0], h[1]); w.y = cvt_pk_bf16(h[2], h[3]); w.z = cvt_pk_bf16(h[4], h[5]); w.w = cvt_pk_bf16(h[6], h[7]);
                __builtin_nontemporal_store(w, (u32x4*)(H + (size_t)(row0 + ai * HALF + m * 16) * FF + col0)); }
    }
};
struct EpiIn {
    static constexpr bool PERM = true, AFTER_DRAIN = false, HAS_TAB = false;
    unsigned char* ws; const float* lbf; const float* lbb;
    __device__ __forceinline__ void operator()(const f32x4 (&acc)[2][2][4][2], const Unit& u, int wr, int wc, int fr, int fq) const {
        bf16_t* QA = (bf16_t*)(ws + WS_QA); bf16_t* KA = (bf16_t*)(ws + WS_KA); bf16_t* VT = (bf16_t*)(ws + WS_VT);
        const int pn = u.pn; const int row0 = u.pm * BM + wr * 64 + fr; const int c8 = wc * 32 + 8 * fq;
        if (pn <= 2) {
            const int hd = wc >> 1, dim = (wc & 1) * 32 + 8 * fq, d0 = dim >> 4, hh = (dim >> 3) & 1;
#pragma unroll
            for (int ai = 0; ai < 2; ++ai)
#pragma unroll
                for (int m = 0; m < 4; ++m) { const int row = row0 + ai * HALF + m * 16;
#pragma unroll
                    for (int bj = 0; bj < 2; ++bj) { const f32x4 v0 = acc[ai][bj][m][0], v1 = acc[ai][bj][m][1];
                        if (pn < 2) { const int head = pn * 4 + bj * 2 + hd; u32x4 w; w.x = cvt_pk_bf16(v0[0] * QSCALE, v0[1] * QSCALE); w.y = cvt_pk_bf16(v0[2] * QSCALE, v0[3] * QSCALE);
                            w.z = cvt_pk_bf16(v1[0] * QSCALE, v1[1] * QSCALE); w.w = cvt_pk_bf16(v1[2] * QSCALE, v1[3] * QSCALE); *(u32x4*)(QA + qk_off(row, head, d0, hh)) = w; }
                        else if (bj == 0) { u32x4 w; w.x = cvt_pk_bf16(v0[0], v0[1]); w.y = cvt_pk_bf16(v0[2], v0[3]); w.z = cvt_pk_bf16(v1[0], v1[1]); w.w = cvt_pk_bf16(v1[2], v1[3]); *(u32x4*)(KA + qk_off(row, hd, d0, hh)) = w; }
                        else { bf16_t* vp = VT + vt_off(row, hd, dim);
#pragma unroll
                            for (int i = 0; i < 4; ++i) { vp[i * 16] = (bf16_t)f2bf(v0[i]); vp[(4 + i) * 16] = (bf16_t)f2bf(v1[i]); } } } }
        } else if (pn <= 4 || pn >= 9) {
            bf16_t* dst = (bf16_t*)(ws + (pn <= 4 ? WS_QH : (pn <= 10 ? WS_IH : WS_GH))); const int cb = ((pn <= 4 ? pn - 3 : (pn <= 10 ? pn - 9 : pn - 11)) * 256) + c8;
#pragma unroll
            for (int ai = 0; ai < 2; ++ai)
#pragma unroll
                for (int m = 0; m < 4; ++m) { const int row = row0 + ai * HALF + m * 16;
#pragma unroll
                    for (int bj = 0; bj < 2; ++bj) { const f32x4 v0 = acc[ai][bj][m][0], v1 = acc[ai][bj][m][1];
                        u32x4 w; w.x = cvt_pk_bf16(v0[0], v0[1]); w.y = cvt_pk_bf16(v0[2], v0[3]); w.z = cvt_pk_bf16(v1[0], v1[1]); w.w = cvt_pk_bf16(v1[2], v1[3]);
                        *(u32x4*)(dst + (size_t)row * 512 + cb + bj * HALF) = w; } }
        } else {
            bf16_t* dst = (bf16_t*)(ws + (pn <= 6 ? WS_GF : WS_GB)); const float* lp = pn <= 6 ? lbf : lbb; const int cb = ((pn - 5) & 1) * 256 + c8;
#pragma unroll
            for (int bj = 0; bj < 2; ++bj) { float lb[8];
#pragma unroll
                for (int i = 0; i < 8; ++i) { const float p0 = lp[cb + bj * HALF + i], p1 = lp[512 + cb + bj * HALF + i]; lb[i] = __builtin_amdgcn_rcpf(1.0f + __expf(p1 - p0)); }
#pragma unroll
                for (int ai = 0; ai < 2; ++ai)
#pragma unroll
                    for (int m = 0; m < 4; ++m) { const int row = row0 + ai * HALF + m * 16; float g[8];
#pragma unroll
                        for (int n = 0; n < 2; ++n)
#pragma unroll
                            for (int i = 0; i < 4; ++i) { const float x = acc[ai][bj][m][n][i]; const float sg = __builtin_amdgcn_rcpf(1.0f + __builtin_amdgcn_exp2f(-x * 1.4426950408889634f));
                                const float l = lb[n * 4 + i]; g[n * 4 + i] = __logf(l + (1.0f - l) * sg); }
                        u32x4 w; w.x = cvt_pk_bf16(g[0], g[1]); w.y = cvt_pk_bf16(g[2], g[3]); w.z = cvt_pk_bf16(g[4], g[5]); w.w = cvt_pk_bf16(g[6], g[7]);
                        *(u32x4*)(dst + (size_t)row * 512 + cb + bj * HALF) = w; } }
        }
    }
};
}

struct Args { const float* in[13]; float* out; unsigned char* ws; };

struct Frame {
    LAS unsigned char* lds; int tid, lane, wave, G, bid;
};

struct TrItem { const float* W; bf16* WT; int K, N, mode, r; };
__device__ __forceinline__ void p0_decode(const Args& a, unsigned char* ws, int it, TrItem& t) {
    constexpr int I13 = (D / 64) * (2 * FF / 32), I2 = (FF / 64) * (D / 32), IIN = (D / 64) * (NIN / 32);
    int r = it;
    if (r < I13) { t = TrItem{a.in[4], (bf16*)(ws + WS_W13A), D, 2 * FF, 1, r}; return; } r -= I13;
    if (r < I13) { t = TrItem{a.in[4] + (size_t)D * 2 * FF, (bf16*)(ws + WS_W13B), D, 2 * FF, 1, r}; return; } r -= I13;
    if (r < I2) { t = TrItem{a.in[5], (bf16*)(ws + WS_W2A), FF, D, 0, r}; return; } r -= I2;
    if (r < I2) { t = TrItem{a.in[5] + (size_t)FF * D, (bf16*)(ws + WS_W2B), FF, D, 0, r}; return; } r -= I2;
    if (r < IIN) { t = TrItem{a.in[6], (bf16*)(ws + WS_WIN), D, NIN, 0, r}; return; } r -= IIN;
    t = TrItem{a.in[12], (bf16*)(ws + WS_WOUT), D, D, 0, r};
}
__device__ __forceinline__ void p0_load(const TrItem& t, int lane, float (&wv)[32]) {
    const int nblk = t.N / 32, kb = t.r / nblk, nb = t.r % nblk, k0 = 64 * kb, n0 = 32 * nb;
    const float* p = t.W + (size_t)(k0 + (lane >> 5)) * t.N + n0 + (lane & 31);
#pragma unroll
    for (int i = 0; i < 32; ++i) wv[i] = p[(size_t)(2 * i) * t.N];
}
__device__ __forceinline__ void p0_store(const TrItem& t, LAS float* scr, int lane, const float (&wv)[32]) {
    const int nblk = t.N / 32, kb = t.r / nblk, nb = t.r % nblk, k0 = 64 * kb, n0 = 32 * nb;
    int rbase = n0;
    if (t.mode == 1) { const int h0 = n0 < FF ? n0 : n0 - FF; rbase = (h0 >> 7) * 256 + (n0 < FF ? 0 : 128) + (h0 & 127); }
#pragma unroll
    for (int i = 0; i < 32; ++i) scr[(2 * i + (lane >> 5)) * 33 + (lane & 31)] = wv[i];
    asm volatile("s_waitcnt lgkmcnt(0)" ::: "memory");
    const int c = lane & 7;
#pragma unroll
    for (int j = 0; j < 4; ++j) { const int n = (lane >> 3) + 8 * j; const LAS float* s = scr + (8 * c) * 33 + n;
        v4u o; o.x = pk2v(s[0 * 33], s[1 * 33]); o.y = pk2v(s[2 * 33], s[3 * 33]); o.z = pk2v(s[4 * 33], s[5 * 33]); o.w = pk2v(s[6 * 33], s[7 * 33]);
        *(v4u*)(t.WT + (size_t)(rbase + n) * t.K + k0 + 8 * c) = o; }
    asm volatile("s_waitcnt lgkmcnt(0)" ::: "memory");
}
__device__ __forceinline__ void p0_prologue(const Frame& F, const Args& a, int part) {
    LAS float* scr = (LAS float*)(F.lds + F.wave * 16384);
    const int gw = F.bid * NWAVES + F.wave, NGW = F.G * NWAVES;
    unsigned char* ws = a.ws;
    constexpr int NITEMS = 2 * (D / 64) * (2 * FF / 32) + 2 * (FF / 64) * (D / 32) + (D / 64) * (NIN / 32) + (D / 64) * (D / 32);
    if (part == 0) {
        TrItem cur, nxt; float wv[32], wn[32]; int it = gw;
        if (it < NITEMS) { p0_decode(a, ws, it, cur); p0_load(cur, F.lane, wv); }
        while (it < NITEMS) { const int itn = it + NGW; const bool hn = itn < NITEMS;
            if (hn) { p0_decode(a, ws, itn, nxt); p0_load(nxt, F.lane, wn); }
            p0_store(cur, scr, F.lane, wv);
            if (hn) { cur = nxt;
#pragma unroll
                for (int i = 0; i < 32; ++i) wv[i] = wn[i]; }
            it = itn; }
    }
    bf16* XB = (bf16*)(ws + WS_XB);
    if (part == 1) for (int m4 = gw * 4; m4 < M; m4 += NGW * 4) {
        f32x4 v[4][4];
#pragma unroll
        for (int rr = 0; rr < 4; ++rr) { const int m = m4 + rr; const float* xrow = m < M_P ? a.in[0] + (size_t)m * D : a.in[1] + (size_t)(m - M_P) * D; const f32x4* xr = (const f32x4*)xrow + F.lane;
#pragma unroll
            for (int j = 0; j < 4; ++j) v[rr][j] = __builtin_nontemporal_load(xr + 64 * j); }
#pragma unroll
        for (int rr = 0; rr < 4; ++rr) { v2u* o8 = (v2u*)(XB + (size_t)(m4 + rr) * D) + F.lane;
#pragma unroll
            for (int j = 0; j < 4; ++j) { v2u w; w.x = pk2v(v[rr][j].x, v[rr][j].y); w.y = pk2v(v[rr][j].z, v[rr][j].w); o8[64 * j] = w; } }
    }
}
__device__ __forceinline__ void ln_phase(const Frame& F, const bf16* vin, bf16* xb, float* fout, const float* g, const float* b) {
    const int gw = F.bid * NWAVES + F.wave, NGW = F.G * NWAVES;
    f32x4 gv[4], bv[4];
#pragma unroll
    for (int j = 0; j < 4; ++j) { gv[j] = ((const f32x4*)g)[F.lane + 64 * j]; bv[j] = ((const f32x4*)b)[F.lane + 64 * j]; }
    for (int m2 = gw * 2; m2 < M; m2 += NGW * 2) {
        f32x4 v[2][4]; float s[2], s2[2], mean[2], rstd[2];
#pragma unroll
        for (int rr = 0; rr < 2; ++rr) { const v2u* xr = (const v2u*)(vin + (size_t)(m2 + rr) * D) + F.lane; s[rr] = 0.f;
#pragma unroll
            for (int j = 0; j < 4; ++j) { const v2u w = __builtin_nontemporal_load(xr + 64 * j); v[rr][j] = (f32x4){bflo(w.x), bfhi(w.x), bflo(w.y), bfhi(w.y)}; } }
#pragma unroll
        for (int rr = 0; rr < 2; ++rr) {
#pragma unroll
            for (int j = 0; j < 4; ++j) s[rr] += (v[rr][j].x + v[rr][j].y) + (v[rr][j].z + v[rr][j].w); }
#pragma unroll
        for (int rr = 0; rr < 2; ++rr) { mean[rr] = wave_sum(s[rr]) * (1.f / D); s2[rr] = 0.f;
#pragma unroll
            for (int j = 0; j < 4; ++j) { v[rr][j] = v[rr][j] - mean[rr]; s2[rr] += (v[rr][j].x * v[rr][j].x + v[rr][j].y * v[rr][j].y) + (v[rr][j].z * v[rr][j].z + v[rr][j].w * v[rr][j].w); } }
#pragma unroll
        for (int rr = 0; rr < 2; ++rr) { rstd[rr] = 1.f / sqrtf(wave_sum(s2[rr]) * (1.f / D) + EPS);
#pragma unroll
            for (int j = 0; j < 4; ++j) { const f32x4 y = v[rr][j] * rstd[rr] * gv[j] + bv[j];
                if (fout) __builtin_nontemporal_store(y, (f32x4*)(fout + (size_t)(m2 + rr) * D) + F.lane + 64 * j);
                else { v2u w; w.x = pk2v(y.x, y.y); w.y = pk2v(y.z, y.w); ((v2u*)(xb + (size_t)(m2 + rr) * D) + F.lane)[64 * j] = w; } } }
    }
}
__device__ __forceinline__ void hgrn_item_naive(const Frame& F, const Args& a, int it) {
    unsigned char* ws = a.ws;
    int s0, T, head, dir;
    if (it < 128) { s0 = M_P + (it >> 3) * T_S; T = T_S; } else { s0 = ((it - 128) >> 3) * T_P; T = T_P; }
    head = (it >> 1) & 3; dir = it & 1;
    const bf16* QH = (const bf16*)(ws + WS_QH); const bf16* G = (const bf16*)(ws + (dir ? WS_GB : WS_GF)); const bf16* IH = (const bf16*)(ws + WS_IH);
    bf16* O = (bf16*)a.out + (dir ? (size_t)M * 512 : 0);
    LAS float* qs = (LAS float*)F.lds; LAS float* fs = qs + 1024; LAS float* ks = fs + 1024; LAS float* vs = ks + 1024; LAS float* red = vs + 1024;
    const int v = F.tid & 127, dq = F.tid >> 7;
    float S[32];
#pragma unroll
    for (int i = 0; i < 32; ++i) S[i] = 0.f;
    for (int b0 = 0; b0 < T; b0 += 8) {
        __syncthreads();
#pragma unroll
        for (int e = F.tid; e < 1024; e += 512) { const int tok = e >> 7, d = e & 127; const int j = b0 + tok; const int t = dir ? T - 1 - j : j; const size_t idx = (size_t)(s0 + t) * 512 + head * 128 + d;
            qs[e] = bf2f(QH[idx]); const float f = __expf(bf2f(G[idx])); fs[e] = f; ks[e] = 1.0f - f; vs[e] = bf2f(IH[idx]); }
        __syncthreads();
#pragma unroll 1
        for (int tok = 0; tok < 8; ++tok) { const float iv = vs[tok * 128 + v]; float o = 0.f;
#pragma unroll
            for (int dd = 0; dd < 32; ++dd) { const int d = dq * 32 + dd; S[dd] = fs[tok * 128 + d] * S[dd] + ks[tok * 128 + d] * iv; o += qs[tok * 128 + d] * S[dd]; }
            red[(dq * 8 + tok) * 128 + v] = o; }
        __syncthreads();
#pragma unroll
        for (int e = F.tid; e < 1024; e += 512) { const int tok = e >> 7, vv = e & 127; const int j = b0 + tok; const int t = dir ? T - 1 - j : j;
            const float sm = (red[(0 * 8 + tok) * 128 + vv] + red[(1 * 8 + tok) * 128 + vv]) + (red[(2 * 8 + tok) * 128 + vv] + red[(3 * 8 + tok) * 128 + vv]);
            O[(size_t)(s0 + t) * 512 + head * 128 + vv] = (bf16)f2bf(sm); }
    }
    __syncthreads();
}

__device__ __forceinline__ float exp_c(float x) { return __builtin_amdgcn_exp2f(fminf(x, 80.0f) * LOG2E); }
__device__ __forceinline__ int dperm(int d) { return (d & ~31) | (((d >> 2) & 3) << 3) | (((d >> 4) & 1) << 2) | (d & 3); }
#define LDS_BAR() do { asm volatile("s_waitcnt lgkmcnt(0)" ::: "memory"); __builtin_amdgcn_s_barrier(); asm volatile("" ::: "memory"); } while (0)
constexpr int HO_QS = 0, HO_KS = 17408, HO_KT = 34816, HO_VT = 53248, HO_AS = 71680, HO_E1 = 80896, HO_E2 = HO_E1 + 512, HO_E3 = HO_E1 + 1024, HO_TOT = 82432, HO_OS = 86528;
#define LDSP(T_, base_, off_) ((LAS T_*)(uintptr_t)(unsigned)((base_) + (unsigned)(off_)))
__device__ __forceinline__ void hgrn_item_mfma(const Frame& F, const Args& a, int it) {
    unsigned char* ws = a.ws;
    int s0, T;
    if (it < 128) { s0 = M_P + (it >> 3) * T_S; T = T_S; } else { s0 = ((it - 128) >> 3) * T_P; T = T_P; }
    const int head = (it >> 1) & 3, dir = it & 1;
    const bf16* QH = (const bf16*)(ws + WS_QH); const bf16* G = (const bf16*)(ws + (dir ? WS_GB : WS_GF)); const bf16* IH = (const bf16*)(ws + WS_IH);
    bf16* O = (bf16*)a.out + (dir ? (size_t)M * 512 : 0);
    const int dp = F.tid & 63, w = F.wave, part = w, r = F.lane & 15, q4 = F.lane >> 4;
    const int d0 = 2 * dp, pd0 = dperm(d0);
    const unsigned L0 = (unsigned)(uintptr_t)F.lds;
    unsigned pA = L0 + d0 * 4 + part * 512, pA0 = L0 + d0 * 4, pQ = L0 + pd0 * 2 + part * 2176, pK = L0 + d0 * 144 + part * 16;
    unsigned rA = L0 + r * 272 + q4 * 16, rB = L0 + r * 144 + q4 * 16, rBv = L0 + r * 144 + q4 * 16 + w * 2304, pE = L0 + q4 * 16;
    unsigned pO = L0 + q4 * 1088 + (16 * w + r) * 2, pF = L0 + (F.tid >> 4) * 272 + (F.tid & 15) * 16;
    unsigned rAc = L0 + r * 272 + q4 * 16 + (w >> 1) * 4352, rKc = L0 + r * 272 + q4 * 16 + ((w & 1) * 2) * 4352, pAs = L0 + q4 * 576 + r * 2 + (w >> 1) * 2304 + (w & 1) * 64;
    asm volatile("" : "+v"(pA), "+v"(pA0), "+v"(pQ), "+v"(pK), "+v"(rA), "+v"(rB), "+v"(rBv), "+v"(pE));
    asm volatile("" : "+v"(pO), "+v"(pF), "+v"(rAc), "+v"(rKc), "+v"(pAs));
    const int nch = T / 64;
    pg8::f32x4 S[8];
#pragma unroll
    for (int i = 0; i < 8; ++i) S[i] = (pg8::f32x4){0.f, 0.f, 0.f, 0.f};
    unsigned g2[8], q2[8], v2[8];
    const bf16* Gb = G + (size_t)s0 * 512 + head * 128; const bf16* Qb = QH + (size_t)s0 * 512 + head * 128; const bf16* Vb = IH + (size_t)s0 * 512 + head * 128;
    bf16* Ob = O + (size_t)s0 * 512 + head * 128;
    const int rstep = dir ? -512 : 512; const int roff0 = (dir ? (T - 1 - part * 8) : part * 8) * 512 + d0;
#define HG_LOAD(c) do { const int o0_ = roff0 + (c) * 64 * rstep; _Pragma("unroll") for (int ii = 0; ii < 8; ++ii) { const unsigned o_ = (unsigned)(o0_ + ii * rstep); \
        g2[ii] = *(const unsigned*)(Gb + o_); q2[ii] = *(const unsigned*)(Qb + o_); v2[ii] = *(const unsigned*)(Vb + o_); } } while (0)
#define HG_FLUSH(c) do { _Pragma("unroll") for (int k_ = 0; k_ < 2; ++k_) { const int row_ = (F.tid >> 4) + 32 * k_; const int tk_ = (c) * 64 + row_; const int t_ = dir ? T - 1 - tk_ : tk_; \
        *(v4u*)(Ob + (size_t)t_ * 512 + (F.tid & 15) * 8) = *LDSP(v4u, pF, HO_OS + k_ * 8704); } } while (0)
    HG_LOAD(0);
    const int ti_c = w >> 1, tj0_c = (w & 1) * 2;
    for (int c = 0; c < nch; ++c) {
        typedef float f32x2_ __attribute__((ext_vector_type(2))); typedef unsigned u32x2_ __attribute__((ext_vector_type(2)));
        float pa[8], pb[8]; float ra = 0.f, rb = 0.f;
#pragma unroll
        for (int ii = 0; ii < 8; ++ii) { ra += bflo(g2[ii]) * LOG2E; rb += bfhi(g2[ii]) * LOG2E; pa[ii] = ra; pb[ii] = rb; }
        *LDSP(f32x2_, pA, HO_TOT) = (f32x2_){ra, rb};
        LDS_BAR();
        if (c > 0) HG_FLUSH(c - 1);
        float offA = 0.f, offB = 0.f, brefA = 0.f, brefB = 0.f, blastA = 0.f, blastB = 0.f;
#pragma unroll
        for (int p_ = 0; p_ < 8; ++p_) { const f32x2_ tt = *LDSP(f32x2_, pA0, HO_TOT + p_ * 512); if (p_ < part) { offA += tt.x; offB += tt.y; } if (p_ < 4) { brefA += tt.x; brefB += tt.y; } blastA += tt.x; blastB += tt.y; }
        offA -= brefA; offB -= brefB;
        float ka[8], kb[8];
#pragma unroll
        for (int ii = 0; ii < 8; ++ii) { const float xa = offA + pa[ii], xb = offB + pb[ii];
            const float fa = __builtin_amdgcn_exp2f(bflo(g2[ii]) * LOG2E), fb = __builtin_amdgcn_exp2f(bfhi(g2[ii]) * LOG2E);
            const float qa = bflo(q2[ii]) * __builtin_amdgcn_exp2f(fminf(xa, 115.0f)), qb = bfhi(q2[ii]) * __builtin_amdgcn_exp2f(fminf(xb, 115.0f));
            ka[ii] = (1.0f - fa) * __builtin_amdgcn_exp2f(fminf(-xa, 115.0f)); kb[ii] = (1.0f - fb) * __builtin_amdgcn_exp2f(fminf(-xb, 115.0f));
            *LDSP(unsigned, pQ, HO_QS + ii * 272) = pg8::cvt_pk_bf16(qa, qb); *LDSP(unsigned, pQ, HO_KS + ii * 272) = pg8::cvt_pk_bf16(ka[ii], kb[ii]); }
        *LDSP(v4u, pK, HO_KT) = (v4u){pg8::cvt_pk_bf16(ka[0], ka[1]), pg8::cvt_pk_bf16(ka[2], ka[3]), pg8::cvt_pk_bf16(ka[4], ka[5]), pg8::cvt_pk_bf16(ka[6], ka[7])};
        *LDSP(v4u, pK, HO_KT + 144) = (v4u){pg8::cvt_pk_bf16(kb[0], kb[1]), pg8::cvt_pk_bf16(kb[2], kb[3]), pg8::cvt_pk_bf16(kb[4], kb[5]), pg8::cvt_pk_bf16(kb[6], kb[7])};
        *LDSP(v4u, pK, HO_VT) = (v4u){(v2[0] & 0xffffu) | (v2[1] << 16), (v2[2] & 0xffffu) | (v2[3] << 16), (v2[4] & 0xffffu) | (v2[5] << 16), (v2[6] & 0xffffu) | (v2[7] << 16)};
        *LDSP(v4u, pK, HO_VT + 144) = (v4u){(v2[0] >> 16) | (v2[1] & 0xffff0000u), (v2[2] >> 16) | (v2[3] & 0xffff0000u), (v2[4] >> 16) | (v2[5] & 0xffff0000u), (v2[6] >> 16) | (v2[7] & 0xffff0000u)};
        if (part == 0) { *LDSP(f32x2_, pA0, HO_E1) = (f32x2_){__builtin_amdgcn_exp2f(fminf(blastA, 115.0f)), __builtin_amdgcn_exp2f(fminf(blastB, 115.0f))};
            *LDSP(f32x2_, pA0, HO_E2) = (f32x2_){__builtin_amdgcn_exp2f(fminf(blastA - brefA, 115.0f)), __builtin_amdgcn_exp2f(fminf(blastB - brefB, 115.0f))};
            *LDSP(f32x2_, pA0, HO_E3) = (f32x2_){__builtin_amdgcn_exp2f(fminf(brefA, 115.0f)), __builtin_amdgcn_exp2f(fminf(brefB, 115.0f))}; }
        if (c + 1 < nch) HG_LOAD(c + 1);
        LDS_BAR();
#pragma unroll
        for (int tjj = 0; tjj < 2; ++tjj) { const int tj = tj0_c + tjj; pg8::f32x4 acc = (pg8::f32x4){0.f, 0.f, 0.f, 0.f};
            if (tj <= ti_c) { bf16x8 af[4], bfr[4];
#pragma unroll
                for (int ks = 0; ks < 4; ++ks) { af[ks] = *LDSP(bf16x8, rAc, HO_QS + ks * 64); bfr[ks] = *LDSP(bf16x8, rKc, HO_KS + tjj * 4352 + ks * 64); }
#pragma unroll
                for (int ks = 0; ks < 4; ++ks) acc = __builtin_amdgcn_mfma_f32_16x16x32_bf16(af[ks], bfr[ks], acc, 0, 0, 0); }
#pragma unroll
            for (int rg = 0; rg < 4; ++rg) { const int i = 16 * ti_c + 4 * q4 + rg, j = 16 * tj + r; *LDSP(bf16, pAs, HO_AS + tjj * 32 + rg * 144) = (bf16)f2bf(j <= i ? acc[rg] : 0.f); } }
        LDS_BAR();
        { bf16x8 vB[2], sB[4]; pg8::f32x4 o[4];
          { pg8::f32x4 e3a[4], e3b[4];
#pragma unroll
            for (int ks = 0; ks < 2; ++ks) vB[ks] = *LDSP(bf16x8, rBv, HO_VT + ks * 64);
#pragma unroll
            for (int ks = 0; ks < 4; ++ks) { e3a[ks] = *LDSP(pg8::f32x4, pE, HO_E3 + ks * 128); e3b[ks] = *LDSP(pg8::f32x4, pE, HO_E3 + ks * 128 + 64); }
            __builtin_amdgcn_sched_barrier(0);
#pragma unroll
            for (int ks = 0; ks < 4; ++ks) { const pg8::f32x4 sa = S[2 * ks] * e3a[ks], sb = S[2 * ks + 1] * e3b[ks];
                v4u pw; pw.x = pk2v(sa[0], sa[1]); pw.y = pk2v(sa[2], sa[3]); pw.z = pk2v(sb[0], sb[1]); pw.w = pk2v(sb[2], sb[3]); sB[ks] = __builtin_bit_cast(bf16x8, pw); } }
#pragma unroll
          for (int tp = 0; tp < 2; ++tp) { bf16x8 aA[2][2], aQ[2][4];
#pragma unroll
              for (int tt = 0; tt < 2; ++tt) { const int ti = tp * 2 + tt;
#pragma unroll
                  for (int ks = 0; ks < 2; ++ks) aA[tt][ks] = *LDSP(bf16x8, rB, HO_AS + ti * 2304 + ks * 64);
#pragma unroll
                  for (int ks = 0; ks < 4; ++ks) aQ[tt][ks] = *LDSP(bf16x8, rA, HO_QS + ti * 4352 + ks * 64); }
              __builtin_amdgcn_sched_barrier(0);
#pragma unroll
              for (int tt = 0; tt < 2; ++tt) o[tp * 2 + tt] = (pg8::f32x4){0.f, 0.f, 0.f, 0.f};
#pragma unroll
              for (int ks = 0; ks < 2; ++ks)
#pragma unroll
                  for (int tt = 0; tt < 2; ++tt) o[tp * 2 + tt] = __builtin_amdgcn_mfma_f32_16x16x32_bf16(aA[tt][ks], vB[ks], o[tp * 2 + tt], 0, 0, 0);
#pragma unroll
              for (int ks = 0; ks < 4; ++ks)
#pragma unroll
                  for (int tt = 0; tt < 2; ++tt) o[tp * 2 + tt] = __builtin_amdgcn_mfma_f32_16x16x32_bf16(aQ[tt][ks], sB[ks], o[tp * 2 + tt], 0, 0, 0);
              __builtin_amdgcn_sched_barrier(0); }
#pragma unroll
          for (int hf = 0; hf < 2; ++hf) { bf16x8 aK[4][2]; pg8::f32x4 e1v[4], e2v[4];
#pragma unroll
              for (int dd = 0; dd < 4; ++dd) { const int dt = hf * 4 + dd;
#pragma unroll
                  for (int ks = 0; ks < 2; ++ks) aK[dd][ks] = *LDSP(bf16x8, rB, HO_KT + dt * 2304 + ks * 64);
                  e1v[dd] = *LDSP(pg8::f32x4, pE, HO_E1 + dt * 64); e2v[dd] = *LDSP(pg8::f32x4, pE, HO_E2 + dt * 64); }
              if (hf == 0) {
#pragma unroll
                  for (int ti = 0; ti < 4; ++ti)
#pragma unroll
                      for (int rg = 0; rg < 4; ++rg) *LDSP(bf16, pO, HO_OS + ti * 4352 + rg * 272) = (bf16)f2bf(o[ti][rg]); }
              __builtin_amdgcn_sched_barrier(0);
              pg8::f32x4 u[4];
#pragma unroll
              for (int dd = 0; dd < 4; ++dd) u[dd] = (pg8::f32x4){0.f, 0.f, 0.f, 0.f};
#pragma unroll
              for (int ks = 0; ks < 2; ++ks)
#pragma unroll
                  for (int dd = 0; dd < 4; ++dd) u[dd] = __builtin_amdgcn_mfma_f32_16x16x32_bf16(aK[dd][ks], vB[ks], u[dd], 0, 0, 0);
#pragma unroll
              for (int dd = 0; dd < 4; ++dd) S[hf * 4 + dd] = S[hf * 4 + dd] * e1v[dd] + u[dd] * e2v[dd];
              __builtin_amdgcn_sched_barrier(0); } }
    }
    LDS_BAR();
    HG_FLUSH(nch - 1);
    LDS_BAR();
#undef HG_LOAD
#undef HG_FLUSH
}

typedef float f32x16 __attribute__((ext_vector_type(16)));
constexpr int H2_QS = 0, H2_KT = 17408, H2_VT = 35840, H2_AS = 54272, H2_E1 = 63488, H2_E2 = 64000, H2_E3 = 64512, H2_BUF = 65024, H2_KS = 2 * H2_BUF;
__device__ __forceinline__ int dperm16(int d) { return (d & ~15) | (((d >> 2) & 1) << 3) | (((d >> 3) & 1) << 2) | (d & 3); }
__device__ __forceinline__ void hgrn_item_ws(const Frame& F, const Args& a, int it) {
    unsigned char* ws = a.ws;
    int s0, T;
    if (it < 128) { s0 = M_P + (it >> 3) * T_S; T = T_S; } else { s0 = ((it - 128) >> 3) * T_P; T = T_P; }
    const int head = (it >> 1) & 3, dir = it & 1;
    const bf16* QH = (const bf16*)(ws + WS_QH); const bf16* G = (const bf16*)(ws + (dir ? WS_GB : WS_GF)); const bf16* IH = (const bf16*)(ws + WS_IH);
    bf16* O = (bf16*)a.out + (dir ? (size_t)M * 512 : 0);
    const int w = F.wave, nch = T / 64;
    const unsigned L0 = (unsigned)(uintptr_t)F.lds;
    const bf16* Gb = G + (size_t)s0 * 512 + head * 128; const bf16* Qb = QH + (size_t)s0 * 512 + head * 128; const bf16* Vb = IH + (size_t)s0 * 512 + head * 128;
    bf16* Ob = O + (size_t)s0 * 512 + head * 128;
    const int rstep = dir ? -512 : 512;
    const int pw = w & 3, cp = F.lane & 15, rq = F.lane >> 4, d0 = 32 * pw + 2 * cp, pd0 = dperm16(d0);
    const int r = F.lane & 15, q4 = F.lane >> 4, r32 = F.lane & 31, hi = F.lane >> 5;
    const bool prod = w >= 4;
    unsigned R0 = prod ? L0 + pd0 * 2 + rq * 4352 : L0 + (32 * w + r32) * 144 + hi * 16;
    unsigned R1 = prod ? L0 + d0 * 144 + rq * 32 : L0 + r32 * 144 + hi * 16;
    unsigned R2 = prod ? L0 + d0 * 4 : L0 + r32 * 272 + hi * 16;
    unsigned R3 = prod ? L0 + r * 272 + q4 * 16 + pw * 4352 : L0 + hi * 16;
    unsigned R4 = L0 + H2_KS + r * 272 + q4 * 16, R5 = L0 + q4 * 576 + r * 2 + pw * 2304;
    asm volatile("" : "+v"(R0), "+v"(R1), "+v"(R2), "+v"(R3), "+v"(R4), "+v"(R5));
#define pQ R0
#define cV R0
#define pK R1
#define cA R1
#define pE R2
#define cQ R2
#define rAc R3
#define cE R3
#define rKc R4
#define pAs R5
    const int roff0 = (dir ? (T - 1 - rq * 16) : rq * 16) * 512 + d0;
    typedef unsigned u32x16_ __attribute__((ext_vector_type(16)));
#define g2(i_) SU[0][i_]
#define q2(i_) SU[1][i_]
#define v2(i_) SU[2][i_]
    u32x16_ SU[4];
#pragma unroll
    for (int i = 0; i < 4; ++i)
#pragma unroll
        for (int k = 0; k < 16; ++k) SU[i][k] = 0u;
#define H2_LOAD(c) do { const int o0_ = roff0 + (c) * 64 * rstep; _Pragma("unroll") for (int ii = 0; ii < 16; ++ii) { const unsigned o_ = (unsigned)(o0_ + ii * rstep); \
        SU[0][ii] = *(const unsigned*)(Gb + o_); SU[1][ii] = *(const unsigned*)(Qb + o_); SU[2][ii] = *(const unsigned*)(Vb + o_); } } while (0)
#define H2_PROD_B(bo) do { \
        float ra = 0.f, rb = 0.f; \
        _Pragma("unroll") for (int ii = 0; ii < 16; ++ii) { ra += bflo(g2(ii)) * LOG2E; rb += bfhi(g2(ii)) * LOG2E; } \
        const float ta0 = __shfl(ra, cp), ta1 = __shfl(ra, 16 + cp), ta2 = __shfl(ra, 32 + cp), ta3 = __shfl(ra, 48 + cp); \
        const float tb0 = __shfl(rb, cp), tb1 = __shfl(rb, 16 + cp), tb2 = __shfl(rb, 32 + cp), tb3 = __shfl(rb, 48 + cp); \
        const float brefA = ta0 + ta1, brefB = tb0 + tb1, blastA = brefA + (ta2 + ta3), blastB = brefB + (tb2 + tb3); \
        const float offA = (rq == 0 ? 0.f : (rq == 1 ? ta0 : (rq == 2 ? ta0 + ta1 : ta0 + ta1 + ta2))) - brefA; \
        const float offB = (rq == 0 ? 0.f : (rq == 1 ? tb0 : (rq == 2 ? tb0 + tb1 : tb0 + tb1 + tb2))) - brefB; \
        unsigned ktA[8], ktB[8], vtA[8], vtB[8]; float kpa = 0.f, kpb = 0.f; \
        float xa = offA, xb = offB; \
        _Pragma("unroll") for (int ii = 0; ii < 16; ++ii) { xa += bflo(g2(ii)) * LOG2E; xb += bfhi(g2(ii)) * LOG2E; \
            const float fa = __builtin_amdgcn_exp2f(bflo(g2(ii)) * LOG2E), fb = __builtin_amdgcn_exp2f(bfhi(g2(ii)) * LOG2E); \
            const float qa = bflo(q2(ii)) * __builtin_amdgcn_exp2f(fminf(xa, 115.0f)), qb = bfhi(q2(ii)) * __builtin_amdgcn_exp2f(fminf(xb, 115.0f)); \
            const float ka = (1.0f - fa) * __builtin_amdgcn_exp2f(fminf(-xa, 115.0f)), kb = (1.0f - fb) * __builtin_amdgcn_exp2f(fminf(-xb, 115.0f)); \
            *LDSP(unsigned, pQ, (bo) + H2_QS + ii * 272) = pg8::cvt_pk_bf16(qa, qb); *LDSP(unsigned, pQ, H2_KS + ii * 272) = pg8::cvt_pk_bf16(ka, kb); \
            if (ii & 1) { ktA[ii >> 1] = pg8::cvt_pk_bf16(kpa, ka); ktB[ii >> 1] = pg8::cvt_pk_bf16(kpb, kb); vtA[ii >> 1] = (v2(ii - 1) & 0xffffu) | (v2(ii) << 16); vtB[ii >> 1] = (v2(ii - 1) >> 16) | (v2(ii) & 0xffff0000u); } \
            else { kpa = ka; kpb = kb; } } \
        *LDSP(v4u, pK, (bo) + H2_KT) = (v4u){ktA[0], ktA[1], ktA[2], ktA[3]}; *LDSP(v4u, pK, (bo) + H2_KT + 16) = (v4u){ktA[4], ktA[5], ktA[6], ktA[7]}; \
        *LDSP(v4u, pK, (bo) + H2_KT + 144) = (v4u){ktB[0], ktB[1], ktB[2], ktB[3]}; *LDSP(v4u, pK, (bo) + H2_KT + 160) = (v4u){ktB[4], ktB[5], ktB[6], ktB[7]}; \
        *LDSP(v4u, pK, (bo) + H2_VT) = (v4u){vtA[0], vtA[1], vtA[2], vtA[3]}; *LDSP(v4u, pK, (bo) + H2_VT + 16) = (v4u){vtA[4], vtA[5], vtA[6], vtA[7]}; \
        *LDSP(v4u, pK, (bo) + H2_VT + 144) = (v4u){vtB[0], vtB[1], vtB[2], vtB[3]}; *LDSP(v4u, pK, (bo) + H2_VT + 160) = (v4u){vtB[4], vtB[5], vtB[6], vtB[7]}; \
        if (rq == 0) { typedef float f32x2_ __attribute__((ext_vector_type(2))); \
            *LDSP(f32x2_, pE, (bo) + H2_E1) = (f32x2_){__builtin_amdgcn_exp2f(fminf(blastA, 115.0f)), __builtin_amdgcn_exp2f(fminf(blastB, 115.0f))}; \
            *LDSP(f32x2_, pE, (bo) + H2_E2) = (f32x2_){__builtin_amdgcn_exp2f(fminf(blastA - brefA, 115.0f)), __builtin_amdgcn_exp2f(fminf(blastB - brefB, 115.0f))}; \
            *LDSP(f32x2_, pE, (bo) + H2_E3) = (f32x2_){__builtin_amdgcn_exp2f(fminf(brefA, 115.0f)), __builtin_amdgcn_exp2f(fminf(brefB, 115.0f))}; } } while (0)
#define H2_PROD_A(bo) do { _Pragma("unroll") for (int tj = 0; tj < 4; ++tj) { pg8::f32x4 acc = (pg8::f32x4){0.f, 0.f, 0.f, 0.f}; \
        if (tj <= pw) { bf16x8 af[4], bfr[4]; \
            _Pragma("unroll") for (int ks = 0; ks < 4; ++ks) { af[ks] = *LDSP(bf16x8, rAc, (bo) + H2_QS + ks * 64); bfr[ks] = *LDSP(bf16x8, rKc, tj * 4352 + ks * 64); } \
            _Pragma("unroll") for (int ks = 0; ks < 4; ++ks) acc = __builtin_amdgcn_mfma_f32_16x16x32_bf16(af[ks], bfr[ks], acc, 0, 0, 0); } \
        _Pragma("unroll") for (int rg = 0; rg < 4; ++rg) { const int i_ = 16 * pw + 4 * q4 + rg, j_ = 16 * tj + r; *LDSP(bf16, pAs, (bo) + H2_AS + tj * 32 + rg * 144) = (bf16)f2bf(j_ <= i_ ? acc[rg] : 0.f); } } } while (0)
    if (prod) { H2_LOAD(0); H2_PROD_B(0); if (nch > 1) H2_LOAD(1); }
    LDS_BAR();
    if (prod) { H2_PROD_A(0); }
    LDS_BAR();
    for (int c = 0; c < nch; ++c) {
        const int bo = (c & 1) * H2_BUF, bn = H2_BUF - bo;
        if (prod) { if (c + 1 < nch) { H2_PROD_B(bn); if (c + 2 < nch) H2_LOAD(c + 2); } }
        else {
            bf16x8 sB[8];
#pragma unroll
            for (int dt = 0; dt < 4; ++dt) { pg8::f32x4 e[4]; const f32x16 Sd = __builtin_bit_cast(f32x16, SU[dt]);
#pragma unroll
                for (int g = 0; g < 4; ++g) e[g] = *LDSP(pg8::f32x4, cE, bo + H2_E3 + (32 * dt + 8 * g) * 4);
#pragma unroll
                for (int s = 0; s < 2; ++s) { v4u pw_;
                    pw_.x = pg8::cvt_pk_bf16(Sd[8 * s + 0] * e[2 * s][0], Sd[8 * s + 1] * e[2 * s][1]); pw_.y = pg8::cvt_pk_bf16(Sd[8 * s + 2] * e[2 * s][2], Sd[8 * s + 3] * e[2 * s][3]);
                    pw_.z = pg8::cvt_pk_bf16(Sd[8 * s + 4] * e[2 * s + 1][0], Sd[8 * s + 5] * e[2 * s + 1][1]); pw_.w = pg8::cvt_pk_bf16(Sd[8 * s + 6] * e[2 * s + 1][2], Sd[8 * s + 7] * e[2 * s + 1][3]);
                    sB[dt * 2 + s] = __builtin_bit_cast(bf16x8, pw_); } }
#pragma unroll
            for (int tt = 0; tt < 2; ++tt) { f32x16 o;
#pragma unroll
                for (int k = 0; k < 16; ++k) o[k] = 0.f;
                { bf16x8 aA[4], vB[4];
#pragma unroll
                  for (int ks = 0; ks < 4; ++ks) { vB[ks] = *LDSP(bf16x8, cV, bo + H2_VT + ks * 32); aA[ks] = *LDSP(bf16x8, cA, bo + H2_AS + tt * 4608 + ks * 32); }
#pragma unroll
                  for (int ks = 0; ks < 4; ++ks) o = __builtin_amdgcn_mfma_f32_32x32x16_bf16(vB[ks], aA[ks], o, 0, 0, 0); }
#pragma unroll
                for (int hf = 0; hf < 2; ++hf) { bf16x8 aQ[4];
#pragma unroll
                    for (int k4 = 0; k4 < 4; ++k4) aQ[k4] = *LDSP(bf16x8, cQ, bo + H2_QS + tt * 8704 + (hf * 4 + k4) * 32);
#pragma unroll
                    for (int k4 = 0; k4 < 4; ++k4) o = __builtin_amdgcn_mfma_f32_32x32x16_bf16(sB[hf * 4 + k4], aQ[k4], o, 0, 0, 0); }
                { const int tk = c * 64 + 32 * tt + r32; const int t_ = dir ? T - 1 - tk : tk; bf16* orow = Ob + (size_t)t_ * 512 + 32 * w + 4 * hi;
#pragma unroll
                  for (int g = 0; g < 4; ++g) { v2u w2; w2.x = pk2(o[4 * g + 0], o[4 * g + 1]); w2.y = pk2(o[4 * g + 2], o[4 * g + 3]); *(v2u*)(orow + 8 * g) = w2; } } }
        }
        LDS_BAR();
        if (prod) { if (c + 1 < nch) { H2_PROD_A(bn); } }
        else { bf16x8 vB[4];
#pragma unroll
            for (int ks = 0; ks < 4; ++ks) vB[ks] = *LDSP(bf16x8, cV, bo + H2_VT + ks * 32);
#pragma unroll
            for (int dt = 0; dt < 4; ++dt) { bf16x8 aK[4]; pg8::f32x4 e1v[4], e2v[4];
#pragma unroll
                for (int ks = 0; ks < 4; ++ks) aK[ks] = *LDSP(bf16x8, cA, bo + H2_KT + dt * 4608 + ks * 32);
#pragma unroll
                for (int g = 0; g < 4; ++g) { e1v[g] = *LDSP(pg8::f32x4, cE, bo + H2_E1 + (32 * dt + 8 * g) * 4); e2v[g] = *LDSP(pg8::f32x4, cE, bo + H2_E2 + (32 * dt + 8 * g) * 4); }
                f32x16 u;
#pragma unroll
                for (int k = 0; k < 16; ++k) u[k] = 0.f;
#pragma unroll
                for (int ks = 0; ks < 4; ++ks) u = __builtin_amdgcn_mfma_f32_32x32x16_bf16(aK[ks], vB[ks], u, 0, 0, 0);
                f32x16 Sd = __builtin_bit_cast(f32x16, SU[dt]);
#pragma unroll
                for (int k = 0; k < 16; ++k) Sd[k] = Sd[k] * e1v[k >> 2][k & 3] + u[k] * e2v[k >> 2][k & 3];
                SU[dt] = __builtin_bit_cast(u32x16_, Sd);
                __builtin_amdgcn_sched_barrier(0); }
        }
        LDS_BAR();
    }
#undef H2_LOAD
#undef H2_PROD_B
#undef H2_PROD_A
#undef pQ
#undef cV
#undef pK
#undef cA
#undef pE
#undef cQ
#undef rAc
#undef cE
#undef rKc
#undef pAs
#undef g2
#undef q2
#undef v2
}
__device__ __forceinline__ void attn_item_naive(const Frame& F, const Args& a, int ib) {
    unsigned char* ws = a.ws;
    const bf16* QA = (const bf16*)(ws + WS_QA); const bf16* KA = (const bf16*)(ws + WS_KA); const bf16* VT = (const bf16*)(ws + WS_VT); bf16* MIX = (bf16*)(ws + WS_MIX);
    const int tok = F.tid & 63, head = F.tid >> 6, kvh = head >> 2, m = ib * 64 + tok;
    int s0, T; if (m < M_P) { T = T_P; s0 = m & ~(T_P - 1); } else { T = T_S; s0 = M_P + ((m - M_P) & ~(T_S - 1)); }
    const int t = m - s0;
    float q[64], o[64];
#pragma unroll
    for (int c = 0; c < 8; ++c) { const v4u w = *(const v4u*)(QA + qk_off(m, head, c >> 1, c & 1));
        q[c * 8 + 0] = bflo(w.x); q[c * 8 + 1] = bfhi(w.x); q[c * 8 + 2] = bflo(w.y); q[c * 8 + 3] = bfhi(w.y); q[c * 8 + 4] = bflo(w.z); q[c * 8 + 5] = bfhi(w.z); q[c * 8 + 6] = bflo(w.w); q[c * 8 + 7] = bfhi(w.w); }
#pragma unroll
    for (int d = 0; d < 64; ++d) o[d] = 0.f;
    float mx = a.in[7][head] * LOG2E, l = 1.0f;
    const float slope2 = __builtin_amdgcn_exp2f(-(float)(head + 1)) * LOG2E;
    const int lo = t - 128 < 0 ? 0 : t - 128, hi = t + 128 > T - 1 ? T - 1 : t + 128;
    for (int s = lo; s <= hi; ++s) {
        const int ms = s0 + s; float dot = 0.f;
#pragma unroll
        for (int c = 0; c < 8; ++c) { const v4u w = *(const v4u*)(KA + qk_off(ms, kvh, c >> 1, c & 1));
            dot += q[c * 8 + 0] * bflo(w.x) + q[c * 8 + 1] * bfhi(w.x) + q[c * 8 + 2] * bflo(w.y) + q[c * 8 + 3] * bfhi(w.y) + q[c * 8 + 4] * bflo(w.z) + q[c * 8 + 5] * bfhi(w.z) + q[c * 8 + 6] * bflo(w.w) + q[c * 8 + 7] * bfhi(w.w); }
        const int rel = s - t; const float lg = dot - slope2 * (float)(rel < 0 ? -rel : rel);
        const float mn = fmaxf(mx, lg), corr = __builtin_amdgcn_exp2f(mx - mn), p = __builtin_amdgcn_exp2f(lg - mn);
        l = l * corr + p; mx = mn;
        const bf16* vp = VT + vt_off(ms, kvh, 0);
#pragma unroll
        for (int d = 0; d < 64; ++d) o[d] = o[d] * corr + p * bf2f(vp[d * 16]);
    }
    const float inv = 1.0f / l; float ss = 0.f;
#pragma unroll
    for (int d = 0; d < 64; ++d) { o[d] *= inv; ss += o[d] * o[d]; }
    LAS float* red = (LAS float*)F.lds;
    red[head * 64 + tok] = ss;
    __syncthreads();
    float tot = 0.f;
#pragma unroll
    for (int h = 0; h < 8; ++h) tot += red[h * 64 + tok];
    const float rstd = 1.0f / sqrtf(tot * (1.0f / 512.0f) + EPS);
    const float* ng = a.in[8] + head * 64;
#pragma unroll
    for (int c = 0; c < 8; ++c) { v4u w; w.x = pk2v(o[c * 8 + 0] * rstd * ng[c * 8 + 0], o[c * 8 + 1] * rstd * ng[c * 8 + 1]); w.y = pk2v(o[c * 8 + 2] * rstd * ng[c * 8 + 2], o[c * 8 + 3] * rstd * ng[c * 8 + 3]);
        w.z = pk2v(o[c * 8 + 4] * rstd * ng[c * 8 + 4], o[c * 8 + 5] * rstd * ng[c * 8 + 5]); w.w = pk2v(o[c * 8 + 6] * rstd * ng[c * 8 + 6], o[c * 8 + 7] * rstd * ng[c * 8 + 7]);
        *(v4u*)(MIX + (size_t)m * D + head * 64 + c * 8) = w; }
    __syncthreads();
}

typedef float f32x16 __attribute__((ext_vector_type(16)));
__device__ __forceinline__ void attn_item_mfma(const Frame& F, const Args& a, int ib) {
    unsigned char* ws = a.ws;
    const bf16* QA = (const bf16*)(ws + WS_QA); const bf16* KA = (const bf16*)(ws + WS_KA); const bf16* VT = (const bf16*)(ws + WS_VT); bf16* MIX = (bf16*)(ws + WS_MIX);
    const int head = F.wave, kvh = head >> 2, r32 = F.lane & 31, hi = F.lane >> 5, m0 = ib * 32;
    int s0, T; if (m0 < M_P) { T = T_P; s0 = m0 & ~(T_P - 1); } else { T = T_S; s0 = M_P + ((m0 - M_P) & ~(T_S - 1)); }
    const int t0 = m0 - s0;
    const bf16* qb = QA + (((size_t)head * NT32 + ib) * 4) * 512 + r32 * 16 + hi * 8;
    bf16x8 qr[4];
#pragma unroll
    for (int d0 = 0; d0 < 4; ++d0) qr[d0] = *(const bf16x8*)(qb + d0 * 512);
    f32x16 o0, o1;
#pragma unroll
    for (int r = 0; r < 16; ++r) { o0[r] = 0.f; o1[r] = 0.f; }
    float mrun = a.in[7][head] * LOG2E, l = hi == 0 ? 1.0f : 0.0f;
    const float slope2 = __builtin_amdgcn_exp2f(-(float)(head + 1)) * LOG2E;
    const int i_lo = t0 >= 128 ? 0 : (128 - t0) >> 5; int i_hi = (T - t0 + 96) >> 5; i_hi = i_hi > 8 ? 8 : i_hi;
    for (int i = i_lo; i <= i_hi; ++i) {
        const int kt = ib - 4 + i;
        const bf16* kb = KA + (((size_t)kvh * NT32 + kt) * 4) * 512 + r32 * 16 + hi * 8;
        f32x16 s;
#pragma unroll
        for (int r = 0; r < 16; ++r) s[r] = 0.f;
#pragma unroll
        for (int d0 = 0; d0 < 4; ++d0) { const bf16x8 kf = *(const bf16x8*)(kb + d0 * 512); s = __builtin_amdgcn_mfma_f32_32x32x16_bf16(kf, qr[d0], s, 0, 0, 0); }
        const int relb = 32 * (i - 4) - r32 + 4 * hi;
        float mx = -1e30f;
#pragma unroll
        for (int r = 0; r < 16; ++r) { const int rel = relb + (r & 3) + 8 * (r >> 2); const int ar = rel < 0 ? -rel : rel; float lg = s[r] - slope2 * (float)ar; lg = ar <= 128 ? lg : -1e30f; s[r] = lg; mx = fmaxf(mx, lg); }
        mx = fmaxf(mx, __shfl_xor(mx, 32));
        const float mnew = fmaxf(mrun, mx), corr = __builtin_amdgcn_exp2f(mrun - mnew); mrun = mnew;
        float ps = 0.f;
#pragma unroll
        for (int r = 0; r < 16; ++r) { s[r] = __builtin_amdgcn_exp2f(s[r] - mnew); ps += s[r]; }
        l = l * corr + ps;
#pragma unroll
        for (int r = 0; r < 16; ++r) { o0[r] *= corr; o1[r] *= corr; }
#pragma unroll
        for (int ks = 0; ks < 2; ++ks) {
            v4u pw; pw.x = pg8::cvt_pk_bf16(s[8 * ks + 0], s[8 * ks + 1]); pw.y = pg8::cvt_pk_bf16(s[8 * ks + 2], s[8 * ks + 3]); pw.z = pg8::cvt_pk_bf16(s[8 * ks + 4], s[8 * ks + 5]); pw.w = pg8::cvt_pk_bf16(s[8 * ks + 6], s[8 * ks + 7]);
            const bf16x8 pb = __builtin_bit_cast(bf16x8, pw);
            const bf16* vb = VT + (((size_t)kvh * NT16 + kt * 2 + ks) * 64 + r32) * 16 + hi * 8;
            const bf16x8 v0 = *(const bf16x8*)(vb), v1 = *(const bf16x8*)(vb + 32 * 16);
            o0 = __builtin_amdgcn_mfma_f32_32x32x16_bf16(v0, pb, o0, 0, 0, 0);
            o1 = __builtin_amdgcn_mfma_f32_32x32x16_bf16(v1, pb, o1, 0, 0, 0);
        }
    }
    l += __shfl_xor(l, 32);
    const float inv = 1.0f / l; float ss = 0.f;
#pragma unroll
    for (int r = 0; r < 16; ++r) { o0[r] *= inv; o1[r] *= inv; ss += o0[r] * o0[r] + o1[r] * o1[r]; }
    ss += __shfl_xor(ss, 32);
    LAS float* red = (LAS float*)F.lds;
    if (hi == 0) red[head * 32 + r32] = ss;
    __syncthreads();
    float tot = 0.f;
#pragma unroll
    for (int h = 0; h < 8; ++h) tot += red[h * 32 + r32];
    const float rstd = 1.0f / sqrtf(tot * (1.0f / 512.0f) + EPS);
    const float* ng = a.in[8] + head * 64 + 4 * hi;
    bf16* orow = MIX + (size_t)(m0 + r32) * D + head * 64 + 4 * hi;
#pragma unroll
    for (int g = 0; g < 4; ++g) {
        const f32x4 g0 = *(const f32x4*)(ng + 8 * g), g1 = *(const f32x4*)(ng + 32 + 8 * g);
        v2u w0, w1; w0.x = pk2v(o0[4 * g + 0] * rstd * g0.x, o0[4 * g + 1] * rstd * g0.y); w0.y = pk2v(o0[4 * g + 2] * rstd * g0.z, o0[4 * g + 3] * rstd * g0.w);
        w1.x = pk2v(o1[4 * g + 0] * rstd * g1.x, o1[4 * g + 1] * rstd * g1.y); w1.y = pk2v(o1[4 * g + 2] * rstd * g1.z, o1[4 * g + 3] * rstd * g1.w);
        *(v2u*)(orow + 8 * g) = w0; *(v2u*)(orow + 32 + 8 * g) = w1;
    }
    __syncthreads();
}

__device__ __forceinline__ void attn_qblock(const bf16x8 (&kf)[4], const bf16x8 (&vf)[4], const bf16x8 (&qr)[4], int dtile, int dl, float slope2, const float (&cs)[16], f32x16& o0, f32x16& o1, float& mrun, float& l) {
    f32x16 s; const float dlf = (float)dl;
    if (dtile < 0) { const float base = slope2 * ((float)(32 * dtile) + dlf);
#pragma unroll
        for (int r = 0; r < 16; ++r) s[r] = base + cs[r]; }
    else if (dtile > 0) { const float base = -slope2 * ((float)(32 * dtile) + dlf);
#pragma unroll
        for (int r = 0; r < 16; ++r) s[r] = base - cs[r]; }
    else { const float base = slope2 * dlf;
#pragma unroll
        for (int r = 0; r < 16; ++r) s[r] = -__builtin_fabsf(base + cs[r]); }
#pragma unroll
    for (int d0 = 0; d0 < 4; ++d0) s = __builtin_amdgcn_mfma_f32_32x32x16_bf16(kf[d0], qr[d0], s, 0, 0, 0);
    if (dtile == -4) {
#pragma unroll
        for (int r = 0; r < 16; ++r) s[r] = ((r & 3) + 8 * (r >> 2) + dl >= 0) ? s[r] : -1e30f; }
    if (dtile == 4) {
#pragma unroll
        for (int r = 0; r < 16; ++r) s[r] = ((r & 3) + 8 * (r >> 2) + dl <= 0) ? s[r] : -1e30f; }
    float mx = __builtin_fmaxf(__builtin_fmaxf(s[0], s[1]), s[2]);
#pragma unroll
    for (int r = 3; r < 15; r += 2) mx = __builtin_fmaxf(__builtin_fmaxf(mx, s[r]), s[r + 1]);
    mx = __builtin_fmaxf(mx, s[15]);
    mx = __builtin_fmaxf(mx, __shfl_xor(mx, 32));
    if (__builtin_amdgcn_ballot_w64(mx > mrun) != 0ull) {
        const float mnew = __builtin_fmaxf(mrun, mx), corr = __builtin_amdgcn_exp2f(mrun - mnew); mrun = mnew; l *= corr;
#pragma unroll
        for (int r = 0; r < 16; ++r) { o0[r] *= corr; o1[r] *= corr; } }
    float ps = 0.f;
#pragma unroll
    for (int r = 0; r < 16; ++r) { s[r] = __builtin_amdgcn_exp2f(s[r] - mrun); ps += s[r]; }
    l += ps;
#pragma unroll
    for (int ks = 0; ks < 2; ++ks) {
        v4u pw; pw.x = pg8::cvt_pk_bf16(s[8 * ks + 0], s[8 * ks + 1]); pw.y = pg8::cvt_pk_bf16(s[8 * ks + 2], s[8 * ks + 3]); pw.z = pg8::cvt_pk_bf16(s[8 * ks + 4], s[8 * ks + 5]); pw.w = pg8::cvt_pk_bf16(s[8 * ks + 6], s[8 * ks + 7]);
        const bf16x8 pb = __builtin_bit_cast(bf16x8, pw);
        o0 = __builtin_amdgcn_mfma_f32_32x32x16_bf16(vf[ks * 2 + 0], pb, o0, 0, 0, 0);
        o1 = __builtin_amdgcn_mfma_f32_32x32x16_bf16(vf[ks * 2 + 1], pb, o1, 0, 0, 0);
    }
}
__device__ __forceinline__ void attn_item_mfma2(const Frame& F, const Args& a, int ib) {
    unsigned char* ws = a.ws;
    const bf16* QA = (const bf16*)(ws + WS_QA); const bf16* KA = (const bf16*)(ws + WS_KA); const bf16* VT = (const bf16*)(ws + WS_VT); bf16* MIX = (bf16*)(ws + WS_MIX);
    const int head = F.wave, kvh = head >> 2, r32 = F.lane & 31, hi = F.lane >> 5, m0 = ib * 64;
    int s0, T; if (m0 < M_P) { T = T_P; s0 = m0 & ~(T_P - 1); } else { T = T_S; s0 = M_P + ((m0 - M_P) & ~(T_S - 1)); }
    const int t0 = m0 - s0;
    const int lofs = r32 * 16 + hi * 8;
    bf16x8 qa[4], qb[4];
    { const bf16* q0 = QA + (((size_t)head * NT32 + 2 * ib) * 4) * 512 + lofs;
#pragma unroll
      for (int d0 = 0; d0 < 4; ++d0) { qa[d0] = *(const bf16x8*)(q0 + d0 * 512); qb[d0] = *(const bf16x8*)(q0 + 2048 + d0 * 512); } }
    f32x16 oa0, oa1, ob0, ob1;
#pragma unroll
    for (int r = 0; r < 16; ++r) { oa0[r] = 0.f; oa1[r] = 0.f; ob0[r] = 0.f; ob1[r] = 0.f; }
    const float sink2 = a.in[7][head] * LOG2E;
    float ma = sink2, mb = sink2, la = hi == 0 ? 1.0f : 0.0f, lb = la;
    const float slope2 = __builtin_amdgcn_exp2f(-(float)(head + 1)) * LOG2E;
    const int i_lo = t0 >= 128 ? 0 : (128 - t0) >> 5; int i_hi = (T - t0 + 96) >> 5; i_hi = i_hi > 9 ? 9 : i_hi;
    const bf16* kbase = KA + (((size_t)kvh * NT32 + (2 * ib - 4)) * 4) * 512 + lofs;
    const bf16* vbase = VT + (((size_t)kvh * NT16 + (size_t)(2 * ib - 4) * 2) * 64) * 16 + lofs;
    bf16x8 kf[4], vf[4];
    LAS unsigned char* ring = F.lds + F.wave * 16384;
#define AT_DMA(slot_, i_) do { const bf16* kp_ = kbase + (ptrdiff_t)(i_) * 2048; const bf16* vp_ = vbase + (ptrdiff_t)(i_) * 2048; \
        _Pragma("unroll") for (int d0 = 0; d0 < 4; ++d0) { \
            __builtin_amdgcn_global_load_lds((const unsigned*)(kp_ + d0 * 512), (LAS unsigned*)(ring + (slot_) * 8192 + d0 * 1024), 16, 0, 0); \
            __builtin_amdgcn_global_load_lds((const unsigned*)(vp_ + d0 * 512), (LAS unsigned*)(ring + (slot_) * 8192 + 4096 + d0 * 1024), 16, 0, 0); } } while (0)
    AT_DMA(0, i_lo);
    if (i_lo + 1 <= i_hi) AT_DMA(1, i_lo + 1);
    const int relq = -r32 + 4 * hi;
    float cs[16];
#pragma unroll
    for (int r = 0; r < 16; ++r) cs[r] = slope2 * (float)((r & 3) + 8 * (r >> 2));
    for (int i = i_lo; i <= i_hi; ++i) {
        const int sl = (i - i_lo) & 1;
        if (i < i_hi) asm volatile("s_waitcnt vmcnt(8)" ::: "memory"); else asm volatile("s_waitcnt vmcnt(0)" ::: "memory");
        { const LAS unsigned char* sp = ring + sl * 8192 + F.lane * 16;
#pragma unroll
          for (int d0 = 0; d0 < 4; ++d0) { kf[d0] = *(const LAS bf16x8*)(sp + d0 * 1024); vf[d0] = *(const LAS bf16x8*)(sp + 4096 + d0 * 1024); } }
        asm volatile("s_waitcnt lgkmcnt(0)" ::: "memory");
        if (i + 2 <= i_hi) AT_DMA(sl, i + 2);
        if (i <= 8) attn_qblock(kf, vf, qa, i - 4, relq, slope2, cs, oa0, oa1, ma, la);
        if (i >= 1) attn_qblock(kf, vf, qb, i - 5, relq, slope2, cs, ob0, ob1, mb, lb);
    }
#undef AT_DMA
    la += __shfl_xor(la, 32); lb += __shfl_xor(lb, 32);
    const float ia = 1.0f / la, ibv = 1.0f / lb; float ssa = 0.f, ssb = 0.f;
#pragma unroll
    for (int r = 0; r < 16; ++r) { oa0[r] *= ia; oa1[r] *= ia; ob0[r] *= ibv; ob1[r] *= ibv; ssa += oa0[r] * oa0[r] + oa1[r] * oa1[r]; ssb += ob0[r] * ob0[r] + ob1[r] * ob1[r]; }
    ssa += __shfl_xor(ssa, 32); ssb += __shfl_xor(ssb, 32);
    LAS float* red = (LAS float*)(F.lds + 131072);
    if (hi == 0) { red[head * 64 + r32] = ssa; red[head * 64 + 32 + r32] = ssb; }
    __syncthreads();
    float ta = 0.f, tb = 0.f;
#pragma unroll
    for (int h = 0; h < 8; ++h) { ta += red[h * 64 + r32]; tb += red[h * 64 + 32 + r32]; }
    const float ra = 1.0f / sqrtf(ta * (1.0f / 512.0f) + EPS), rb = 1.0f / sqrtf(tb * (1.0f / 512.0f) + EPS);
    const float* ng = a.in[8] + head * 64 + 4 * hi;
    bf16* orow = MIX + (size_t)(m0 + r32) * D + head * 64 + 4 * hi;
#pragma unroll
    for (int g = 0; g < 4; ++g) {
        const f32x4 g0 = *(const f32x4*)(ng + 8 * g), g1 = *(const f32x4*)(ng + 32 + 8 * g);
        v2u w0, w1; w0.x = pk2v(oa0[4 * g + 0] * ra * g0.x, oa0[4 * g + 1] * ra * g0.y); w0.y = pk2v(oa0[4 * g + 2] * ra * g0.z, oa0[4 * g + 3] * ra * g0.w);
        w1.x = pk2v(oa1[4 * g + 0] * ra * g1.x, oa1[4 * g + 1] * ra * g1.y); w1.y = pk2v(oa1[4 * g + 2] * ra * g1.z, oa1[4 * g + 3] * ra * g1.w);
        *(v2u*)(orow + 8 * g) = w0; *(v2u*)(orow + 32 + 8 * g) = w1;
        w0.x = pk2v(ob0[4 * g + 0] * rb * g0.x, ob0[4 * g + 1] * rb * g0.y); w0.y = pk2v(ob0[4 * g + 2] * rb * g0.z, ob0[4 * g + 3] * rb * g0.w);
        w1.x = pk2v(ob1[4 * g + 0] * rb * g1.x, ob1[4 * g + 1] * rb * g1.y); w1.y = pk2v(ob1[4 * g + 2] * rb * g1.z, ob1[4 * g + 3] * rb * g1.w);
        *(v2u*)(orow + 32 * D + 8 * g) = w0; *(v2u*)(orow + 32 * D + 32 + 8 * g) = w1;
    }
    __syncthreads();
}
__device__ __forceinline__ void hg_finalize(const Frame& F, const Args& a) {
    unsigned char* ws = a.ws;
    const bf16* OF = (const bf16*)a.out; const bf16* OB = OF + (size_t)M * 512; const bf16* GH = (const bf16*)(ws + WS_GH); bf16* MIX = (bf16*)(ws + WS_MIX);
    const int gw = F.bid * NWAVES + F.wave, NGW = F.G * NWAVES;
    float ng[8];
#pragma unroll
    for (int i = 0; i < 8; ++i) ng[i] = a.in[11][F.lane * 8 + i];
    for (int m2 = gw * 2; m2 < M; m2 += NGW * 2) {
        v4u wf[2], wb[2], wg[2];
#pragma unroll
        for (int rr = 0; rr < 2; ++rr) { const size_t idx = (size_t)(m2 + rr) * 512 + F.lane * 8; wf[rr] = __builtin_nontemporal_load((const v4u*)(OF + idx)); wb[rr] = __builtin_nontemporal_load((const v4u*)(OB + idx)); wg[rr] = __builtin_nontemporal_load((const v4u*)(GH + idx)); }
#pragma unroll
        for (int rr = 0; rr < 2; ++rr) {
            float o[8], gt[8];
            o[0] = bflo(wf[rr].x) + bflo(wb[rr].x); o[1] = bfhi(wf[rr].x) + bfhi(wb[rr].x); o[2] = bflo(wf[rr].y) + bflo(wb[rr].y); o[3] = bfhi(wf[rr].y) + bfhi(wb[rr].y);
            o[4] = bflo(wf[rr].z) + bflo(wb[rr].z); o[5] = bfhi(wf[rr].z) + bfhi(wb[rr].z); o[6] = bflo(wf[rr].w) + bflo(wb[rr].w); o[7] = bfhi(wf[rr].w) + bfhi(wb[rr].w);
            gt[0] = bflo(wg[rr].x); gt[1] = bfhi(wg[rr].x); gt[2] = bflo(wg[rr].y); gt[3] = bfhi(wg[rr].y); gt[4] = bflo(wg[rr].z); gt[5] = bfhi(wg[rr].z); gt[6] = bflo(wg[rr].w); gt[7] = bfhi(wg[rr].w);
            float ss = 0.f;
#pragma unroll
            for (int i = 0; i < 8; ++i) ss += o[i] * o[i];
            ss += __shfl_xor(ss, 1); ss += __shfl_xor(ss, 2); ss += __shfl_xor(ss, 4); ss += __shfl_xor(ss, 8);
            const float rstd = 1.0f / sqrtf(ss * (1.0f / 128.0f) + EPS);
            float y[8];
#pragma unroll
            for (int i = 0; i < 8; ++i) y[i] = o[i] * rstd * ng[i] * silu_f(gt[i]);
            v4u w; w.x = pk2v(y[0], y[1]); w.y = pk2v(y[2], y[3]); w.z = pk2v(y[4], y[5]); w.w = pk2v(y[6], y[7]);
            *(v4u*)(MIX + (size_t)(m2 + rr) * D + 512 + F.lane * 8) = w; }
    }
}

#define XB_TMO      128
#define XB_XCNT(j)  (256  + 64 * (j))
#define XB_XSUB(j)  (1280 + 64 * (j))
#define XB_XGEN(j)  (2304 + 64 * (j))
#define XB_TOP      3328
#define XB_TOPGEN   3392
#define XCD_BAR_WORDS 3456
#define XB_SPIN_CAP (1u << 18)

__device__ __forceinline__ unsigned xb_ld(unsigned* p)              { return __hip_atomic_load(p, __ATOMIC_RELAXED, __HIP_MEMORY_SCOPE_AGENT); }
__device__ __forceinline__ unsigned xb_add(unsigned* p, unsigned v) { return __hip_atomic_fetch_add(p, v, __ATOMIC_RELAXED, __HIP_MEMORY_SCOPE_AGENT); }
__device__ __forceinline__ unsigned xb_xcc_id() { return (unsigned)__builtin_amdgcn_s_getreg((3 << 11) | 20) & 0xFu; }
#define XB_SPIN(cond, bar) do { unsigned _sp = 0; while (cond) { __builtin_amdgcn_s_sleep(1); \
    if ((++_sp & 255u) == 0u) { if (xb_ld(&(bar)[XB_TMO])) break; if (_sp > XB_SPIN_CAP) { atomicAdd(&(bar)[XB_TMO], 1u); break; } } } } while (0)

struct XcdBarrier {
    unsigned* bar; unsigned x;
    volatile LAS unsigned* st;
};

__device__ __forceinline__ XcdBarrier xcd_barrier_post(unsigned* bar, volatile LAS unsigned* st) {
    XcdBarrier b; b.bar = bar; b.x = xb_xcc_id(); b.st = st;
    if (threadIdx.x == 0) (void)xb_add(&bar[XB_XCNT(b.x)], 1u);
    return b;
}
__device__ __forceinline__ void xcd_barrier_complete(unsigned* bar, unsigned x, unsigned& nloc, unsigned& nx) {
    const unsigned G = gridDim.x * gridDim.y * gridDim.z;
    unsigned sum, cnt, mine, sp = 0u;
    for (;;) {
        sum = 0u; cnt = 0u; mine = 0u;
#pragma unroll
        for (unsigned j = 0; j < 16; ++j) { const unsigned c = xb_ld(&bar[XB_XCNT(j)]); sum += c; cnt += (c > 0u) ? 1u : 0u; mine = (j == x) ? c : mine; }
        if (sum == G) break;
        __builtin_amdgcn_s_sleep(1);
        if ((++sp & 255u) == 0u) { if (xb_ld(&bar[XB_TMO])) break; if (sp > XB_SPIN_CAP) { atomicAdd(&bar[XB_TMO], 1u); break; } }
    }
    nloc = mine > 0u ? mine : 1u; nx = cnt > 0u ? cnt : 1u;
}

__device__ __forceinline__ void xcd_barrier(const XcdBarrier& b) {
    asm volatile("s_waitcnt vmcnt(0)" ::: "memory");
    __syncthreads();
    if (threadIdx.x == 0) {
        unsigned* bar = b.bar;
        __builtin_amdgcn_s_waitcnt(0);
        unsigned nloc = b.st[0], nx = b.st[1];
        if (nloc == 0u) { xcd_barrier_complete(bar, b.x, nloc, nx); b.st[0] = nloc; b.st[1] = nx; }
        const unsigned old = xb_add(&bar[XB_XSUB(b.x)], 1u);
        const unsigned gen = old / nloc;
        if (old + 1u == (gen + 1u) * nloc) {
            __builtin_amdgcn_fence(__ATOMIC_RELEASE, "agent");
            asm volatile("s_waitcnt vmcnt(0)" ::: "memory");
            const unsigned og = xb_add(&bar[XB_TOP], 1u);
            const unsigned tg = og / nx;
            if (og + 1u == (tg + 1u) * nx) xb_add(&bar[XB_TOPGEN], 1u);
            else XB_SPIN(xb_ld(&bar[XB_TOPGEN]) == tg, bar);
            __builtin_amdgcn_fence(__ATOMIC_ACQUIRE, "agent");
            xb_add(&bar[XB_XGEN(b.x)], 1u);
            asm volatile("s_waitcnt vmcnt(0)" ::: "memory");
        } else {
            XB_SPIN(xb_ld(&bar[XB_XGEN(b.x)]) == gen, bar);
            __builtin_amdgcn_fence(__ATOMIC_ACQUIRE, "agent");
            asm volatile("s_waitcnt vmcnt(0)" ::: "memory");
        }
    }
    __syncthreads();
}

#ifndef PROBE_MASK
#define PROBE_MASK 0
#endif
#if PROBE_MASK
#define PSTAMP(k) do { const unsigned long long now_ = __builtin_amdgcn_s_memrealtime(); if ((PROBE_MASK >> (k)) & 1) tacc += now_ - tprev; tprev = now_; } while (0)
#else
#define PSTAMP(k) do {} while (0)
#endif
__global__ void __launch_bounds__(NWAVES * 64, 2) hymba_fwd(Args args) {
    extern __shared__ __attribute__((aligned(16))) unsigned char lds[];
    cg::grid_group grid = cg::this_grid();
    Frame F; F.lds = (LAS unsigned char*)lds; F.tid = threadIdx.x; F.lane = F.tid & 63; F.wave = __builtin_amdgcn_readfirstlane(F.tid >> 6); F.G = gridDim.x; F.bid = blockIdx.x;
    unsigned char* ws = args.ws;
    bf16* XB = (bf16*)(ws + WS_XB); bf16* HB = (bf16*)(ws + WS_H);
    const float* ln_g = args.in[2]; const float* ln_b = args.in[3];
    volatile LAS int* misc = (volatile LAS int*)(F.lds + MISC_OFF);
    bf16* VHI = (bf16*)(ws + WS_GH); bf16* VLO = (bf16*)(ws + WS_BIG);

#if PROBE_MASK
    unsigned long long tacc = 0, tprev = __builtin_amdgcn_s_memrealtime();
#endif
    if (F.tid < 2) misc[8 + F.tid] = 0;
    __syncthreads();
    XcdBarrier xbar = xcd_barrier_post((unsigned*)(ws + WS_BAR), (volatile LAS unsigned*)(misc + 8));
    if (args.ws == nullptr) grid.sync();
    p0_prologue(F, args, 0);
    PSTAMP(12);
    p0_prologue(F, args, 1);
    PSTAMP(13);
    xcd_barrier(xbar); PSTAMP(0);
#ifndef NO_P1
    { pg8::Gemm g{XB, (const bf16*)(ws + WS_W13A), M, 2 * FF, D}; pg8::StaticOrder S; S.init(M, 2 * FF, F.G, F.bid); pg8::EpiSwiGLU E{HB};
      pg8::gemm_phase<pg8::EpiSwiGLU, pg8::StaticOrder, false, PG8_SP2>(F.lds, g, S, E); }
#endif
    xcd_barrier(xbar); PSTAMP(1);
#ifndef NO_P2
    { pg8::Gemm g{HB, (const bf16*)(ws + WS_W2A), M, D, FF}; pg8::StaticOrder S; S.init(M, D, F.G, F.bid); pg8::EpiResB E{XB, VHI, ALPHA, 0.5f};
      pg8::gemm_phase<pg8::EpiResB, pg8::StaticOrder, PG8_ALIGN, PG8_SP2>(F.lds, g, S, E); }
#endif
    xcd_barrier(xbar); PSTAMP(2);
#ifndef NO_P3
    ln_phase(F, VHI, XB, nullptr, ln_g, ln_b);
#endif
    xcd_barrier(xbar); PSTAMP(3);
#ifndef NO_P4
    { pg8::Gemm g{XB, (const bf16*)(ws + WS_WIN), M, NIN, D}; pg8::StaticOrder S; S.init(M, NIN, F.G, F.bid);
      pg8::EpiIn E{ws, args.in[9], args.in[10]};
      pg8::gemm_phase<pg8::EpiIn, pg8::StaticOrder, PG8_ALIGN, PG8_SP2>(F.lds, g, S, E); }
#endif
    xcd_barrier(xbar); PSTAMP(4);
#ifndef NO_P5
#ifndef NO_P5H
    if (F.bid < 192) { Frame F1 = F; int t1 = threadIdx.x; asm volatile("" : "+v"(t1)); F1.tid = t1; F1.lane = t1 & 63; F1.wave = __builtin_amdgcn_readfirstlane(t1 >> 6); hgrn_item_ws(F1, args, F.bid); }
    PSTAMP(11);
#endif
#ifndef NO_P5A
    { unsigned* ctr = (unsigned*)(ws + WS_CTL); Frame F2 = F; int t2 = threadIdx.x; asm volatile("" : "+v"(t2)); F2.tid = t2; F2.lane = t2 & 63; F2.wave = __builtin_amdgcn_readfirstlane(t2 >> 6);
      constexpr int NIT = M / 64, PER = NIT / 8;
      for (int gg = 0; gg < 8; ++gg) { const int grp = (F.bid + gg) & 7; unsigned* cg_ = ctr + grp * 64;
          for (;;) { if (F2.tid == 0) misc[0] = (int)atomicAdd(cg_, 1u); __syncthreads(); const int k = misc[0]; __syncthreads(); if (k >= PER) break; attn_item_mfma2(F2, args, grp * PER + k); } } }
#endif
#endif
    xcd_barrier(xbar); PSTAMP(5);
#ifndef NO_P6
    hg_finalize(F, args);
#endif
    xcd_barrier(xbar); PSTAMP(6);
#ifndef NO_P7
    { pg8::Gemm g{(const bf16*)(ws + WS_MIX), (const bf16*)(ws + WS_WOUT), M, D, D}; pg8::StaticOrder S; S.init(M, D, F.G, F.bid); pg8::EpiResB E{XB, VLO, ALPHA, 1.0f};
      pg8::gemm_phase<pg8::EpiResB, pg8::StaticOrder, PG8_ALIGN, PG8_SP2>(F.lds, g, S, E); }
#endif
    xcd_barrier(xbar); PSTAMP(7);
#ifndef NO_P8
    ln_phase(F, VLO, XB, nullptr, ln_g + D, ln_b + D);
#endif
    xcd_barrier(xbar); PSTAMP(8);
#ifndef NO_P9
#ifdef COOL_TEST
    { const unsigned long long t0_ = __builtin_amdgcn_s_memrealtime(); while (__builtin_amdgcn_s_memrealtime() - t0_ < 100000ull) __builtin_amdgcn_s_sleep(32); PSTAMP(14); }
#endif
    { pg8::Gemm g{XB, (const bf16*)(ws + WS_W13B), M, 2 * FF, D}; pg8::StaticOrder S; S.init(M, 2 * FF, F.G, F.bid); pg8::EpiSwiGLU E{HB};
      pg8::gemm_phase<pg8::EpiSwiGLU, pg8::StaticOrder, false, PG8_SP2>(F.lds, g, S, E); }
#endif
    xcd_barrier(xbar); PSTAMP(9);
#ifndef NO_P10
    { pg8::Gemm g{HB, (const bf16*)(ws + WS_W2B), M, D, FF}; pg8::StaticOrder S; S.init(M, D, F.G, F.bid); pg8::EpiResB E{XB, VHI, ALPHA, 0.5f};
      pg8::gemm_phase<pg8::EpiResB, pg8::StaticOrder, PG8_ALIGN, PG8_SP2>(F.lds, g, S, E); }
#endif
    xcd_barrier(xbar); PSTAMP(10);
#ifndef NO_P11
#if PROBE_MASK
    if (F.bid == 0 && F.tid == 0) *(volatile unsigned long long*)(ws + WS_CTL + 3072) = tacc;
    grid.sync();
    { const unsigned long long dl = *(volatile unsigned long long*)(ws + WS_CTL + 3072); const unsigned long long t0_ = __builtin_amdgcn_s_memrealtime();
      while (__builtin_amdgcn_s_memrealtime() - t0_ < dl) __builtin_amdgcn_s_sleep(8); }
#endif
#ifdef SYNC_TEST
    for (int q_ = 0; q_ < 10; ++q_) grid.sync();
#endif
    ln_phase(F, VHI, nullptr, args.out, ln_g + 2 * D, ln_b + 2 * D);
#ifdef DUP_P11
    xcd_barrier(xbar);
    ln_phase(F, VHI, nullptr, args.out, ln_g + 2 * D, ln_b + 2 * D);
#endif
#endif
}

extern "C" void kernel_launch(void* const* d_in, const int* in_sizes, int n_in, void* d_out, int out_size, void* d_ws, size_t ws_size, hipStream_t stream) {
    static int grid = 0;
    if (grid == 0) {
        if (n_in != 13 || out_size != M * D || ws_size < WS_END) { fprintf(stderr, "kernel_launch: unexpected shapes n_in %d out %d ws %zu\n", n_in, out_size, ws_size); grid = -1; return; }
        int dev = 0, cus = 0, per_cu = 0;
        hipGetDevice(&dev); hipDeviceGetAttribute(&cus, hipDeviceAttributeMultiprocessorCount, dev);
        hipFuncSetAttribute((const void*)hymba_fwd, hipFuncAttributeMaxDynamicSharedMemorySize, LDS_BYTES);
        hipOccupancyMaxActiveBlocksPerMultiprocessor(&per_cu, (const void*)hymba_fwd, NWAVES * 64, LDS_BYTES);
        if (per_cu < 1) { fprintf(stderr, "kernel_launch: occupancy query %d\n", per_cu); per_cu = 1; }
        (void)hipGetLastError();
        grid = cus;
    }
    if (grid < 0) return;
    hipMemsetAsync((char*)d_ws + WS_CTL, 0, 4096 + 16384, stream);
    Args a{};
    for (int i = 0; i < 13; ++i) a.in[i] = (const float*)d_in[i];
    a.out = (float*)d_out; a.ws = (unsigned char*)d_ws;
    void* kargs[] = {&a};
    hipError_t e = hipLaunchCooperativeKernel((const void*)hymba_fwd, dim3(grid), dim3(NWAVES * 64), kargs, LDS_BYTES, stream);
    if (e != hipSuccess) fprintf(stderr, "cooperative launch failed: %s (grid %d)\n", hipGetErrorString(e), grid);
}
```

```cpp
#include <hip/hip_runtime.h>
#include <cstdio>
#include <cstdint>
namespace pg8 {
#define PG8_LAS __attribute__((address_space(3)))
typedef unsigned short bf16_t;
typedef short bf16x8 __attribute__((ext_vector_type(8)));
typedef float f32x4 __attribute__((ext_vector_type(4)));
typedef unsigned u32x4 __attribute__((ext_vector_type(4)));
constexpr int BM = 256, BK = 64, HALF = 128, HTB = HALF * BK * 2  , STAGE_BYTES = 8 * HTB, NXCD = 8, WGM = 8;

__host__ __device__ __forceinline__ int lds_byte(int r, int c) { const int st = (r >> 4) * 2 + (c >> 5), rr = r & 15, cc = c & 31, ob = rr * 64 + cc * 2; return st * 1024 + (ob ^ (((ob >> 9) & 1) << 5)); }
__host__ __device__ __forceinline__ void stage_rc(int b, int& R, int& C) { const int st = b / 1024, sb = b % 1024, swz = sb ^ (((sb >> 9) & 1) << 5); R = (st >> 1) * 16 + swz / 64; C = (st & 1) * 32 + (swz % 64) / 2; }
__host__ __device__ __forceinline__ int perm32(int rho) { const int n = rho >> 4, i = rho & 15; return 8 * (i >> 2) + 4 * n + (i & 3); }

struct Unit { int pm, pn; };
struct Gemm { const bf16_t* A; const bf16_t* Bt; int M, N, K; };

struct StaticOrder {
    int nM, nN, nwg, G, c;
    __host__ __device__ void init(int M, int N, int G_, int c_) { nM = M / BM; nN = N / BM; nwg = nM * nN; G = G_; c = c_; }
    __host__ __device__ bool next(int i, Unit& u) const {
        const long L = (long)i * G + c; if (L >= nwg) return false;
        int wgid = (int)L; { const int q = nwg / NXCD, r = nwg % NXCD, xcd = wgid % NXCD, off = wgid / NXCD; wgid = (xcd < r ? xcd * (q + 1) : r * (q + 1) + (xcd - r) * q) + off; }
        const int nig = WGM * nN, gid = wgid / nig, fm = gid * WGM, gsz = (nM - fm) < WGM ? (nM - fm) : WGM;
        u.pm = fm + ((wgid % nig) % gsz); u.pn = (wgid % nig) / gsz; return true;
    }
    __device__ __forceinline__ void a_ready(const Unit&) const {}
    __device__ __forceinline__ void done(const Unit&) const {}
};

__device__ __forceinline__ unsigned cvt_pk_bf16(float lo, float hi) { unsigned r; asm volatile("v_cvt_pk_bf16_f32 %0, %1, %2" : "=v"(r) : "v"(lo), "v"(hi)); return r; }
typedef float f32x2 __attribute__((ext_vector_type(2)));
__device__ __forceinline__ f32x2 gelu_pk(f32x2 v) {
    const f32x2 av = __builtin_elementwise_abs(v), d = av * 0.2316418882f + 1.0f;
    f32x2 t; t.x = __builtin_amdgcn_rcpf(d.x); t.y = __builtin_amdgcn_rcpf(d.y);
    f32x2 q = t * 0.5307027145f + (-0.7265760135f); q = q * t + 0.7107068705f; q = q * t + (-0.142248368f); q = q * t + 0.127414796f; q = q * t;
    const f32x2 s = (v * v) * (-0.72134752044f);
    f32x2 e; e.x = __builtin_amdgcn_exp2f(s.x); e.y = __builtin_amdgcn_exp2f(s.y);
    const f32x2 m = v * (q * e), r = v - m;
    f32x2 o; o.x = v.x < 0.f ? m.x : r.x; o.y = v.y < 0.f ? m.y : r.y; return o;
}

template <int ACT  > struct EpiBf16 {
    static constexpr bool PERM = true, AFTER_DRAIN = false, HAS_TAB = false; static_assert(ACT == 0 || ACT == 1, "EpiBf16: ACT is 0 (none) or 1 (gelu_pk)");
    bf16_t* O; int ldc; const float* bias; int split_cols; size_t split_stride; float scale0;
    __device__ __forceinline__ void operator()(const f32x4 (&acc)[2][2][4][2], const Unit& u, int wr, int wc, int fr, int fq) const {
        const int row0 = u.pm * BM + wr * 64 + fr; int colt = u.pn * BM; bf16_t* base = O;
        float sc = 1.f; if (split_cols) { const int t = colt / split_cols; base += (size_t)t * split_stride; colt -= t * split_cols; if (t == 0) sc = scale0; }
        const int col0 = colt + wc * 32 + 8 * fq, bcol0 = u.pn * BM + wc * 32 + 8 * fq;
        f32x4 bv[2][2];
#pragma unroll
        for (int bj = 0; bj < 2; ++bj)
#pragma unroll
            for (int n = 0; n < 2; ++n) bv[bj][n] = bias ? *(const f32x4*)(bias + bcol0 + bj * HALF + 4 * n) : (f32x4){0.f, 0.f, 0.f, 0.f};
#pragma unroll
        for (int ai = 0; ai < 2; ++ai)
#pragma unroll
            for (int m = 0; m < 4; ++m) { bf16_t* rowp = base + (size_t)(row0 + ai * HALF + m * 16) * ldc + col0;
#pragma unroll
                for (int bj = 0; bj < 2; ++bj) { f32x4 v0 = acc[ai][bj][m][0] + bv[bj][0], v1 = acc[ai][bj][m][1] + bv[bj][1];
                    if (ACT == 1) { f32x2 a = gelu_pk((f32x2){v0[0], v0[1]}), b = gelu_pk((f32x2){v0[2], v0[3]}), c = gelu_pk((f32x2){v1[0], v1[1]}), d = gelu_pk((f32x2){v1[2], v1[3]});
                        v0 = (f32x4){a.x, a.y, b.x, b.y}; v1 = (f32x4){c.x, c.y, d.x, d.y}; }
                    v0 = v0 * sc; v1 = v1 * sc; u32x4 w; w.x = cvt_pk_bf16(v0[0], v0[1]); w.y = cvt_pk_bf16(v0[2], v0[3]); w.z = cvt_pk_bf16(v1[0], v1[1]); w.w = cvt_pk_bf16(v1[2], v1[3]);
                    *(u32x4*)(rowp + bj * HALF) = w; } }
    }
};

struct PanelStats {
    unsigned* xbuf;
    unsigned* cnt;
    unsigned* tmo;
    int ntn; float eps;
    unsigned code;
    __device__ __forceinline__ bool run(const f32x4 (&v)[2][2][4][2], const Unit& u, int wr, int wc, int fr, int fq, PG8_LAS unsigned char* lds, int wid, int lane) const {
        typedef float f32x2v __attribute__((ext_vector_type(2)));
        PG8_LAS f32x2v* P = (PG8_LAS f32x2v*)lds;
        PG8_LAS f32x2v* S = (PG8_LAS f32x2v*)(lds + 8192);
        PG8_LAS unsigned* flag = (PG8_LAS unsigned*)(lds + 8192 + 2048);
#pragma unroll
        for (int ai = 0; ai < 2; ++ai)
#pragma unroll
            for (int m = 0; m < 4; ++m) {
                float s = 0.f;
#pragma unroll
                for (int bj = 0; bj < 2; ++bj)
#pragma unroll
                    for (int n = 0; n < 2; ++n) { const f32x4 x = v[ai][bj][m][n]; s += (x[0] + x[1]) + (x[2] + x[3]); }
                s += __shfl_xor(s, 16); s += __shfl_xor(s, 32);
                const float mw = s * (1.0f / 64.0f); float q = 0.f;
#pragma unroll
                for (int bj = 0; bj < 2; ++bj)
#pragma unroll
                    for (int n = 0; n < 2; ++n) { const f32x4 d = v[ai][bj][m][n] - mw; q += (d[0] * d[0] + d[1] * d[1]) + (d[2] * d[2] + d[3] * d[3]); }
                q += __shfl_xor(q, 16); q += __shfl_xor(q, 32);
                if (fq == 0) P[(ai * HALF + wr * 64 + m * 16 + fr) * 4 + wc] = (f32x2v){mw, q};
            }
        asm volatile("s_waitcnt lgkmcnt(0)" ::: "memory"); __builtin_amdgcn_s_barrier(); asm volatile("" ::: "memory");
#if defined(BROKEN_EXCHANGE_NO_WAIT)
#warning BROKEN CONTROL BUILD: the row-statistics exchange does not wait; results are wrong by design
        if (blockIdx.x >= 64) { const long long t0_ = clock64(); while (clock64() - t0_ < 60000) __builtin_amdgcn_s_sleep(8); }
#endif
        const int row = wid * 32 + (lane & 31);
        if (lane < 32) {
            const f32x2v a = P[row * 4 + 0], b = P[row * 4 + 1], c = P[row * 4 + 2], d = P[row * 4 + 3];
            const float mt = (a.x + b.x + c.x + d.x) * 0.25f;
            const float da = a.x - mt, db = b.x - mt, dc = c.x - mt, dd = d.x - mt;
            const float m2 = (a.y + b.y) + (c.y + d.y) + 64.0f * ((da * da + db * db) + (dc * dc + dd * dd));
            unsigned long long* slot = (unsigned long long*)xbuf + ((size_t)(u.pm * BM + row) * 4 + u.pn);
            __hip_atomic_store(slot, ((unsigned long long)__float_as_uint(m2) << 32) | __float_as_uint(mt), __ATOMIC_RELAXED, __HIP_MEMORY_SCOPE_AGENT);
        }
        asm volatile("s_waitcnt vmcnt(0)" ::: "memory");
        if (lane == 0) __hip_atomic_fetch_add(cnt + 64 * u.pm, 1u, __ATOMIC_RELAXED, __HIP_MEMORY_SCOPE_AGENT);
        if (wid == 0) {
            bool dead = false; const unsigned long long t0 = __builtin_amdgcn_s_memrealtime(); const unsigned want = 8u * (unsigned)ntn;
            for (;;) {
#if defined(BROKEN_EXCHANGE_NO_WAIT)
                break;
#endif
                if ((unsigned)__builtin_amdgcn_readfirstlane(__hip_atomic_load(cnt + 64 * u.pm, __ATOMIC_RELAXED, __HIP_MEMORY_SCOPE_AGENT)) >= want) break;
                if (__builtin_amdgcn_s_memrealtime() - t0 > 2000000ull) {
                    if (lane == 0) { unsigned expect = 0u; __hip_atomic_compare_exchange_strong(tmo + 1, &expect, code | (unsigned)(u.pm & 0xff), __ATOMIC_RELAXED, __ATOMIC_RELAXED, __HIP_MEMORY_SCOPE_AGENT);
                                     __hip_atomic_store(tmo, 1u, __ATOMIC_RELAXED, __HIP_MEMORY_SCOPE_AGENT); }
                    dead = true; break; }
                __builtin_amdgcn_s_sleep(2);
            }
            __builtin_amdgcn_fence(__ATOMIC_ACQUIRE, "agent");
            if (lane == 0) flag[0] = dead ? 1u : 0u;
        }
        asm volatile("s_waitcnt vmcnt(0) lgkmcnt(0)" ::: "memory"); __builtin_amdgcn_s_barrier(); asm volatile("" ::: "memory");
        const bool bad = flag[0] != 0u;
        if (lane < 32) {
            const unsigned long long* slot = (const unsigned long long*)xbuf + (size_t)(u.pm * BM + row) * 4; float mt[4], m2[4]; float ms = 0.f;
#pragma unroll
            for (int t = 0; t < 4; ++t) { if (t < ntn) { const unsigned long long w = __hip_atomic_load(slot + t, __ATOMIC_RELAXED, __HIP_MEMORY_SCOPE_AGENT); mt[t] = __uint_as_float((unsigned)w); m2[t] = __uint_as_float((unsigned)(w >> 32)); } else { mt[t] = 0.f; m2[t] = 0.f; } ms += mt[t]; }
            const float mean = ms / (float)ntn; float q = 0.f;
#pragma unroll
            for (int t = 0; t < 4; ++t) if (t < ntn) { const float dm = mt[t] - mean; q += m2[t] + 256.0f * dm * dm; }
            S[row] = (f32x2v){mean, 1.0f / sqrtf(q / (256.0f * (float)ntn) + eps)};
        }
        asm volatile("s_waitcnt lgkmcnt(0)" ::: "memory"); __builtin_amdgcn_s_barrier(); asm volatile("" ::: "memory");
        return bad;
    }
};
struct EpiLnRes {
    static constexpr bool PERM = false, AFTER_DRAIN = true, HAS_TAB = false;
    const float* base; float* out; int ldc; const float* bias; PanelStats st; unsigned poison;
    __device__ __forceinline__ void fused(f32x4 (&acc)[2][2][4][2], const Unit& u, int wr, int wc, int fr, int fq, PG8_LAS unsigned char* lds, int wid, int lane) const {
        typedef float f32x2v __attribute__((ext_vector_type(2)));
        const PG8_LAS f32x2v* S = (const PG8_LAS f32x2v*)(lds + 8192);
        const int col0 = u.pn * BM + wc * 32 + 4 * fq;
#pragma unroll
        for (int bj = 0; bj < 2; ++bj)
#pragma unroll
            for (int n = 0; n < 2; ++n) { const f32x4 bv = bias ? *(const f32x4*)(bias + col0 + bj * HALF + n * 16) : (f32x4){0.f, 0.f, 0.f, 0.f};
#pragma unroll
                for (int ai = 0; ai < 2; ++ai)
#pragma unroll
                    for (int m = 0; m < 4; ++m) acc[ai][bj][m][n] += bv; }
        f32x4 pre[4][2][2];
#pragma unroll
        for (int m = 0; m < 4; ++m) { const size_t off = (size_t)(u.pm * BM + wr * 64 + m * 16 + fr) * ldc + col0;
#pragma unroll
            for (int bj = 0; bj < 2; ++bj)
#pragma unroll
                for (int n = 0; n < 2; ++n) pre[m][bj][n] = *(const f32x4*)(base + off + bj * HALF + n * 16); }
        const bool bad = st.run(acc, u, wr, wc, fr, fq, lds, wid, lane) || poison != 0u;
        const float qnan = __builtin_nanf("");
#pragma unroll
        for (int ai = 0; ai < 2; ++ai)
#pragma unroll
            for (int m = 0; m < 4; ++m) { const int r = ai * HALF + wr * 64 + m * 16 + fr; const f32x2v sr = S[r]; const size_t off = (size_t)(u.pm * BM + r) * ldc + col0;
#pragma unroll
                for (int bj = 0; bj < 2; ++bj)
#pragma unroll
                    for (int n = 0; n < 2; ++n) { const f32x4 bs = ai == 0 ? pre[m][bj][n] : *(const f32x4*)(base + off + bj * HALF + n * 16); f32x4 o = bs + (acc[ai][bj][m][n] - sr.x) * sr.y;
                        if (bad) o = (f32x4){qnan, qnan, qnan, qnan}; *(f32x4*)(out + off + bj * HALF + n * 16) = o; }
                if (m & 1) asm volatile("" ::: "memory"); }
    }
};
struct EpiLnResLn {
    static constexpr bool PERM = false, AFTER_DRAIN = true, HAS_TAB = false;
    const float* base; float* out; bf16_t* xn; int ldc; const float* bias; PanelStats st1, st2; unsigned poison;
    __device__ __forceinline__ void fused(f32x4 (&acc)[2][2][4][2], const Unit& u, int wr, int wc, int fr, int fq, PG8_LAS unsigned char* lds, int wid, int lane) const {
        typedef float f32x2v __attribute__((ext_vector_type(2))); typedef unsigned u32x2v __attribute__((ext_vector_type(2)));
        const PG8_LAS f32x2v* S = (const PG8_LAS f32x2v*)(lds + 8192);
        const int col0 = u.pn * BM + wc * 32 + 4 * fq;
#pragma unroll
        for (int bj = 0; bj < 2; ++bj)
#pragma unroll
            for (int n = 0; n < 2; ++n) { const f32x4 bv = bias ? *(const f32x4*)(bias + col0 + bj * HALF + n * 16) : (f32x4){0.f, 0.f, 0.f, 0.f};
#pragma unroll
                for (int ai = 0; ai < 2; ++ai)
#pragma unroll
                    for (int m = 0; m < 4; ++m) acc[ai][bj][m][n] += bv; }
        bool bad = st1.run(acc, u, wr, wc, fr, fq, lds, wid, lane) || poison != 0u;
        const float qnan = __builtin_nanf("");
#pragma unroll
        for (int ai = 0; ai < 2; ++ai)
#pragma unroll
            for (int m = 0; m < 4; ++m) { const int r = ai * HALF + wr * 64 + m * 16 + fr; const f32x2v sr = S[r]; const size_t off = (size_t)(u.pm * BM + r) * ldc + col0;
#pragma unroll
                for (int bj = 0; bj < 2; ++bj)
#pragma unroll
                    for (int n = 0; n < 2; ++n) { const f32x4 bs = *(const f32x4*)(base + off + bj * HALF + n * 16); acc[ai][bj][m][n] = bs + (acc[ai][bj][m][n] - sr.x) * sr.y; }
                asm volatile("" : "+v"(acc[ai][0][m][0]), "+v"(acc[ai][0][m][1]), "+v"(acc[ai][1][m][0]), "+v"(acc[ai][1][m][1]));
                if (m & 1) asm volatile("" ::: "memory"); }
        const bool bad1 = bad;
        bad = st2.run(acc, u, wr, wc, fr, fq, lds, wid, lane) || bad;
#pragma unroll
        for (int ai = 0; ai < 2; ++ai)
#pragma unroll
            for (int m = 0; m < 4; ++m) { const int r = ai * HALF + wr * 64 + m * 16 + fr; const f32x2v sr = S[r]; const size_t off = (size_t)(u.pm * BM + r) * ldc + col0;
#pragma unroll
                for (int bj = 0; bj < 2; ++bj)
#pragma unroll
                    for (int n = 0; n < 2; ++n) { const f32x4 x1 = acc[ai][bj][m][n]; *(f32x4*)(out + off + bj * HALF + n * 16) = bad1 ? (f32x4){qnan, qnan, qnan, qnan} : x1;
                        const f32x4 o = (x1 - sr.x) * sr.y; u32x2v w; w.x = cvt_pk_bf16(o[0], o[1]); w.y = cvt_pk_bf16(o[2], o[3]);
                        if (bad) { w.x = 0x7fc07fc0u; w.y = 0x7fc07fc0u; } *(u32x2v*)(xn + off + bj * HALF + n * 16) = w; }
                asm volatile("" ::: "memory"); }
    }
};

template <class Epi, class Sched, bool ALIGN_EPI = false, bool SP2 = false>
__device__ __forceinline__ void gemm_phase(PG8_LAS unsigned char* lds, const Gemm g, const Sched& S, const Epi& E) {
    int tid_ = threadIdx.x; asm volatile("" : "+v"(tid_));
    const int tid = tid_, wid = __builtin_amdgcn_readfirstlane(tid >> 6), lane = tid & 63, wr = wid >> 2, wc = wid & 3, fr = lane & 15, fq = lane >> 4;
    const int K = g.K, nt = K / BK;
    unsigned voffA[2], voffB[2];
#pragma unroll
    for (int i = 0; i < 2; ++i) { int R, C; stage_rc(tid * 16 + i * 8192, R, C); const int Rb = Epi::PERM ? ((R & ~31) + perm32(R & 31)) : R;
        voffA[i] = (unsigned)(R * K + C) * 2u; voffB[i] = (unsigned)(Rb * K + C) * 2u; }
    const size_t kstep = (size_t)(BK * 2);
    const size_t hstep = (size_t)HALF * K * 2;
    const size_t tstep = 2 * hstep;
    const unsigned ldsw = (unsigned)wid * 1024u;
    const int aoff = lds_byte(wr * 64 + fr, fq * 8), boff = lds_byte(wc * 32 + fr, fq * 8);
#define PG8_SA(b, h) (((b) * 2 + (h)) * HTB)
#define PG8_SB(b, h) ((4 + (b) * 2 + (h)) * HTB)
#define PG8_STAGE(bufoff, gbase, voff) do { _Pragma("unroll") for (int _i = 0; _i < 2; ++_i) \
        __builtin_amdgcn_global_load_lds((const unsigned*)((const char*)(gbase) + (voff)[_i]), (PG8_LAS unsigned*)(lds + (bufoff) + ldsw + _i * 8192), 16, 0, 0); } while (0)
#define PG8_LDA(dst, b, h) do { _Pragma("unroll") for (int m = 0; m < 4; ++m) _Pragma("unroll") for (int k = 0; k < 2; ++k) dst[m][k] = *(const PG8_LAS bf16x8*)(lds + PG8_SA(b, h) + aoff + m * 2048 + k * 1024); } while (0)
#define PG8_LDB(dst, b, h) do { _Pragma("unroll") for (int n = 0; n < 2; ++n) _Pragma("unroll") for (int k = 0; k < 2; ++k) dst[n][k] = *(const PG8_LAS bf16x8*)(lds + PG8_SB(b, h) + boff + n * 2048 + k * 1024); } while (0)
#define PG8_MMA(ai, bj, At, Bt) do { __builtin_amdgcn_s_setprio(1); _Pragma("unroll") for (int m = 0; m < 4; ++m) _Pragma("unroll") for (int n = 0; n < 2; ++n) _Pragma("unroll") for (int k = 0; k < 2; ++k) \
        acc[ai][bj][m][n] = __builtin_amdgcn_mfma_f32_16x16x32_bf16(Bt[n][k], At[m][k], acc[ai][bj][m][n], 0, 0, 0); __builtin_amdgcn_s_setprio(0); } while (0)
#define PG8_WAIT_V(n) asm volatile("s_waitcnt vmcnt(" #n ")" ::: "memory")
#define PG8_WAIT_L(n) asm volatile("s_waitcnt lgkmcnt(" #n ")" ::: "memory")
#define PG8_BAR __builtin_amdgcn_s_barrier()
#define PG8_SCHED __builtin_amdgcn_sched_barrier(0)
    Unit cur, nxt; int ui = 0;
    if (!S.next(0, cur)) return;
    f32x4 acc[2][2][4][2];
#pragma unroll
    for (int a = 0; a < 2; ++a)
#pragma unroll
        for (int b = 0; b < 2; ++b)
#pragma unroll
            for (int m = 0; m < 4; ++m)
#pragma unroll
                for (int n = 0; n < 2; ++n) acc[a][b][m][n] = (f32x4){0.f, 0.f, 0.f, 0.f};
    bf16x8 At[4][2], B0[2][2], B1[2][2];
    const char* cA = (const char*)g.A + (size_t)cur.pm * tstep; const char* cB = (const char*)g.Bt + (size_t)cur.pn * tstep;
    S.a_ready(cur);
    if constexpr (Epi::HAS_TAB) { typename Epi::Pre pre0; E.tab_load(pre0, cur.pm); E.tab_store(pre0, 0); }
    if constexpr (SP2) {
        PG8_STAGE(PG8_SB(0, 0), cB, voffB); PG8_STAGE(PG8_SB(0, 1), cB + hstep, voffB); PG8_STAGE(PG8_SA(0, 0), cA, voffA); PG8_STAGE(PG8_SA(0, 1), cA + hstep, voffA);
        if (wr == 1) PG8_BAR;
        PG8_WAIT_V(2); PG8_BAR;
        PG8_STAGE(PG8_SB(1, 0), cB + kstep, voffB); PG8_STAGE(PG8_SA(1, 0), cA + kstep, voffA); PG8_STAGE(PG8_SB(1, 1), cB + hstep + kstep, voffB);
        PG8_WAIT_V(6); PG8_BAR;
    } else {
        PG8_STAGE(PG8_SB(0, 0), cB, voffB); PG8_STAGE(PG8_SA(0, 0), cA, voffA); PG8_STAGE(PG8_SB(0, 1), cB + hstep, voffB); PG8_STAGE(PG8_SA(0, 1), cA + hstep, voffA);
        if (wr == 1) PG8_BAR;
        PG8_WAIT_V(4); PG8_BAR;
        PG8_STAGE(PG8_SB(1, 0), cB + kstep, voffB); PG8_STAGE(PG8_SA(1, 0), cA + kstep, voffA); PG8_STAGE(PG8_SB(1, 1), cB + hstep + kstep, voffB);
        PG8_WAIT_V(6); PG8_BAR;
    }
    for (;;) {
        const bool has_next = S.next(ui + 1, nxt);
        const char* nA = has_next ? (const char*)g.A + (size_t)nxt.pm * tstep : cA; const char* nB = has_next ? (const char*)g.Bt + (size_t)nxt.pn * tstep : cB;
        for (int t = 0; t < nt; t += 2) {
            const bool last = (t == nt - 2);
            const char* a1 = cA + (size_t)(t + 1) * kstep;
            const char* a2 = last ? nA : cA + (size_t)(t + 2) * kstep; const char* b2 = last ? nB : cB + (size_t)(t + 2) * kstep;
            const char* a3 = a2 + kstep; const char* b3 = b2 + kstep;
            if (last && has_next) S.a_ready(nxt);
            if constexpr (SP2) {
            PG8_LDB(B0, 0, 0); PG8_LDB(B1, 0, 1); PG8_SCHED; PG8_LDA(At, 0, 0); PG8_STAGE(PG8_SA(1, 1), a1 + hstep, voffA);
            PG8_WAIT_V(8); PG8_WAIT_L(0); PG8_BAR; PG8_MMA(0, 0, At, B0); PG8_MMA(0, 1, At, B1); PG8_BAR; PG8_SCHED;
            PG8_LDA(At, 0, 1); PG8_STAGE(PG8_SB(0, 0), b2, voffB); PG8_STAGE(PG8_SB(0, 1), b2 + hstep, voffB); PG8_STAGE(PG8_SA(0, 0), a2, voffA);
            PG8_WAIT_V(8); PG8_WAIT_L(0); PG8_BAR; PG8_MMA(1, 0, At, B0); PG8_MMA(1, 1, At, B1); PG8_BAR; PG8_SCHED;
            PG8_LDB(B0, 1, 0); PG8_LDB(B1, 1, 1); PG8_SCHED; PG8_LDA(At, 1, 0); PG8_STAGE(PG8_SA(0, 1), a2 + hstep, voffA);
            PG8_WAIT_V(8); PG8_WAIT_L(0); PG8_BAR; PG8_MMA(0, 0, At, B0); PG8_MMA(0, 1, At, B1); PG8_BAR; PG8_SCHED;
            PG8_LDA(At, 1, 1); PG8_STAGE(PG8_SB(1, 0), b3, voffB); PG8_STAGE(PG8_SB(1, 1), b3 + hstep, voffB); PG8_STAGE(PG8_SA(1, 0), a3, voffA);
            PG8_WAIT_V(8); PG8_WAIT_L(0); PG8_BAR; PG8_MMA(1, 0, At, B0); PG8_MMA(1, 1, At, B1); PG8_BAR; PG8_SCHED;
            } else {
            PG8_LDB(B0, 0, 0); PG8_SCHED; PG8_LDA(At, 0, 0); PG8_STAGE(PG8_SA(1, 1), a1 + hstep, voffA);
            PG8_WAIT_L(8); PG8_BAR; PG8_WAIT_L(0); PG8_MMA(0, 0, At, B0); PG8_BAR; PG8_SCHED;
            PG8_LDB(B1, 0, 1); PG8_STAGE(PG8_SB(0, 0), b2, voffB);
            PG8_BAR; PG8_WAIT_L(0); PG8_MMA(0, 1, At, B1); PG8_BAR;
            PG8_LDA(At, 0, 1); PG8_STAGE(PG8_SA(0, 0), a2, voffA);
            PG8_BAR; PG8_WAIT_L(0); PG8_MMA(1, 0, At, B0); PG8_BAR; PG8_SCHED;
            PG8_STAGE(PG8_SB(0, 1), b2 + hstep, voffB);
            PG8_WAIT_V(6); PG8_BAR; PG8_MMA(1, 1, At, B1); PG8_BAR;
            PG8_LDB(B0, 1, 0); PG8_SCHED; PG8_LDA(At, 1, 0); PG8_STAGE(PG8_SA(0, 1), a2 + hstep, voffA);
            PG8_WAIT_L(8); PG8_BAR; PG8_WAIT_L(0); PG8_MMA(0, 0, At, B0); PG8_BAR; PG8_SCHED;
            PG8_LDB(B1, 1, 1); PG8_STAGE(PG8_SB(1, 0), b3, voffB);
            PG8_BAR; PG8_WAIT_L(0); PG8_MMA(0, 1, At, B1); PG8_BAR;
            PG8_LDA(At, 1, 1); PG8_STAGE(PG8_SA(1, 0), a3, voffA);
            PG8_BAR; PG8_WAIT_L(0); PG8_MMA(1, 0, At, B0); PG8_BAR; PG8_SCHED;
            PG8_STAGE(PG8_SB(1, 1), b3 + hstep, voffB);
            PG8_WAIT_V(6); PG8_BAR; PG8_MMA(1, 1, At, B1); PG8_BAR;
            }
        }
        if constexpr (ALIGN_EPI) { if (wr == 0) PG8_BAR; }
        if constexpr (!Epi::AFTER_DRAIN) {
            if constexpr (Epi::HAS_TAB) { typename Epi::Pre pre; E.tab_load(pre, has_next ? nxt.pm : cur.pm); E(acc, cur, wr, wc, fr, fq, ui & 1); E.tab_store(pre, (ui + 1) & 1); }
            else E(acc, cur, wr, wc, fr, fq);
            S.done(cur); }
        if (!has_next) break;
#pragma unroll
        for (int a = 0; a < 2; ++a)
#pragma unroll
            for (int b = 0; b < 2; ++b)
#pragma unroll
                for (int m = 0; m < 4; ++m)
#pragma unroll
                    for (int n = 0; n < 2; ++n) acc[a][b][m][n] = (f32x4){0.f, 0.f, 0.f, 0.f};
        cur = nxt; cA = nA; cB = nB; ++ui;
        if constexpr (ALIGN_EPI) { if (wr == 1) PG8_BAR; }
    }
    PG8_WAIT_V(0);
    if constexpr (!ALIGN_EPI) { if (wr == 0) PG8_BAR; }
    PG8_BAR;
    if constexpr (Epi::AFTER_DRAIN) { E.fused(acc, cur, wr, wc, fr, fq, lds, wid, lane); S.done(cur); }
#undef PG8_SA
#undef PG8_SB
#undef PG8_STAGE
#undef PG8_LDA
#undef PG8_LDB
#undef PG8_MMA
#undef PG8_WAIT_V
#undef PG8_WAIT_L
#undef PG8_BAR
#undef PG8_SCHED
}
}

#ifndef PG8_SP2
#define PG8_SP2 true
#endif
#ifndef PG8_ALIGN
#define PG8_ALIGN true
#endif

#include <hip/hip_cooperative_groups.h>
namespace cg = cooperative_groups;
#define LAS __attribute__((address_space(3)))
typedef unsigned short bf16;
typedef unsigned v4u __attribute__((ext_vector_type(4)));
typedef unsigned v2u __attribute__((ext_vector_type(2)));
typedef float f32x4 __attribute__((ext_vector_type(4)));
typedef short bf16x8 __attribute__((ext_vector_type(8)));

constexpr int D = 1024, M_P = 16384, M_S = 65536, M = M_P + M_S, T_P = 2048, T_S = 4096;
constexpr int FF = 2816, NIN = 3328, NT32 = M / 32, NT16 = M / 16;
constexpr float ALPHA = 1.189207115002721f;
constexpr float EPS = 1e-5f;
constexpr float LOG2E = 1.4426950408889634f;
constexpr float QSCALE = 0.125f * LOG2E;
constexpr int NWAVES = 8;
constexpr int LDS_BYTES = 155648;
constexpr int MISC_OFF = 151552;

constexpr size_t MiB = 1u << 20;
constexpr size_t WS_W13A = 0, WS_W13B = 11 * MiB, WS_W2A = 22 * MiB, WS_W2B = 28 * MiB, WS_WIN = 34 * MiB, WS_WOUT = 41 * MiB;
constexpr size_t WS_XB = 44 * MiB, WS_BIG = 204 * MiB;
constexpr size_t WS_H = WS_BIG;
constexpr size_t WS_QA = WS_BIG, WS_KA = WS_BIG + 80 * MiB, WS_VT = WS_BIG + 100 * MiB, WS_QH = WS_BIG + 120 * MiB, WS_GF = WS_BIG + 200 * MiB,
                 WS_GB = WS_BIG + 280 * MiB, WS_IH = WS_BIG + 360 * MiB, WS_GH = WS_BIG + 440 * MiB, WS_OF = WS_GF, WS_OB = WS_GB, WS_MIX = WS_BIG + 520 * MiB;
constexpr size_t WS_CTL = WS_BIG + 680 * MiB, WS_BAR = WS_CTL + 4096, WS_END = WS_BAR + 16384;

__device__ __forceinline__ unsigned f2bf(float f) { unsigned u = __builtin_bit_cast(unsigned, f); return (u + 0x7fffu + ((u >> 16) & 1u)) >> 16; }
__device__ __forceinline__ unsigned pk2(float lo, float hi) { return f2bf(lo) | (f2bf(hi) << 16); }
__device__ __forceinline__ float bf2f(unsigned short h) { return __builtin_bit_cast(float, (unsigned)h << 16); }
__device__ __forceinline__ float bflo(unsigned w) { return __builtin_bit_cast(float, w << 16); }
__device__ __forceinline__ float bfhi(unsigned w) { return __builtin_bit_cast(float, w & 0xffff0000u); }
__device__ __forceinline__ float wave_sum(float v) {
#pragma unroll
    for (int o = 1; o < 64; o <<= 1) v += __shfl_xor(v, o);
    return v;
}
__device__ __forceinline__ float silu_f(float x) { return x * __builtin_amdgcn_rcpf(1.0f + __builtin_amdgcn_exp2f(-x * LOG2E)); }

__device__ __forceinline__ size_t qk_off(int m, int head, int d0, int hh) { return ((((size_t)head * NT32 + (m >> 5)) * 4 + d0) * 32 + (m & 31)) * 16 + hh * 8; }
__device__ __forceinline__ int vt_slot(int o) { return ((o >> 2) & 1) * 8 + (o >> 3) * 4 + (o & 3); }
__device__ __forceinline__ size_t vt_off(int m, int kvh, int d) { return (((size_t)kvh * NT16 + (m >> 4)) * 64 + d) * 16 + vt_slot(m & 15); }

namespace pg8 {
struct EpiRes {
    static constexpr bool PERM = false, AFTER_DRAIN = false, HAS_TAB = false;
    const float* res0; const float* res1; int split; float* out; float alpha, s;
    __device__ __forceinline__ void operator()(const f32x4 (&acc)[2][2][4][2], const Unit& u, int wr, int wc, int fr, int fq) const {
        const int row0 = u.pm * BM + wr * 64 + fr, col0 = u.pn * BM + wc * 32 + 4 * fq;
        const float* rb = (u.pm * BM < split) ? res0 : res1 - (size_t)split * 1024;
#pragma unroll
        for (int ai = 0; ai < 2; ++ai)
#pragma unroll
            for (int m = 0; m < 4; ++m) { const size_t off = (size_t)(row0 + ai * HALF + m * 16) * 1024 + col0;
#pragma unroll
                for (int bj = 0; bj < 2; ++bj)
#pragma unroll
                    for (int n = 0; n < 2; ++n) { const f32x4 rv = *(const f32x4*)(rb + off + bj * HALF + n * 16);
                        *(f32x4*)(out + off + bj * HALF + n * 16) = rv * alpha + acc[ai][bj][m][n] * s; }
                if (m & 1) asm volatile("" ::: "memory"); }
    }
};
struct EpiResB {
    static constexpr bool PERM = false, AFTER_DRAIN = false, HAS_TAB = false;
    const bf16_t* res; bf16_t* vout; float alpha, s;
    __device__ __forceinline__ void operator()(const f32x4 (&acc)[2][2][4][2], const Unit& u, int wr, int wc, int fr, int fq) const {
        typedef unsigned u32x2e __attribute__((ext_vector_type(2)));
        const int row0 = u.pm * BM + wr * 64 + fr, col0 = u.pn * BM + wc * 32 + 4 * fq;
#pragma unroll
        for (int ai = 0; ai < 2; ++ai)
#pragma unroll
            for (int m = 0; m < 4; ++m) { const size_t off = (size_t)(row0 + ai * HALF + m * 16) * 1024 + col0;
#pragma unroll
                for (int bj = 0; bj < 2; ++bj)
#pragma unroll
                    for (int n = 0; n < 2; ++n) { const u32x2e rw = *(const u32x2e*)(res + off + bj * HALF + n * 16);
                        const f32x4 rv = (f32x4){__builtin_bit_cast(float, rw[0] << 16), __builtin_bit_cast(float, rw[0] & 0xffff0000u), __builtin_bit_cast(float, rw[1] << 16), __builtin_bit_cast(float, rw[1] & 0xffff0000u)};
                        const f32x4 o = rv * alpha + acc[ai][bj][m][n] * s;
                        u32x2e w; w[0] = cvt_pk_bf16(o[0], o[1]); w[1] = cvt_pk_bf16(o[2], o[3]); *(u32x2e*)(vout + off + bj * HALF + n * 16) = w; }
                if (m & 1) asm volatile("" ::: "memory"); }
    }
};
struct EpiSwiGLU {
    static constexpr bool PERM = true, AFTER_DRAIN = false, HAS_TAB = false;
    bf16_t* H;
    __device__ __forceinline__ void operator()(const f32x4 (&acc)[2][2][4][2], const Unit& u, int wr, int wc, int fr, int fq) const {
        const int row0 = u.pm * BM + wr * 64 + fr, col0 = u.pn * HALF + wc * 32 + 8 * fq;
#pragma unroll
        for (int ai = 0; ai < 2; ++ai)
#pragma unroll
            for (int m = 0; m < 4; ++m) {
                float h[8];
#pragma unroll
                for (int n = 0; n < 2; ++n)
#pragma unroll
                    for (int i = 0; i < 4; ++i) { const float g = acc[ai][0][m][n][i], up = acc[ai][1][m][n][i]; h[n * 4 + i] = silu_f(g) * up; }
                u32x4 w; w.x = cvt_pk_bf16(h[0], h[1]); w.y = cvt_pk_bf16(h[2], h[3]); w.z = cvt_pk_bf16(h[4], h[5]); w.w = cvt_pk_bf16(h[6], h[7]);
                __builtin_nontemporal_store(w, (u32x4*)(H + (size_t)(row0 + ai * HALF + m * 16) * FF + col0)); }
    }
};
struct EpiIn {
    static constexpr bool PERM = true, AFTER_DRAIN = false, HAS_TAB = false;
    unsigned char* ws; const float* lbf; const float* lbb;
    __device__ __forceinline__ void operator()(const f32x4 (&acc)[2][2][4][2], const Unit& u, int wr, int wc, int fr, int fq) const {
        bf16_t* QA = (bf16_t*)(ws + WS_QA); bf16_t* KA = (bf16_t*)(ws + WS_KA); bf16_t* VT = (bf16_t*)(ws + WS_VT);
        const int pn = u.pn; const int row0 = u.pm * BM + wr * 64 + fr; const int c8 = wc * 32 + 8 * fq;
        if (pn <= 2) {
            const int hd = wc >> 1, dim = (wc & 1) * 32 + 8 * fq, d0 = dim >> 4, hh = (dim >> 3) & 1;
#pragma unroll
            for (int ai = 0; ai < 2; ++ai)
#pragma unroll
                for (int m = 0; m < 4; ++m) { const int row = row0 + ai * HALF + m * 16;
#pragma unroll
                    for (int bj = 0; bj < 2; ++bj) { const f32x4 v0 = acc[ai][bj][m][0], v1 = acc[ai][bj][m][1];
                        if (pn < 2) { const int head = pn * 4 + bj * 2 + hd; u32x4 w; w.x = cvt_pk_bf16(v0[0] * QSCALE, v0[1] * QSCALE); w.y = cvt_pk_bf16(v0[2] * QSCALE, v0[3] * QSCALE);
                            w.z = cvt_pk_bf16(v1[0] * QSCALE, v1[1] * QSCALE); w.w = cvt_pk_bf16(v1[2] * QSCALE, v1[3] * QSCALE); *(u32x4*)(QA + qk_off(row, head, d0, hh)) = w; }
                        else if (bj == 0) { u32x4 w; w.x = cvt_pk_bf16(v0[0], v0[1]); w.y = cvt_pk_bf16(v0[2], v0[3]); w.z = cvt_pk_bf16(v1[0], v1[1]); w.w = cvt_pk_bf16(v1[2], v1[3]); *(u32x4*)(KA + qk_off(row, hd, d0, hh)) = w; }
                        else { bf16_t* vp = VT + vt_off(row, hd, dim);
#pragma unroll
                            for (int i = 0; i < 4; ++i) { vp[i * 16] = (bf16_t)f2bf(v0[i]); vp[(4 + i) * 16] = (bf16_t)f2bf(v1[i]); } } } }
        } else if (pn <= 4 || pn >= 9) {
            bf16_t* dst = (bf16_t*)(ws + (pn <= 4 ? WS_QH : (pn <= 10 ? WS_IH : WS_GH))); const int cb = ((pn <= 4 ? pn - 3 : (pn <= 10 ? pn - 9 : pn - 11)) * 256) + c8;
#pragma unroll
            for (int ai = 0; ai < 2; ++ai)
#pragma unroll
                for (int m = 0; m < 4; ++m) { const int row = row0 + ai * HALF + m * 16;
#pragma unroll
                    for (int bj = 0; bj < 2; ++bj) { const f32x4 v0 = acc[ai][bj][m][0], v1 = acc[ai][bj][m][1];
                        u32x4 w; w.x = cvt_pk_bf16(v0[0], v0[1]); w.y = cvt_pk_bf16(v0[2], v0[3]); w.z = cvt_pk_bf16(v1[0], v1[1]); w.w = cvt_pk_bf16(v1[2], v1[3]);
                        *(u32x4*)(dst + (size_t)row * 512 + cb + bj * HALF) = w; } }
        } else {
            bf16_t* dst = (bf16_t*)(ws + (pn <= 6 ? WS_GF : WS_GB)); const float* lp = pn <= 6 ? lbf : lbb; const int cb = ((pn - 5) & 1) * 256 + c8;
#pragma unroll
            for (int bj = 0; bj < 2; ++bj) { float lb[8];
#pragma unroll
                for (int i = 0; i < 8; ++i) { const float p0 = lp[cb + bj * HALF + i], p1 = lp[512 + cb + bj * HALF + i]; lb[i] = __builtin_amdgcn_rcpf(1.0f + __expf(p1 - p0)); }
#pragma unroll
                for (int ai = 0; ai < 2; ++ai)
#pragma unroll
                    for (int m = 0; m < 4; ++m) { const int row = row0 + ai * HALF + m * 16; float g[8];
#pragma unroll
                        for (int n = 0; n < 2; ++n)
#pragma unroll
                            for (int i = 0; i < 4; ++i) { const float x = acc[ai][bj][m][n][i]; const float sg = __builtin_amdgcn_rcpf(1.0f + __builtin_amdgcn_exp2f(-x * 1.4426950408889634f));
                                const float l = lb[n * 4 + i]; g[n * 4 + i] = __logf(l + (1.0f - l) * sg); }
                        u32x4 w; w.x = cvt_pk_bf16(g[0], g[1]); w.y = cvt_pk_bf16(g[2], g[3]); w.z = cvt_pk_bf16(g[4], g[5]); w.w = cvt_pk_bf16(g[6], g[7]);
                        *(u32x4*)(dst + (size_t)row * 512 + cb + bj * HALF) = w; } }
        }
    }
};
}

struct Args { const float* in[13]; float* out; unsigned char* ws; };

struct Frame {
    LAS unsigned char* lds; int tid, lane, wave, G, bid;
};

struct TrItem { const float* W; bf16* WT; int K, N, mode, r; };
__device__ __forceinline__ void p0_decode(const Args& a, unsigned char* ws, int it, TrItem& t) {
    constexpr int I13 = (D / 64) * (2 * FF / 32), I2 = (FF / 64) * (D / 32), IIN = (D / 64) * (NIN / 32);
    int r = it;
    if (r < I13) { t = TrItem{a.in[4], (bf16*)(ws + WS_W13A), D, 2 * FF, 1, r}; return; } r -= I13;
    if (r < I13) { t = TrItem{a.in[4] + (size_t)D * 2 * FF, (bf16*)(ws + WS_W13B), D, 2 * FF, 1, r}; return; } r -= I13;
    if (r < I2) { t = TrItem{a.in[5], (bf16*)(ws + WS_W2A), FF, D, 0, r}; return; } r -= I2;
    if (r < I2) { t = TrItem{a.in[5] + (size_t)FF * D, (bf16*)(ws + WS_W2B), FF, D, 0, r}; return; } r -= I2;
    if (r < IIN) { t = TrItem{a.in[6], (bf16*)(ws + WS_WIN), D, NIN, 0, r}; return; } r -= IIN;
    t = TrItem{a.in[12], (bf16*)(ws + WS_WOUT), D, D, 0, r};
}
__device__ __forceinline__ void p0_load(const TrItem& t, int lane, float (&wv)[32]) {
    const int nblk = t.N / 32, kb = t.r / nblk, nb = t.r % nblk, k0 = 64 * kb, n0 = 32 * nb;
    const float* p = t.W + (size_t)(k0 + (lane >> 5)) * t.N + n0 + (lane & 31);
#pragma unroll
    for (int i = 0; i < 32; ++i) wv[i] = p[(size_t)(2 * i) * t.N];
}
__device__ __forceinline__ void p0_store(const TrItem& t, LAS float* scr, int lane, const float (&wv)[32]) {
    const int nblk = t.N / 32, kb = t.r / nblk, nb = t.r % nblk, k0 = 64 * kb, n0 = 32 * nb;
    int rbase = n0;
    if (t.mode == 1) { const int h0 = n0 < FF ? n0 : n0 - FF; rbase = (h0 >> 7) * 256 + (n0 < FF ? 0 : 128) + (h0 & 127); }
#pragma unroll
    for (int i = 0; i < 32; ++i) scr[(2 * i + (lane >> 5)) * 33 + (lane & 31)] = wv[i];
    asm volatile("s_waitcnt lgkmcnt(0)" ::: "memory");
    const int c = lane & 7;
#pragma unroll
    for (int j = 0; j < 4; ++j) { const int n = (lane >> 3) + 8 * j; const LAS float* s = scr + (8 * c) * 33 + n;
        v4u o; o.x = pk2(s[0 * 33], s[1 * 33]); o.y = pk2(s[2 * 33], s[3 * 33]); o.z = pk2(s[4 * 33], s[5 * 33]); o.w = pk2(s[6 * 33], s[7 * 33]);
        *(v4u*)(t.WT + (size_t)(rbase + n) * t.K + k0 + 8 * c) = o; }
    asm volatile("s_waitcnt lgkmcnt(0)" ::: "memory");
}
__device__ __forceinline__ void p0_prologue(const Frame& F, const Args& a, int part) {
    LAS float* scr = (LAS float*)(F.lds + F.wave * 16384);
    const int gw = F.bid * NWAVES + F.wave, NGW = F.G * NWAVES;
    unsigned char* ws = a.ws;
    constexpr int NITEMS = 2 * (D / 64) * (2 * FF / 32) + 2 * (FF / 64) * (D / 32) + (D / 64) * (NIN / 32) + (D / 64) * (D / 32);
    if (part == 0) {
        TrItem cur, nxt; float wv[32], wn[32]; int it = gw;
        if (it < NITEMS) { p0_decode(a, ws, it, cur); p0_load(cur, F.lane, wv); }
        while (it < NITEMS) { const int itn = it + NGW; const bool hn = itn < NITEMS;
            if (hn) { p0_decode(a, ws, itn, nxt); p0_load(nxt, F.lane, wn); }
            p0_store(cur, scr, F.lane, wv);
            if (hn) { cur = nxt;
#pragma unroll
                for (int i = 0; i < 32; ++i) wv[i] = wn[i]; }
            it = itn; }
    }
    bf16* XB = (bf16*)(ws + WS_XB);
    if (part == 1) for (int m4 = gw * 4; m4 < M; m4 += NGW * 4) {
        f32x4 v[4][4];
#pragma unroll
        for (int rr = 0; rr < 4; ++rr) { const int m = m4 + rr; const float* xrow = m < M_P ? a.in[0] + (size_t)m * D : a.in[1] + (size_t)(m - M_P) * D; const f32x4* xr = (const f32x4*)xrow + F.lane;
#pragma unroll
            for (int j = 0; j < 4; ++j) v[rr][j] = __builtin_nontemporal_load(xr + 64 * j); }
#pragma unroll
        for (int rr = 0; rr < 4; ++rr) { v2u* o8 = (v2u*)(XB + (size_t)(m4 + rr) * D) + F.lane;
#pragma unroll
            for (int j = 0; j < 4; ++j) { v2u w; w.x = pk2(v[rr][j].x, v[rr][j].y); w.y = pk2(v[rr][j].z, v[rr][j].w); o8[64 * j] = w; } }
    }
}
__device__ __forceinline__ void ln_phase(const Frame& F, const bf16* vin, bf16* xb, float* fout, const float* g, const float* b) {
    const int gw = F.bid * NWAVES + F.wave, NGW = F.G * NWAVES;
    f32x4 gv[4], bv[4];
#pragma unroll
    for (int j = 0; j < 4; ++j) { gv[j] = ((const f32x4*)g)[F.lane + 64 * j]; bv[j] = ((const f32x4*)b)[F.lane + 64 * j]; }
    for (int m2 = gw * 2; m2 < M; m2 += NGW * 2) {
        f32x4 v[2][4]; float s[2], s2[2], mean[2], rstd[2];
#pragma unroll
        for (int rr = 0; rr < 2; ++rr) { const v2u* xr = (const v2u*)(vin + (size_t)(m2 + rr) * D) + F.lane; s[rr] = 0.f;
#pragma unroll
            for (int j = 0; j < 4; ++j) { const v2u w = __builtin_nontemporal_load(xr + 64 * j); v[rr][j] = (f32x4){bflo(w.x), bfhi(w.x), bflo(w.y), bfhi(w.y)}; } }
#pragma unroll
        for (int rr = 0; rr < 2; ++rr) {
#pragma unroll
            for (int j = 0; j < 4; ++j) s[rr] += (v[rr][j].x + v[rr][j].y) + (v[rr][j].z + v[rr][j].w); }
#pragma unroll
        for (int rr = 0; rr < 2; ++rr) { mean[rr] = wave_sum(s[rr]) * (1.f / D); s2[rr] = 0.f;
#pragma unroll
            for (int j = 0; j < 4; ++j) { v[rr][j] = v[rr][j] - mean[rr]; s2[rr] += (v[rr][j].x * v[rr][j].x + v[rr][j].y * v[rr][j].y) + (v[rr][j].z * v[rr][j].z + v[rr][j].w * v[rr][j].w); } }
#pragma unroll
        for (int rr = 0; rr < 2; ++rr) { rstd[rr] = 1.f / sqrtf(wave_sum(s2[rr]) * (1.f / D) + EPS);
#pragma unroll
            for (int j = 0; j < 4; ++j) { const f32x4 y = v[rr][j] * rstd[rr] * gv[j] + bv[j];
                if (fout) __builtin_nontemporal_store(y, (f32x4*)(fout + (size_t)(m2 + rr) * D) + F.lane + 64 * j);
                else { v2u w; w.x = pk2(y.x, y.y); w.y = pk2(y.z, y.w); ((v2u*)(xb + (size_t)(m2 + rr) * D) + F.lane)[64 * j] = w; } } }
    }
}
__device__ __forceinline__ void hgrn_item_naive(const Frame& F, const Args& a, int it) {
    unsigned char* ws = a.ws;
    int s0, T, head, dir;
    if (it < 128) { s0 = M_P + (it >> 3) * T_S; T = T_S; } else { s0 = ((it - 128) >> 3) * T_P; T = T_P; }
    head = (it >> 1) & 3; dir = it & 1;
    const bf16* QH = (const bf16*)(ws + WS_QH); const bf16* G = (const bf16*)(ws + (dir ? WS_GB : WS_GF)); const bf16* IH = (const bf16*)(ws + WS_IH);
    bf16* O = (bf16*)a.out + (dir ? (size_t)M * 512 : 0);
    LAS float* qs = (LAS float*)F.lds; LAS float* fs = qs + 1024; LAS float* ks = fs + 1024; LAS float* vs = ks + 1024; LAS float* red = vs + 1024;
    const int v = F.tid & 127, dq = F.tid >> 7;
    float S[32];
#pragma unroll
    for (int i = 0; i < 32; ++i) S[i] = 0.f;
    for (int b0 = 0; b0 < T; b0 += 8) {
        __syncthreads();
#pragma unroll
        for (int e = F.tid; e < 1024; e += 512) { const int tok = e >> 7, d = e & 127; const int j = b0 + tok; const int t = dir ? T - 1 - j : j; const size_t idx = (size_t)(s0 + t) * 512 + head * 128 + d;
            qs[e] = bf2f(QH[idx]); const float f = __expf(bf2f(G[idx])); fs[e] = f; ks[e] = 1.0f - f; vs[e] = bf2f(IH[idx]); }
        __syncthreads();
#pragma unroll 1
        for (int tok = 0; tok < 8; ++tok) { const float iv = vs[tok * 128 + v]; float o = 0.f;
#pragma unroll
            for (int dd = 0; dd < 32; ++dd) { const int d = dq * 32 + dd; S[dd] = fs[tok * 128 + d] * S[dd] + ks[tok * 128 + d] * iv; o += qs[tok * 128 + d] * S[dd]; }
            red[(dq * 8 + tok) * 128 + v] = o; }
        __syncthreads();
#pragma unroll
        for (int e = F.tid; e < 1024; e += 512) { const int tok = e >> 7, vv = e & 127; const int j = b0 + tok; const int t = dir ? T - 1 - j : j;
            const float sm = (red[(0 * 8 + tok) * 128 + vv] + red[(1 * 8 + tok) * 128 + vv]) + (red[(2 * 8 + tok) * 128 + vv] + red[(3 * 8 + tok) * 128 + vv]);
            O[(size_t)(s0 + t) * 512 + head * 128 + vv] = (bf16)f2bf(sm); }
    }
    __syncthreads();
}

__device__ __forceinline__ float exp_c(float x) { return __builtin_amdgcn_exp2f(fminf(x, 80.0f) * LOG2E); }
__device__ __forceinline__ int dperm(int d) { return (d & ~31) | (((d >> 2) & 3) << 3) | (((d >> 4) & 1) << 2) | (d & 3); }
#define LDS_BAR() do { asm volatile("s_waitcnt lgkmcnt(0)" ::: "memory"); __builtin_amdgcn_s_barrier(); asm volatile("" ::: "memory"); } while (0)
constexpr int HO_QS = 0, HO_KS = 17408, HO_KT = 34816, HO_VT = 53248, HO_AS = 71680, HO_E1 = 80896, HO_E2 = HO_E1 + 512, HO_E3 = HO_E1 + 1024, HO_TOT = 82432, HO_OS = 86528;
#define LDSP(T_, base_, off_) ((LAS T_*)(uintptr_t)(unsigned)((base_) + (unsigned)(off_)))
__device__ __forceinline__ void hgrn_item_mfma(const Frame& F, const Args& a, int it) {
    unsigned char* ws = a.ws;
    int s0, T;
    if (it < 128) { s0 = M_P + (it >> 3) * T_S; T = T_S; } else { s0 = ((it - 128) >> 3) * T_P; T = T_P; }
    const int head = (it >> 1) & 3, dir = it & 1;
    const bf16* QH = (const bf16*)(ws + WS_QH); const bf16* G = (const bf16*)(ws + (dir ? WS_GB : WS_GF)); const bf16* IH = (const bf16*)(ws + WS_IH);
    bf16* O = (bf16*)a.out + (dir ? (size_t)M * 512 : 0);
    const int dp = F.tid & 63, w = F.wave, part = w, r = F.lane & 15, q4 = F.lane >> 4;
    const int d0 = 2 * dp, pd0 = dperm(d0);
    const unsigned L0 = (unsigned)(uintptr_t)F.lds;
    unsigned pA = L0 + d0 * 4 + part * 512, pA0 = L0 + d0 * 4, pQ = L0 + pd0 * 2 + part * 2176, pK = L0 + d0 * 144 + part * 16;
    unsigned rA = L0 + r * 272 + q4 * 16, rB = L0 + r * 144 + q4 * 16, rBv = L0 + r * 144 + q4 * 16 + w * 2304, pE = L0 + q4 * 16;
    unsigned pO = L0 + q4 * 1088 + (16 * w + r) * 2, pF = L0 + (F.tid >> 4) * 272 + (F.tid & 15) * 16;
    unsigned rAc = L0 + r * 272 + q4 * 16 + (w >> 1) * 4352, rKc = L0 + r * 272 + q4 * 16 + ((w & 1) * 2) * 4352, pAs = L0 + q4 * 576 + r * 2 + (w >> 1) * 2304 + (w & 1) * 64;
    asm volatile("" : "+v"(pA), "+v"(pA0), "+v"(pQ), "+v"(pK), "+v"(rA), "+v"(rB), "+v"(rBv), "+v"(pE));
    asm volatile("" : "+v"(pO), "+v"(pF), "+v"(rAc), "+v"(rKc), "+v"(pAs));
    const int nch = T / 64;
    pg8::f32x4 S[8];
#pragma unroll
    for (int i = 0; i < 8; ++i) S[i] = (pg8::f32x4){0.f, 0.f, 0.f, 0.f};
    unsigned g2[8], q2[8], v2[8];
    const bf16* Gb = G + (size_t)s0 * 512 + head * 128; const bf16* Qb = QH + (size_t)s0 * 512 + head * 128; const bf16* Vb = IH + (size_t)s0 * 512 + head * 128;
    bf16* Ob = O + (size_t)s0 * 512 + head * 128;
    const int rstep = dir ? -512 : 512; const int roff0 = (dir ? (T - 1 - part * 8) : part * 8) * 512 + d0;
#define HG_LOAD(c) do { const int o0_ = roff0 + (c) * 64 * rstep; _Pragma("unroll") for (int ii = 0; ii < 8; ++ii) { const unsigned o_ = (unsigned)(o0_ + ii * rstep); \
        g2[ii] = *(const unsigned*)(Gb + o_); q2[ii] = *(const unsigned*)(Qb + o_); v2[ii] = *(const unsigned*)(Vb + o_); } } while (0)
#define HG_FLUSH(c) do { _Pragma("unroll") for (int k_ = 0; k_ < 2; ++k_) { const int row_ = (F.tid >> 4) + 32 * k_; const int tk_ = (c) * 64 + row_; const int t_ = dir ? T - 1 - tk_ : tk_; \
        *(v4u*)(Ob + (size_t)t_ * 512 + (F.tid & 15) * 8) = *LDSP(v4u, pF, HO_OS + k_ * 8704); } } while (0)
    HG_LOAD(0);
    const int ti_c = w >> 1, tj0_c = (w & 1) * 2;
    for (int c = 0; c < nch; ++c) {
        typedef float f32x2_ __attribute__((ext_vector_type(2))); typedef unsigned u32x2_ __attribute__((ext_vector_type(2)));
        float pa[8], pb[8]; float ra = 0.f, rb = 0.f;
#pragma unroll
        for (int ii = 0; ii < 8; ++ii) { ra += bflo(g2[ii]) * LOG2E; rb += bfhi(g2[ii]) * LOG2E; pa[ii] = ra; pb[ii] = rb; }
        *LDSP(f32x2_, pA, HO_TOT) = (f32x2_){ra, rb};
        LDS_BAR();
        if (c > 0) HG_FLUSH(c - 1);
        float offA = 0.f, offB = 0.f, brefA = 0.f, brefB = 0.f, blastA = 0.f, blastB = 0.f;
#pragma unroll
        for (int p_ = 0; p_ < 8; ++p_) { const f32x2_ tt = *LDSP(f32x2_, pA0, HO_TOT + p_ * 512); if (p_ < part) { offA += tt.x; offB += tt.y; } if (p_ < 4) { brefA += tt.x; brefB += tt.y; } blastA += tt.x; blastB += tt.y; }
        offA -= brefA; offB -= brefB;
        float ka[8], kb[8];
#pragma unroll
        for (int ii = 0; ii < 8; ++ii) { const float xa = offA + pa[ii], xb = offB + pb[ii];
            const float fa = __builtin_amdgcn_exp2f(bflo(g2[ii]) * LOG2E), fb = __builtin_amdgcn_exp2f(bfhi(g2[ii]) * LOG2E);
            const float qa = bflo(q2[ii]) * __builtin_amdgcn_exp2f(fminf(xa, 115.0f)), qb = bfhi(q2[ii]) * __builtin_amdgcn_exp2f(fminf(xb, 115.0f));
            ka[ii] = (1.0f - fa) * __builtin_amdgcn_exp2f(fminf(-xa, 115.0f)); kb[ii] = (1.0f - fb) * __builtin_amdgcn_exp2f(fminf(-xb, 115.0f));
            *LDSP(unsigned, pQ, HO_QS + ii * 272) = pg8::cvt_pk_bf16(qa, qb); *LDSP(unsigned, pQ, HO_KS + ii * 272) = pg8::cvt_pk_bf16(ka[ii], kb[ii]); }
        *LDSP(v4u, pK, HO_KT) = (v4u){pg8::cvt_pk_bf16(ka[0], ka[1]), pg8::cvt_pk_bf16(ka[2], ka[3]), pg8::cvt_pk_bf16(ka[4], ka[5]), pg8::cvt_pk_bf16(ka[6], ka[7])};
        *LDSP(v4u, pK, HO_KT + 144) = (v4u){pg8::cvt_pk_bf16(kb[0], kb[1]), pg8::cvt_pk_bf16(kb[2], kb[3]), pg8::cvt_pk_bf16(kb[4], kb[5]), pg8::cvt_pk_bf16(kb[6], kb[7])};
        *LDSP(v4u, pK, HO_VT) = (v4u){(v2[0] & 0xffffu) | (v2[1] << 16), (v2[2] & 0xffffu) | (v2[3] << 16), (v2[4] & 0xffffu) | (v2[5] << 16), (v2[6] & 0xffffu) | (v2[7] << 16)};
        *LDSP(v4u, pK, HO_VT + 144) = (v4u){(v2[0] >> 16) | (v2[1] & 0xffff0000u), (v2[2] >> 16) | (v2[3] & 0xffff0000u), (v2[4] >> 16) | (v2[5] & 0xffff0000u), (v2[6] >> 16) | (v2[7] & 0xffff0000u)};
        if (part == 0) { *LDSP(f32x2_, pA0, HO_E1) = (f32x2_){__builtin_amdgcn_exp2f(fminf(blastA, 115.0f)), __builtin_amdgcn_exp2f(fminf(blastB, 115.0f))};
            *LDSP(f32x2_, pA0, HO_E2) = (f32x2_){__builtin_amdgcn_exp2f(fminf(blastA - brefA, 115.0f)), __builtin_amdgcn_exp2f(fminf(blastB - brefB, 115.0f))};
            *LDSP(f32x2_, pA0, HO_E3) = (f32x2_){__builtin_amdgcn_exp2f(fminf(brefA, 115.0f)), __builtin_amdgcn_exp2f(fminf(brefB, 115.0f))}; }
        if (c + 1 < nch) HG_LOAD(c + 1);
        LDS_BAR();
#pragma unroll
        for (int tjj = 0; tjj < 2; ++tjj) { const int tj = tj0_c + tjj; pg8::f32x4 acc = (pg8::f32x4){0.f, 0.f, 0.f, 0.f};
            if (tj <= ti_c) { bf16x8 af[4], bfr[4];
#pragma unroll
                for (int ks = 0; ks < 4; ++ks) { af[ks] = *LDSP(bf16x8, rAc, HO_QS + ks * 64); bfr[ks] = *LDSP(bf16x8, rKc, HO_KS + tjj * 4352 + ks * 64); }
#pragma unroll
                for (int ks = 0; ks < 4; ++ks) acc = __builtin_amdgcn_mfma_f32_16x16x32_bf16(af[ks], bfr[ks], acc, 0, 0, 0); }
#pragma unroll
            for (int rg = 0; rg < 4; ++rg) { const int i = 16 * ti_c + 4 * q4 + rg, j = 16 * tj + r; *LDSP(bf16, pAs, HO_AS + tjj * 32 + rg * 144) = (bf16)f2bf(j <= i ? acc[rg] : 0.f); } }
        LDS_BAR();
        { bf16x8 vB[2], sB[4]; pg8::f32x4 o[4];
          { pg8::f32x4 e3a[4], e3b[4];
#pragma unroll
            for (int ks = 0; ks < 2; ++ks) vB[ks] = *LDSP(bf16x8, rBv, HO_VT + ks * 64);
#pragma unroll
            for (int ks = 0; ks < 4; ++ks) { e3a[ks] = *LDSP(pg8::f32x4, pE, HO_E3 + ks * 128); e3b[ks] = *LDSP(pg8::f32x4, pE, HO_E3 + ks * 128 + 64); }
            __builtin_amdgcn_sched_barrier(0);
#pragma unroll
            for (int ks = 0; ks < 4; ++ks) { const pg8::f32x4 sa = S[2 * ks] * e3a[ks], sb = S[2 * ks + 1] * e3b[ks];
                v4u pw; pw.x = pk2(sa[0], sa[1]); pw.y = pk2(sa[2], sa[3]); pw.z = pk2(sb[0], sb[1]); pw.w = pk2(sb[2], sb[3]); sB[ks] = __builtin_bit_cast(bf16x8, pw); } }
#pragma unroll
          for (int tp = 0; tp < 2; ++tp) { bf16x8 aA[2][2], aQ[2][4];
#pragma unroll
              for (int tt = 0; tt < 2; ++tt) { const int ti = tp * 2 + tt;
#pragma unroll
                  for (int ks = 0; ks < 2; ++ks) aA[tt][ks] = *LDSP(bf16x8, rB, HO_AS + ti * 2304 + ks * 64);
#pragma unroll
                  for (int ks = 0; ks < 4; ++ks) aQ[tt][ks] = *LDSP(bf16x8, rA, HO_QS + ti * 4352 + ks * 64); }
              __builtin_amdgcn_sched_barrier(0);
#pragma unroll
              for (int tt = 0; tt < 2; ++tt) o[tp * 2 + tt] = (pg8::f32x4){0.f, 0.f, 0.f, 0.f};
#pragma unroll
              for (int ks = 0; ks < 2; ++ks)
#pragma unroll
                  for (int tt = 0; tt < 2; ++tt) o[tp * 2 + tt] = __builtin_amdgcn_mfma_f32_16x16x32_bf16(aA[tt][ks], vB[ks], o[tp * 2 + tt], 0, 0, 0);
#pragma unroll
              for (int ks = 0; ks < 4; ++ks)
#pragma unroll
                  for (int tt = 0; tt < 2; ++tt) o[tp * 2 + tt] = __builtin_amdgcn_mfma_f32_16x16x32_bf16(aQ[tt][ks], sB[ks], o[tp * 2 + tt], 0, 0, 0);
              __builtin_amdgcn_sched_barrier(0); }
#pragma unroll
          for (int hf = 0; hf < 2; ++hf) { bf16x8 aK[4][2]; pg8::f32x4 e1v[4], e2v[4];
#pragma unroll
              for (int dd = 0; dd < 4; ++dd) { const int dt = hf * 4 + dd;
#pragma unroll
                  for (int ks = 0; ks < 2; ++ks) aK[dd][ks] = *LDSP(bf16x8, rB, HO_KT + dt * 2304 + ks * 64);
                  e1v[dd] = *LDSP(pg8::f32x4, pE, HO_E1 + dt * 64); e2v[dd] = *LDSP(pg8::f32x4, pE, HO_E2 + dt * 64); }
              if (hf == 0) {
#pragma unroll
                  for (int ti = 0; ti < 4; ++ti)
#pragma unroll
                      for (int rg = 0; rg < 4; ++rg) *LDSP(bf16, pO, HO_OS + ti * 4352 + rg * 272) = (bf16)f2bf(o[ti][rg]); }
              __builtin_amdgcn_sched_barrier(0);
              pg8::f32x4 u[4];
#pragma unroll
              for (int dd = 0; dd < 4; ++dd) u[dd] = (pg8::f32x4){0.f, 0.f, 0.f, 0.f};
#pragma unroll
              for (int ks = 0; ks < 2; ++ks)
#pragma unroll
                  for (int dd = 0; dd < 4; ++dd) u[dd] = __builtin_amdgcn_mfma_f32_16x16x32_bf16(aK[dd][ks], vB[ks], u[dd], 0, 0, 0);
#pragma unroll
              for (int dd = 0; dd < 4; ++dd) S[hf * 4 + dd] = S[hf * 4 + dd] * e1v[dd] + u[dd] * e2v[dd];
              __builtin_amdgcn_sched_barrier(0); } }
    }
    LDS_BAR();
    HG_FLUSH(nch - 1);
    LDS_BAR();
#undef HG_LOAD
#undef HG_FLUSH
}

typedef float f32x16 __attribute__((ext_vector_type(16)));
constexpr int H2_QS = 0, H2_KT = 17408, H2_VT = 35840, H2_AS = 54272, H2_E1 = 63488, H2_E2 = 64000, H2_E3 = 64512, H2_BUF = 65024, H2_KS = 2 * H2_BUF;
__device__ __forceinline__ int dperm16(int d) { return (d & ~15) | (((d >> 2) & 1) << 3) | (((d >> 3) & 1) << 2) | (d & 3); }
__device__ __forceinline__ void hgrn_item_ws(const Frame& F, const Args& a, int it) {
    unsigned char* ws = a.ws;
    int s0, T;
    if (it < 128) { s0 = M_P + (it >> 3) * T_S; T = T_S; } else { s0 = ((it - 128) >> 3) * T_P; T = T_P; }
    const int head = (it >> 1) & 3, dir = it & 1;
    const bf16* QH = (const bf16*)(ws + WS_QH); const bf16* G = (const bf16*)(ws + (dir ? WS_GB : WS_GF)); const bf16* IH = (const bf16*)(ws + WS_IH);
    bf16* O = (bf16*)a.out + (dir ? (size_t)M * 512 : 0);
    const int w = F.wave, nch = T / 64;
    const unsigned L0 = (unsigned)(uintptr_t)F.lds;
    const bf16* Gb = G + (size_t)s0 * 512 + head * 128; const bf16* Qb = QH + (size_t)s0 * 512 + head * 128; const bf16* Vb = IH + (size_t)s0 * 512 + head * 128;
    bf16* Ob = O + (size_t)s0 * 512 + head * 128;
    const int rstep = dir ? -512 : 512;
    const int pw = w & 3, cp = F.lane & 15, rq = F.lane >> 4, d0 = 32 * pw + 2 * cp, pd0 = dperm16(d0);
    const int r = F.lane & 15, q4 = F.lane >> 4, r32 = F.lane & 31, hi = F.lane >> 5;
    const bool prod = w >= 4;
    unsigned R0 = prod ? L0 + pd0 * 2 + rq * 4352 : L0 + (32 * w + r32) * 144 + hi * 16;
    unsigned R1 = prod ? L0 + d0 * 144 + rq * 32 : L0 + r32 * 144 + hi * 16;
    unsigned R2 = prod ? L0 + d0 * 4 : L0 + r32 * 272 + hi * 16;
    unsigned R3 = prod ? L0 + r * 272 + q4 * 16 + pw * 4352 : L0 + hi * 16;
    unsigned R4 = L0 + H2_KS + r * 272 + q4 * 16, R5 = L0 + q4 * 576 + r * 2 + pw * 2304;
    asm volatile("" : "+v"(R0), "+v"(R1), "+v"(R2), "+v"(R3), "+v"(R4), "+v"(R5));
#define pQ R0
#define cV R0
#define pK R1
#define cA R1
#define pE R2
#define cQ R2
#define rAc R3
#define cE R3
#define rKc R4
#define pAs R5
    const int roff0 = (dir ? (T - 1 - rq * 16) : rq * 16) * 512 + d0;
    typedef unsigned u32x16_ __attribute__((ext_vector_type(16)));
#define g2(i_) SU[0][i_]
#define q2(i_) SU[1][i_]
#define v2(i_) SU[2][i_]
    u32x16_ SU[4];
#pragma unroll
    for (int i = 0; i < 4; ++i)
#pragma unroll
        for (int k = 0; k < 16; ++k) SU[i][k] = 0u;
#define H2_LOAD(c) do { const int o0_ = roff0 + (c) * 64 * rstep; _Pragma("unroll") for (int ii = 0; ii < 16; ++ii) { const unsigned o_ = (unsigned)(o0_ + ii * rstep); \
        SU[0][ii] = *(const unsigned*)(Gb + o_); SU[1][ii] = *(const unsigned*)(Qb + o_); SU[2][ii] = *(const unsigned*)(Vb + o_); } } while (0)
#define H2_PROD_B(bo) do { \
        float ra = 0.f, rb = 0.f; \
        _Pragma("unroll") for (int ii = 0; ii < 16; ++ii) { ra += bflo(g2(ii)) * LOG2E; rb += bfhi(g2(ii)) * LOG2E; } \
        const float ta0 = __shfl(ra, cp), ta1 = __shfl(ra, 16 + cp), ta2 = __shfl(ra, 32 + cp), ta3 = __shfl(ra, 48 + cp); \
        const float tb0 = __shfl(rb, cp), tb1 = __shfl(rb, 16 + cp), tb2 = __shfl(rb, 32 + cp), tb3 = __shfl(rb, 48 + cp); \
        const float brefA = ta0 + ta1, brefB = tb0 + tb1, blastA = brefA + (ta2 + ta3), blastB = brefB + (tb2 + tb3); \
        const float offA = (rq == 0 ? 0.f : (rq == 1 ? ta0 : (rq == 2 ? ta0 + ta1 : ta0 + ta1 + ta2))) - brefA; \
        const float offB = (rq == 0 ? 0.f : (rq == 1 ? tb0 : (rq == 2 ? tb0 + tb1 : tb0 + tb1 + tb2))) - brefB; \
        unsigned ktA[8], ktB[8], vtA[8], vtB[8]; float kpa = 0.f, kpb = 0.f; \
        float xa = offA, xb = offB; \
        _Pragma("unroll") for (int ii = 0; ii < 16; ++ii) { xa += bflo(g2(ii)) * LOG2E; xb += bfhi(g2(ii)) * LOG2E; \
            const float fa = __builtin_amdgcn_exp2f(bflo(g2(ii)) * LOG2E), fb = __builtin_amdgcn_exp2f(bfhi(g2(ii)) * LOG2E); \
            const float qa = bflo(q2(ii)) * __builtin_amdgcn_exp2f(fminf(xa, 115.0f)), qb = bfhi(q2(ii)) * __builtin_amdgcn_exp2f(fminf(xb, 115.0f)); \
            const float ka = (1.0f - fa) * __builtin_amdgcn_exp2f(fminf(-xa, 115.0f)), kb = (1.0f - fb) * __builtin_amdgcn_exp2f(fminf(-xb, 115.0f)); \
            *LDSP(unsigned, pQ, (bo) + H2_QS + ii * 272) = pg8::cvt_pk_bf16(qa, qb); *LDSP(unsigned, pQ, H2_KS + ii * 272) = pg8::cvt_pk_bf16(ka, kb); \
            if (ii & 1) { ktA[ii >> 1] = pg8::cvt_pk_bf16(kpa, ka); ktB[ii >> 1] = pg8::cvt_pk_bf16(kpb, kb); vtA[ii >> 1] = (v2(ii - 1) & 0xffffu) | (v2(ii) << 16); vtB[ii >> 1] = (v2(ii - 1) >> 16) | (v2(ii) & 0xffff0000u); } \
            else { kpa = ka; kpb = kb; } } \
        *LDSP(v4u, pK, (bo) + H2_KT) = (v4u){ktA[0], ktA[1], ktA[2], ktA[3]}; *LDSP(v4u, pK, (bo) + H2_KT + 16) = (v4u){ktA[4], ktA[5], ktA[6], ktA[7]}; \
        *LDSP(v4u, pK, (bo) + H2_KT + 144) = (v4u){ktB[0], ktB[1], ktB[2], ktB[3]}; *LDSP(v4u, pK, (bo) + H2_KT + 160) = (v4u){ktB[4], ktB[5], ktB[6], ktB[7]}; \
        *LDSP(v4u, pK, (bo) + H2_VT) = (v4u){vtA[0], vtA[1], vtA[2], vtA[3]}; *LDSP(v4u, pK, (bo) + H2_VT + 16) = (v4u){vtA[4], vtA[5], vtA[6], vtA[7]}; \
        *LDSP(v4u, pK, (bo) + H2_VT + 144) = (v4u){vtB[0], vtB[1], vtB[2], vtB[3]}; *LDSP(v4u, pK, (bo) + H2_VT + 160) = (v4u){vtB[4], vtB[5], vtB[6], vtB[7]}; \
        if (rq == 0) { typedef float f32x2_ __attribute__((ext_vector_type(2))); \
            *LDSP(f32x2_, pE, (bo) + H2_E1) = (f32x2_){__builtin_amdgcn_exp2f(fminf(blastA, 115.0f)), __builtin_amdgcn_exp2f(fminf(blastB, 115.0f))}; \
            *LDSP(f32x2_, pE, (bo) + H2_E2) = (f32x2_){__builtin_amdgcn_exp2f(fminf(blastA - brefA, 115.0f)), __builtin_amdgcn_exp2f(fminf(blastB - brefB, 115.0f))}; \
            *LDSP(f32x2_, pE, (bo) + H2_E3) = (f32x2_){__builtin_amdgcn_exp2f(fminf(brefA, 115.0f)), __builtin_amdgcn_exp2f(fminf(brefB, 115.0f))}; } } while (0)
#define H2_PROD_A(bo) do { _Pragma("unroll") for (int tj = 0; tj < 4; ++tj) { pg8::f32x4 acc = (pg8::f32x4){0.f, 0.f, 0.f, 0.f}; \
        if (tj <= pw) { bf16x8 af[4], bfr[4]; \
            _Pragma("unroll") for (int ks = 0; ks < 4; ++ks) { af[ks] = *LDSP(bf16x8, rAc, (bo) + H2_QS + ks * 64); bfr[ks] = *LDSP(bf16x8, rKc, tj * 4352 + ks * 64); } \
            _Pragma("unroll") for (int ks = 0; ks < 4; ++ks) acc = __builtin_amdgcn_mfma_f32_16x16x32_bf16(af[ks], bfr[ks], acc, 0, 0, 0); } \
        _Pragma("unroll") for (int rg = 0; rg < 4; ++rg) { const int i_ = 16 * pw + 4 * q4 + rg, j_ = 16 * tj + r; *LDSP(bf16, pAs, (bo) + H2_AS + tj * 32 + rg * 144) = (bf16)f2bf(j_ <= i_ ? acc[rg] : 0.f); } } } while (0)
    if (prod) { H2_LOAD(0); H2_PROD_B(0); if (nch > 1) H2_LOAD(1); }
    LDS_BAR();
    if (prod) { H2_PROD_A(0); }
    LDS_BAR();
    for (int c = 0; c < nch; ++c) {
        const int bo = (c & 1) * H2_BUF, bn = H2_BUF - bo;
        if (prod) { if (c + 1 < nch) { H2_PROD_B(bn); if (c + 2 < nch) H2_LOAD(c + 2); } }
        else {
            bf16x8 sB[8];
#pragma unroll
            for (int dt = 0; dt < 4; ++dt) { pg8::f32x4 e[4]; const f32x16 Sd = __builtin_bit_cast(f32x16, SU[dt]);
#pragma unroll
                for (int g = 0; g < 4; ++g) e[g] = *LDSP(pg8::f32x4, cE, bo + H2_E3 + (32 * dt + 8 * g) * 4);
#pragma unroll
                for (int s = 0; s < 2; ++s) { v4u pw_;
                    pw_.x = pg8::cvt_pk_bf16(Sd[8 * s + 0] * e[2 * s][0], Sd[8 * s + 1] * e[2 * s][1]); pw_.y = pg8::cvt_pk_bf16(Sd[8 * s + 2] * e[2 * s][2], Sd[8 * s + 3] * e[2 * s][3]);
                    pw_.z = pg8::cvt_pk_bf16(Sd[8 * s + 4] * e[2 * s + 1][0], Sd[8 * s + 5] * e[2 * s + 1][1]); pw_.w = pg8::cvt_pk_bf16(Sd[8 * s + 6] * e[2 * s + 1][2], Sd[8 * s + 7] * e[2 * s + 1][3]);
                    sB[dt * 2 + s] = __builtin_bit_cast(bf16x8, pw_); } }
#pragma unroll
            for (int tt = 0; tt < 2; ++tt) { f32x16 o;
#pragma unroll
                for (int k = 0; k < 16; ++k) o[k] = 0.f;
                { bf16x8 aA[4], vB[4];
#pragma unroll
                  for (int ks = 0; ks < 4; ++ks) if (tt == 1 || ks < 2) { vB[ks] = *LDSP(bf16x8, cV, bo + H2_VT + ks * 32); aA[ks] = *LDSP(bf16x8, cA, bo + H2_AS + tt * 4608 + ks * 32); }
#pragma unroll
                  for (int ks = 0; ks < 4; ++ks) if (tt == 1 || ks < 2) o = __builtin_amdgcn_mfma_f32_32x32x16_bf16(vB[ks], aA[ks], o, 0, 0, 0); }
#pragma unroll
                for (int hf = 0; hf < 2; ++hf) { bf16x8 aQ[4];
#pragma unroll
                    for (int k4 = 0; k4 < 4; ++k4) aQ[k4] = *LDSP(bf16x8, cQ, bo + H2_QS + tt * 8704 + (hf * 4 + k4) * 32);
#pragma unroll
                    for (int k4 = 0; k4 < 4; ++k4) o = __builtin_amdgcn_mfma_f32_32x32x16_bf16(sB[hf * 4 + k4], aQ[k4], o, 0, 0, 0); }
                { const int tk = c * 64 + 32 * tt + r32; const int t_ = dir ? T - 1 - tk : tk; bf16* orow = Ob + (size_t)t_ * 512 + 32 * w + 4 * hi;
#pragma unroll
                  for (int g = 0; g < 4; ++g) { v2u w2; w2.x = pk2(o[4 * g + 0], o[4 * g + 1]); w2.y = pk2(o[4 * g + 2], o[4 * g + 3]); *(v2u*)(orow + 8 * g) = w2; } } }
        }
        LDS_BAR();
        if (prod) { if (c + 1 < nch) { H2_PROD_A(bn); } }
        else { bf16x8 vB[4];
#pragma unroll
            for (int ks = 0; ks < 4; ++ks) vB[ks] = *LDSP(bf16x8, cV, bo + H2_VT + ks * 32);
#pragma unroll
            for (int dt = 0; dt < 4; ++dt) { bf16x8 aK[4]; pg8::f32x4 e1v[4], e2v[4];
#pragma unroll
                for (int ks = 0; ks < 4; ++ks) aK[ks] = *LDSP(bf16x8, cA, bo + H2_KT + dt * 4608 + ks * 32);
#pragma unroll
                for (int g = 0; g < 4; ++g) { e1v[g] = *LDSP(pg8::f32x4, cE, bo + H2_E1 + (32 * dt + 8 * g) * 4); e2v[g] = *LDSP(pg8::f32x4, cE, bo + H2_E2 + (32 * dt + 8 * g) * 4); }
                f32x16 u;
#pragma unroll
                for (int k = 0; k < 16; ++k) u[k] = 0.f;
#pragma unroll
                for (int ks = 0; ks < 4; ++ks) u = __builtin_amdgcn_mfma_f32_32x32x16_bf16(aK[ks], vB[ks], u, 0, 0, 0);
                f32x16 Sd = __builtin_bit_cast(f32x16, SU[dt]);
#pragma unroll
                for (int k = 0; k < 16; ++k) Sd[k] = Sd[k] * e1v[k >> 2][k & 3] + u[k] * e2v[k >> 2][k & 3];
                SU[dt] = __builtin_bit_cast(u32x16_, Sd);
                __builtin_amdgcn_sched_barrier(0); }
        }
        LDS_BAR();
    }
#undef H2_LOAD
#undef H2_PROD_B
#undef H2_PROD_A
#undef pQ
#undef cV
#undef pK
#undef cA
#undef pE
#undef cQ
#undef rAc
#undef cE
#undef rKc
#undef pAs
#undef g2
#undef q2
#undef v2
}
__device__ __forceinline__ void attn_item_naive(const Frame& F, const Args& a, int ib) {
    unsigned char* ws = a.ws;
    const bf16* QA = (const bf16*)(ws + WS_QA); const bf16* KA = (const bf16*)(ws + WS_KA); const bf16* VT = (const bf16*)(ws + WS_VT); bf16* MIX = (bf16*)(ws + WS_MIX);
    const int tok = F.tid & 63, head = F.tid >> 6, kvh = head >> 2, m = ib * 64 + tok;
    int s0, T; if (m < M_P) { T = T_P; s0 = m & ~(T_P - 1); } else { T = T_S; s0 = M_P + ((m - M_P) & ~(T_S - 1)); }
    const int t = m - s0;
    float q[64], o[64];
#pragma unroll
    for (int c = 0; c < 8; ++c) { const v4u w = *(const v4u*)(QA + qk_off(m, head, c >> 1, c & 1));
        q[c * 8 + 0] = bflo(w.x); q[c * 8 + 1] = bfhi(w.x); q[c * 8 + 2] = bflo(w.y); q[c * 8 + 3] = bfhi(w.y); q[c * 8 + 4] = bflo(w.z); q[c * 8 + 5] = bfhi(w.z); q[c * 8 + 6] = bflo(w.w); q[c * 8 + 7] = bfhi(w.w); }
#pragma unroll
    for (int d = 0; d < 64; ++d) o[d] = 0.f;
    float mx = a.in[7][head] * LOG2E, l = 1.0f;
    const float slope2 = __builtin_amdgcn_exp2f(-(float)(head + 1)) * LOG2E;
    const int lo = t - 128 < 0 ? 0 : t - 128, hi = t + 128 > T - 1 ? T - 1 : t + 128;
    for (int s = lo; s <= hi; ++s) {
        const int ms = s0 + s; float dot = 0.f;
#pragma unroll
        for (int c = 0; c < 8; ++c) { const v4u w = *(const v4u*)(KA + qk_off(ms, kvh, c >> 1, c & 1));
            dot += q[c * 8 + 0] * bflo(w.x) + q[c * 8 + 1] * bfhi(w.x) + q[c * 8 + 2] * bflo(w.y) + q[c * 8 + 3] * bfhi(w.y) + q[c * 8 + 4] * bflo(w.z) + q[c * 8 + 5] * bfhi(w.z) + q[c * 8 + 6] * bflo(w.w) + q[c * 8 + 7] * bfhi(w.w); }
        const int rel = s - t; const float lg = dot - slope2 * (float)(rel < 0 ? -rel : rel);
        const float mn = fmaxf(mx, lg), corr = __builtin_amdgcn_exp2f(mx - mn), p = __builtin_amdgcn_exp2f(lg - mn);
        l = l * corr + p; mx = mn;
        const bf16* vp = VT + vt_off(ms, kvh, 0);
#pragma unroll
        for (int d = 0; d < 64; ++d) o[d] = o[d] * corr + p * bf2f(vp[d * 16]);
    }
    const float inv = 1.0f / l; float ss = 0.f;
#pragma unroll
    for (int d = 0; d < 64; ++d) { o[d] *= inv; ss += o[d] * o[d]; }
    LAS float* red = (LAS float*)F.lds;
    red[head * 64 + tok] = ss;
    __syncthreads();
    float tot = 0.f;
#pragma unroll
    for (int h = 0; h < 8; ++h) tot += red[h * 64 + tok];
    const float rstd = 1.0f / sqrtf(tot * (1.0f / 512.0f) + EPS);
    const float* ng = a.in[8] + head * 64;
#pragma unroll
    for (int c = 0; c < 8; ++c) { v4u w; w.x = pk2(o[c * 8 + 0] * rstd * ng[c * 8 + 0], o[c * 8 + 1] * rstd * ng[c * 8 + 1]); w.y = pk2(o[c * 8 + 2] * rstd * ng[c * 8 + 2], o[c * 8 + 3] * rstd * ng[c * 8 + 3]);
        w.z = pk2(o[c * 8 + 4] * rstd * ng[c * 8 + 4], o[c * 8 + 5] * rstd * ng[c * 8 + 5]); w.w = pk2(o[c * 8 + 6] * rstd * ng[c * 8 + 6], o[c * 8 + 7] * rstd * ng[c * 8 + 7]);
        *(v4u*)(MIX + (size_t)m * D + head * 64 + c * 8) = w; }
    __syncthreads();
}

typedef float f32x16 __attribute__((ext_vector_type(16)));
__device__ __forceinline__ void attn_item_mfma(const Frame& F, const Args& a, int ib) {
    unsigned char* ws = a.ws;
    const bf16* QA = (const bf16*)(ws + WS_QA); const bf16* KA = (const bf16*)(ws + WS_KA); const bf16* VT = (const bf16*)(ws + WS_VT); bf16* MIX = (bf16*)(ws + WS_MIX);
    const int head = F.wave, kvh = head >> 2, r32 = F.lane & 31, hi = F.lane >> 5, m0 = ib * 32;
    int s0, T; if (m0 < M_P) { T = T_P; s0 = m0 & ~(T_P - 1); } else { T = T_S; s0 = M_P + ((m0 - M_P) & ~(T_S - 1)); }
    const int t0 = m0 - s0;
    const bf16* qb = QA + (((size_t)head * NT32 + ib) * 4) * 512 + r32 * 16 + hi * 8;
    bf16x8 qr[4];
#pragma unroll
    for (int d0 = 0; d0 < 4; ++d0) qr[d0] = *(const bf16x8*)(qb + d0 * 512);
    f32x16 o0, o1;
#pragma unroll
    for (int r = 0; r < 16; ++r) { o0[r] = 0.f; o1[r] = 0.f; }
    float mrun = a.in[7][head] * LOG2E, l = hi == 0 ? 1.0f : 0.0f;
    const float slope2 = __builtin_amdgcn_exp2f(-(float)(head + 1)) * LOG2E;
    const int i_lo = t0 >= 128 ? 0 : (128 - t0) >> 5; int i_hi = (T - t0 + 96) >> 5; i_hi = i_hi > 8 ? 8 : i_hi;
    for (int i = i_lo; i <= i_hi; ++i) {
        const int kt = ib - 4 + i;
        const bf16* kb = KA + (((size_t)kvh * NT32 + kt) * 4) * 512 + r32 * 16 + hi * 8;
        f32x16 s;
#pragma unroll
        for (int r = 0; r < 16; ++r) s[r] = 0.f;
#pragma unroll
        for (int d0 = 0; d0 < 4; ++d0) { const bf16x8 kf = *(const bf16x8*)(kb + d0 * 512); s = __builtin_amdgcn_mfma_f32_32x32x16_bf16(kf, qr[d0], s, 0, 0, 0); }
        const int relb = 32 * (i - 4) - r32 + 4 * hi;
        float mx = -1e30f;
#pragma unroll
        for (int r = 0; r < 16; ++r) { const int rel = relb + (r & 3) + 8 * (r >> 2); const int ar = rel < 0 ? -rel : rel; float lg = s[r] - slope2 * (float)ar; lg = ar <= 128 ? lg : -1e30f; s[r] = lg; mx = fmaxf(mx, lg); }
        mx = fmaxf(mx, __shfl_xor(mx, 32));
        const float mnew = fmaxf(mrun, mx), corr = __builtin_amdgcn_exp2f(mrun - mnew); mrun = mnew;
        float ps = 0.f;
#pragma unroll
        for (int r = 0; r < 16; ++r) { s[r] = __builtin_amdgcn_exp2f(s[r] - mnew); ps += s[r]; }
        l = l * corr + ps;
#pragma unroll
        for (int r = 0; r < 16; ++r) { o0[r] *= corr; o1[r] *= corr; }
#pragma unroll
        for (int ks = 0; ks < 2; ++ks) {
            v4u pw; pw.x = pg8::cvt_pk_bf16(s[8 * ks + 0], s[8 * ks + 1]); pw.y = pg8::cvt_pk_bf16(s[8 * ks + 2], s[8 * ks + 3]); pw.z = pg8::cvt_pk_bf16(s[8 * ks + 4], s[8 * ks + 5]); pw.w = pg8::cvt_pk_bf16(s[8 * ks + 6], s[8 * ks + 7]);
            const bf16x8 pb = __builtin_bit_cast(bf16x8, pw);
            const bf16* vb = VT + (((size_t)kvh * NT16 + kt * 2 + ks) * 64 + r32) * 16 + hi * 8;
            const bf16x8 v0 = *(const bf16x8*)(vb), v1 = *(const bf16x8*)(vb + 32 * 16);
            o0 = __builtin_amdgcn_mfma_f32_32x32x16_bf16(v0, pb, o0, 0, 0, 0);
            o1 = __builtin_amdgcn_mfma_f32_32x32x16_bf16(v1, pb, o1, 0, 0, 0);
        }
    }
    l += __shfl_xor(l, 32);
    const float inv = 1.0f / l; float ss = 0.f;
#pragma unroll
    for (int r = 0; r < 16; ++r) { o0[r] *= inv; o1[r] *= inv; ss += o0[r] * o0[r] + o1[r] * o1[r]; }
    ss += __shfl_xor(ss, 32);
    LAS float* red = (LAS float*)F.lds;
    if (hi == 0) red[head * 32 + r32] = ss;
    __syncthreads();
    float tot = 0.f;
#pragma unroll
    for (int h = 0; h < 8; ++h) tot += red[h * 32 + r32];
    const float rstd = 1.0f / sqrtf(tot * (1.0f / 512.0f) + EPS);
    const float* ng = a.in[8] + head * 64 + 4 * hi;
    bf16* orow = MIX + (size_t)(m0 + r32) * D + head * 64 + 4 * hi;
#pragma unroll
    for (int g = 0; g < 4; ++g) {
        const f32x4 g0 = *(const f32x4*)(ng + 8 * g), g1 = *(const f32x4*)(ng + 32 + 8 * g);
        v2u w0, w1; w0.x = pk2(o0[4 * g + 0] * rstd * g0.x, o0[4 * g + 1] * rstd * g0.y); w0.y = pk2(o0[4 * g + 2] * rstd * g0.z, o0[4 * g + 3] * rstd * g0.w);
        w1.x = pk2(o1[4 * g + 0] * rstd * g1.x, o1[4 * g + 1] * rstd * g1.y); w1.y = pk2(o1[4 * g + 2] * rstd * g1.z, o1[4 * g + 3] * rstd * g1.w);
        *(v2u*)(orow + 8 * g) = w0; *(v2u*)(orow + 32 + 8 * g) = w1;
    }
    __syncthreads();
}

__device__ __forceinline__ void attn_qblock(const bf16x8 (&kf)[4], const bf16x8 (&vf)[4], const bf16x8 (&qr)[4], int dtile, int dl, float slope2, const float (&cs)[16], f32x16& o0, f32x16& o1, float& mrun, float& l) {
    f32x16 s; const float dlf = (float)dl;
    if (dtile < 0) { const float base = slope2 * ((float)(32 * dtile) + dlf);
#pragma unroll
        for (int r = 0; r < 16; ++r) s[r] = base + cs[r]; }
    else if (dtile > 0) { const float base = -slope2 * ((float)(32 * dtile) + dlf);
#pragma unroll
        for (int r = 0; r < 16; ++r) s[r] = base - cs[r]; }
    else { const float base = slope2 * dlf;
#pragma unroll
        for (int r = 0; r < 16; ++r) s[r] = -__builtin_fabsf(base + cs[r]); }
#pragma unroll
    for (int d0 = 0; d0 < 4; ++d0) s = __builtin_amdgcn_mfma_f32_32x32x16_bf16(kf[d0], qr[d0], s, 0, 0, 0);
    if (dtile == -4) {
#pragma unroll
        for (int r = 0; r < 16; ++r) s[r] = ((r & 3) + 8 * (r >> 2) + dl >= 0) ? s[r] : -1e30f; }
    if (dtile == 4) {
#pragma unroll
        for (int r = 0; r < 16; ++r) s[r] = ((r & 3) + 8 * (r >> 2) + dl <= 0) ? s[r] : -1e30f; }
    float mx = __builtin_fmaxf(__builtin_fmaxf(s[0], s[1]), s[2]);
#pragma unroll
    for (int r = 3; r < 15; r += 2) mx = __builtin_fmaxf(__builtin_fmaxf(mx, s[r]), s[r + 1]);
    mx = __builtin_fmaxf(mx, s[15]);
    mx = __builtin_fmaxf(mx, __shfl_xor(mx, 32));
    if (__builtin_amdgcn_ballot_w64(mx > mrun) != 0ull) {
        const float mnew = __builtin_fmaxf(mrun, mx), corr = __builtin_amdgcn_exp2f(mrun - mnew); mrun = mnew; l *= corr;
#pragma unroll
        for (int r = 0; r < 16; ++r) { o0[r] *= corr; o1[r] *= corr; } }
    float ps = 0.f;
#pragma unroll
    for (int r = 0; r < 16; ++r) { s[r] = __builtin_amdgcn_exp2f(s[r] - mrun); ps += s[r]; }
    l += ps;
#pragma unroll
    for (int ks = 0; ks < 2; ++ks) {
        v4u pw; pw.x = pg8::cvt_pk_bf16(s[8 * ks + 0], s[8 * ks + 1]); pw.y = pg8::cvt_pk_bf16(s[8 * ks + 2], s[8 * ks + 3]); pw.z = pg8::cvt_pk_bf16(s[8 * ks + 4], s[8 * ks + 5]); pw.w = pg8::cvt_pk_bf16(s[8 * ks + 6], s[8 * ks + 7]);
        const bf16x8 pb = __builtin_bit_cast(bf16x8, pw);
        o0 = __builtin_amdgcn_mfma_f32_32x32x16_bf16(vf[ks * 2 + 0], pb, o0, 0, 0, 0);
        o1 = __builtin_amdgcn_mfma_f32_32x32x16_bf16(vf[ks * 2 + 1], pb, o1, 0, 0, 0);
    }
}
__device__ __forceinline__ void attn_item_mfma2(const Frame& F, const Args& a, int ib) {
    unsigned char* ws = a.ws;
    const bf16* QA = (const bf16*)(ws + WS_QA); const bf16* KA = (const bf16*)(ws + WS_KA); const bf16* VT = (const bf16*)(ws + WS_VT); bf16* MIX = (bf16*)(ws + WS_MIX);
    const int head = F.wave, kvh = head >> 2, r32 = F.lane & 31, hi = F.lane >> 5, m0 = ib * 64;
    int s0, T; if (m0 < M_P) { T = T_P; s0 = m0 & ~(T_P - 1); } else { T = T_S; s0 = M_P + ((m0 - M_P) & ~(T_S - 1)); }
    const int t0 = m0 - s0;
    const int lofs = r32 * 16 + hi * 8;
    bf16x8 qa[4], qb[4];
    { const bf16* q0 = QA + (((size_t)head * NT32 + 2 * ib) * 4) * 512 + lofs;
#pragma unroll
      for (int d0 = 0; d0 < 4; ++d0) { qa[d0] = *(const bf16x8*)(q0 + d0 * 512); qb[d0] = *(const bf16x8*)(q0 + 2048 + d0 * 512); } }
    f32x16 oa0, oa1, ob0, ob1;
#pragma unroll
    for (int r = 0; r < 16; ++r) { oa0[r] = 0.f; oa1[r] = 0.f; ob0[r] = 0.f; ob1[r] = 0.f; }
    const float sink2 = a.in[7][head] * LOG2E;
    float ma = sink2, mb = sink2, la = hi == 0 ? 1.0f : 0.0f, lb = la;
    const float slope2 = __builtin_amdgcn_exp2f(-(float)(head + 1)) * LOG2E;
    const int i_lo = t0 >= 128 ? 0 : (128 - t0) >> 5; int i_hi = (T - t0 + 96) >> 5; i_hi = i_hi > 9 ? 9 : i_hi;
    const bf16* kbase = KA + (((size_t)kvh * NT32 + (2 * ib - 4)) * 4) * 512 + lofs;
    const bf16* vbase = VT + (((size_t)kvh * NT16 + (size_t)(2 * ib - 4) * 2) * 64) * 16 + lofs;
    bf16x8 kf[4], vf[4];
    LAS unsigned char* ring = F.lds + F.wave * 16384;
#define AT_DMA(slot_, i_) do { const bf16* kp_ = kbase + (ptrdiff_t)(i_) * 2048; const bf16* vp_ = vbase + (ptrdiff_t)(i_) * 2048; \
        _Pragma("unroll") for (int d0 = 0; d0 < 4; ++d0) { \
            __builtin_amdgcn_global_load_lds((const unsigned*)(kp_ + d0 * 512), (LAS unsigned*)(ring + (slot_) * 8192 + d0 * 1024), 16, 0, 0); \
            __builtin_amdgcn_global_load_lds((const unsigned*)(vp_ + d0 * 512), (LAS unsigned*)(ring + (slot_) * 8192 + 4096 + d0 * 1024), 16, 0, 0); } } while (0)
    AT_DMA(0, i_lo);
    if (i_lo + 1 <= i_hi) AT_DMA(1, i_lo + 1);
    const int relq = -r32 + 4 * hi;
    float cs[16];
#pragma unroll
    for (int r = 0; r < 16; ++r) cs[r] = slope2 * (float)((r & 3) + 8 * (r >> 2));
    for (int i = i_lo; i <= i_hi; ++i) {
        const int sl = (i - i_lo) & 1;
        if (i < i_hi) asm volatile("s_waitcnt vmcnt(8)" ::: "memory"); else asm volatile("s_waitcnt vmcnt(0)" ::: "memory");
        { const LAS unsigned char* sp = ring + sl * 8192 + F.lane * 16;
#pragma unroll
          for (int d0 = 0; d0 < 4; ++d0) { kf[d0] = *(const LAS bf16x8*)(sp + d0 * 1024); vf[d0] = *(const LAS bf16x8*)(sp + 4096 + d0 * 1024); } }
        asm volatile("s_waitcnt lgkmcnt(0)" ::: "memory");
        if (i + 2 <= i_hi) AT_DMA(sl, i + 2);
        if (i <= 8) attn_qblock(kf, vf, qa, i - 4, relq, slope2, cs, oa0, oa1, ma, la);
        if (i >= 1) attn_qblock(kf, vf, qb, i - 5, relq, slope2, cs, ob0, ob1, mb, lb);
    }
#undef AT_DMA
    la += __shfl_xor(la, 32); lb += __shfl_xor(lb, 32);
    const float ia = 1.0f / la, ibv = 1.0f / lb; float ssa = 0.f, ssb = 0.f;
#pragma unroll
    for (int r = 0; r < 16; ++r) { oa0[r] *= ia; oa1[r] *= ia; ob0[r] *= ibv; ob1[r] *= ibv; ssa += oa0[r] * oa0[r] + oa1[r] * oa1[r]; ssb += ob0[r] * ob0[r] + ob1[r] * ob1[r]; }
    ssa += __shfl_xor(ssa, 32); ssb += __shfl_xor(ssb, 32);
    LAS float* red = (LAS float*)(F.lds + 131072);
    if (hi == 0) { red[head * 64 + r32] = ssa; red[head * 64 + 32 + r32] = ssb; }
    __syncthreads();
    float ta = 0.f, tb = 0.f;
#pragma unroll
    for (int h = 0; h < 8; ++h) { ta += red[h * 64 + r32]; tb += red[h * 64 + 32 + r32]; }
    const float ra = 1.0f / sqrtf(ta * (1.0f / 512.0f) + EPS), rb = 1.0f / sqrtf(tb * (1.0f / 512.0f) + EPS);
    const float* ng = a.in[8] + head * 64 + 4 * hi;
    bf16* orow = MIX + (size_t)(m0 + r32) * D + head * 64 + 4 * hi;
#pragma unroll
    for (int g = 0; g < 4; ++g) {
        const f32x4 g0 = *(const f32x4*)(ng + 8 * g), g1 = *(const f32x4*)(ng + 32 + 8 * g);
        v2u w0, w1; w0.x = pk2(oa0[4 * g + 0] * ra * g0.x, oa0[4 * g + 1] * ra * g0.y); w0.y = pk2(oa0[4 * g + 2] * ra * g0.z, oa0[4 * g + 3] * ra * g0.w);
        w1.x = pk2(oa1[4 * g + 0] * ra * g1.x, oa1[4 * g + 1] * ra * g1.y); w1.y = pk2(oa1[4 * g + 2] * ra * g1.z, oa1[4 * g + 3] * ra * g1.w);
        *(v2u*)(orow + 8 * g) = w0; *(v2u*)(orow + 32 + 8 * g) = w1;
        w0.x = pk2(ob0[4 * g + 0] * rb * g0.x, ob0[4 * g + 1] * rb * g0.y); w0.y = pk2(ob0[4 * g + 2] * rb * g0.z, ob0[4 * g + 3] * rb * g0.w);
        w1.x = pk2(ob1[4 * g + 0] * rb * g1.x, ob1[4 * g + 1] * rb * g1.y); w1.y = pk2(ob1[4 * g + 2] * rb * g1.z, ob1[4 * g + 3] * rb * g1.w);
        *(v2u*)(orow + 32 * D + 8 * g) = w0; *(v2u*)(orow + 32 * D + 32 + 8 * g) = w1;
    }
    __syncthreads();
}
__device__ __forceinline__ void hg_finalize(const Frame& F, const Args& a) {
    unsigned char* ws = a.ws;
    const bf16* OF = (const bf16*)a.out; const bf16* OB = OF + (size_t)M * 512; const bf16* GH = (const bf16*)(ws + WS_GH); bf16* MIX = (bf16*)(ws + WS_MIX);
    const int gw = F.bid * NWAVES + F.wave, NGW = F.G * NWAVES;
    float ng[8];
#pragma unroll
    for (int i = 0; i < 8; ++i) ng[i] = a.in[11][F.lane * 8 + i];
    for (int m2 = gw * 2; m2 < M; m2 += NGW * 2) {
        v4u wf[2], wb[2], wg[2];
#pragma unroll
        for (int rr = 0; rr < 2; ++rr) { const size_t idx = (size_t)(m2 + rr) * 512 + F.lane * 8; wf[rr] = __builtin_nontemporal_load((const v4u*)(OF + idx)); wb[rr] = __builtin_nontemporal_load((const v4u*)(OB + idx)); wg[rr] = __builtin_nontemporal_load((const v4u*)(GH + idx)); }
#pragma unroll
        for (int rr = 0; rr < 2; ++rr) {
            float o[8], gt[8];
            o[0] = bflo(wf[rr].x) + bflo(wb[rr].x); o[1] = bfhi(wf[rr].x) + bfhi(wb[rr].x); o[2] = bflo(wf[rr].y) + bflo(wb[rr].y); o[3] = bfhi(wf[rr].y) + bfhi(wb[rr].y);
            o[4] = bflo(wf[rr].z) + bflo(wb[rr].z); o[5] = bfhi(wf[rr].z) + bfhi(wb[rr].z); o[6] = bflo(wf[rr].w) + bflo(wb[rr].w); o[7] = bfhi(wf[rr].w) + bfhi(wb[rr].w);
            gt[0] = bflo(wg[rr].x); gt[1] = bfhi(wg[rr].x); gt[2] = bflo(wg[rr].y); gt[3] = bfhi(wg[rr].y); gt[4] = bflo(wg[rr].z); gt[5] = bfhi(wg[rr].z); gt[6] = bflo(wg[rr].w); gt[7] = bfhi(wg[rr].w);
            float ss = 0.f;
#pragma unroll
            for (int i = 0; i < 8; ++i) ss += o[i] * o[i];
            ss += __shfl_xor(ss, 1); ss += __shfl_xor(ss, 2); ss += __shfl_xor(ss, 4); ss += __shfl_xor(ss, 8);
            const float rstd = 1.0f / sqrtf(ss * (1.0f / 128.0f) + EPS);
            float y[8];
#pragma unroll
            for (int i = 0; i < 8; ++i) y[i] = o[i] * rstd * ng[i] * silu_f(gt[i]);
            v4u w; w.x = pk2(y[0], y[1]); w.y = pk2(y[2], y[3]); w.z = pk2(y[4], y[5]); w.w = pk2(y[6], y[7]);
            *(v4u*)(MIX + (size_t)(m2 + rr) * D + 512 + F.lane * 8) = w; }
    }
}

#define XB_TMO      128
#define XB_XCNT(j)  (256  + 64 * (j))
#define XB_XSUB(j)  (1280 + 64 * (j))
#define XB_XGEN(j)  (2304 + 64 * (j))
#define XB_TOP      3328
#define XB_TOPGEN   3392
#define XCD_BAR_WORDS 3456
#define XB_SPIN_CAP (1u << 18)

__device__ __forceinline__ unsigned xb_ld(unsigned* p)              { return __hip_atomic_load(p, __ATOMIC_RELAXED, __HIP_MEMORY_SCOPE_AGENT); }
__device__ __forceinline__ unsigned xb_add(unsigned* p, unsigned v) { return __hip_atomic_fetch_add(p, v, __ATOMIC_RELAXED, __HIP_MEMORY_SCOPE_AGENT); }
__device__ __forceinline__ unsigned xb_xcc_id() { return (unsigned)__builtin_amdgcn_s_getreg((3 << 11) | 20) & 0xFu; }
#define XB_SPIN(cond, bar) do { unsigned _sp = 0; while (cond) { __builtin_amdgcn_s_sleep(1); \
    if ((++_sp & 255u) == 0u) { if (xb_ld(&(bar)[XB_TMO])) break; if (_sp > XB_SPIN_CAP) { atomicAdd(&(bar)[XB_TMO], 1u); break; } } } } while (0)

struct XcdBarrier {
    unsigned* bar; unsigned x;
    volatile LAS unsigned* st;
};

__device__ __forceinline__ XcdBarrier xcd_barrier_post(unsigned* bar, volatile LAS unsigned* st) {
    XcdBarrier b; b.bar = bar; b.x = xb_xcc_id(); b.st = st;
    if (threadIdx.x == 0) (void)xb_add(&bar[XB_XCNT(b.x)], 1u);
    return b;
}
__device__ __forceinline__ void xcd_barrier_complete(unsigned* bar, unsigned x, unsigned& nloc, unsigned& nx) {
    const unsigned G = gridDim.x * gridDim.y * gridDim.z;
    unsigned sum, cnt, mine, sp = 0u;
    for (;;) {
        sum = 0u; cnt = 0u; mine = 0u;
#pragma unroll
        for (unsigned j = 0; j < 16; ++j) { const unsigned c = xb_ld(&bar[XB_XCNT(j)]); sum += c; cnt += (c > 0u) ? 1u : 0u; mine = (j == x) ? c : mine; }
        if (sum == G) break;
        __builtin_amdgcn_s_sleep(1);
        if ((++sp & 255u) == 0u) { if (xb_ld(&bar[XB_TMO])) break; if (sp > XB_SPIN_CAP) { atomicAdd(&bar[XB_TMO], 1u); break; } }
    }
    nloc = mine > 0u ? mine : 1u; nx = cnt > 0u ? cnt : 1u;
}

__device__ __forceinline__ void xcd_barrier(const XcdBarrier& b) {
    asm volatile("s_waitcnt vmcnt(0)" ::: "memory");
    __syncthreads();
    if (threadIdx.x == 0) {
        unsigned* bar = b.bar;
        __builtin_amdgcn_s_waitcnt(0);
        unsigned nloc = b.st[0], nx = b.st[1];
        if (nloc == 0u) { xcd_barrier_complete(bar, b.x, nloc, nx); b.st[0] = nloc; b.st[1] = nx; }
        const unsigned old = xb_add(&bar[XB_XSUB(b.x)], 1u);
        const unsigned gen = old / nloc;
        if (old + 1u == (gen + 1u) * nloc) {
            __builtin_amdgcn_fence(__ATOMIC_RELEASE, "agent");
            asm volatile("s_waitcnt vmcnt(0)" ::: "memory");
            const unsigned og = xb_add(&bar[XB_TOP], 1u);
            const unsigned tg = og / nx;
            if (og + 1u == (tg + 1u) * nx) xb_add(&bar[XB_TOPGEN], 1u);
            else XB_SPIN(xb_ld(&bar[XB_TOPGEN]) == tg, bar);
            __builtin_amdgcn_fence(__ATOMIC_ACQUIRE, "agent");
            xb_add(&bar[XB_XGEN(b.x)], 1u);
            asm volatile("s_waitcnt vmcnt(0)" ::: "memory");
        } else {
            XB_SPIN(xb_ld(&bar[XB_XGEN(b.x)]) == gen, bar);
            __builtin_amdgcn_fence(__ATOMIC_ACQUIRE, "agent");
            asm volatile("s_waitcnt vmcnt(0)" ::: "memory");
        }
    }
    __syncthreads();
}

#ifndef PROBE_MASK
#define PROBE_MASK 0
#endif
#if PROBE_MASK
#define PSTAMP(k) do { const unsigned long long now_ = __builtin_amdgcn_s_memrealtime(); if ((PROBE_MASK >> (k)) & 1) tacc += now_ - tprev; tprev = now_; } while (0)
#else
#define PSTAMP(k) do {} while (0)
#endif
__global__ void __launch_bounds__(NWAVES * 64, 2) hymba_fwd(Args args) {
    extern __shared__ __attribute__((aligned(16))) unsigned char lds[];
    cg::grid_group grid = cg::this_grid();
    Frame F; F.lds = (LAS unsigned char*)lds; F.tid = threadIdx.x; F.lane = F.tid & 63; F.wave = __builtin_amdgcn_readfirstlane(F.tid >> 6); F.G = gridDim.x; F.bid = blockIdx.x;
    unsigned char* ws = args.ws;
    bf16* XB = (bf16*)(ws + WS_XB); bf16* HB = (bf16*)(ws + WS_H);
    const float* ln_g = args.in[2]; const float* ln_b = args.in[3];
    volatile LAS int* misc = (volatile LAS int*)(F.lds + MISC_OFF);
    bf16* VHI = (bf16*)(ws + WS_GH); bf16* VLO = (bf16*)(ws + WS_BIG);

#if PROBE_MASK
    unsigned long long tacc = 0, tprev = __builtin_amdgcn_s_memrealtime();
#endif
    if (F.tid < 2) misc[8 + F.tid] = 0;
    __syncthreads();
    XcdBarrier xbar = xcd_barrier_post((unsigned*)(ws + WS_BAR), (volatile LAS unsigned*)(misc + 8));
    if (args.ws == nullptr) grid.sync();
    p0_prologue(F, args, 0);
    PSTAMP(12);
    p0_prologue(F, args, 1);
    PSTAMP(13);
    xcd_barrier(xbar); PSTAMP(0);
#ifndef NO_P1
    { pg8::Gemm g{XB, (const bf16*)(ws + WS_W13A), M, 2 * FF, D}; pg8::StaticOrder S; S.init(M, 2 * FF, F.G, F.bid); pg8::EpiSwiGLU E{HB};
      pg8::gemm_phase<pg8::EpiSwiGLU, pg8::StaticOrder, false, PG8_SP2>(F.lds, g, S, E); }
#endif
    xcd_barrier(xbar); PSTAMP(1);
#ifndef NO_P2
    { pg8::Gemm g{HB, (const bf16*)(ws + WS_W2A), M, D, FF}; pg8::StaticOrder S; S.init(M, D, F.G, F.bid); pg8::EpiResB E{XB, VHI, ALPHA, 0.5f};
      pg8::gemm_phase<pg8::EpiResB, pg8::StaticOrder, PG8_ALIGN, PG8_SP2>(F.lds, g, S, E); }
#endif
    xcd_barrier(xbar); PSTAMP(2);
#ifndef NO_P3
    ln_phase(F, VHI, XB, nullptr, ln_g, ln_b);
#endif
    xcd_barrier(xbar); PSTAMP(3);
#ifndef NO_P4
    { pg8::Gemm g{XB, (const bf16*)(ws + WS_WIN), M, NIN, D}; pg8::StaticOrder S; S.init(M, NIN, F.G, F.bid);
      pg8::EpiIn E{ws, args.in[9], args.in[10]};
      pg8::gemm_phase<pg8::EpiIn, pg8::StaticOrder, PG8_ALIGN, PG8_SP2>(F.lds, g, S, E); }
#endif
    xcd_barrier(xbar); PSTAMP(4);
#ifndef NO_P5
#ifndef NO_P5H
    if (F.bid < 192) { Frame F1 = F; int t1 = threadIdx.x; asm volatile("" : "+v"(t1)); F1.tid = t1; F1.lane = t1 & 63; F1.wave = __builtin_amdgcn_readfirstlane(t1 >> 6); hgrn_item_ws(F1, args, F.bid); }
    PSTAMP(11);
#endif
#ifndef NO_P5A
    { unsigned* ctr = (unsigned*)(ws + WS_CTL); Frame F2 = F; int t2 = threadIdx.x; asm volatile("" : "+v"(t2)); F2.tid = t2; F2.lane = t2 & 63; F2.wave = __builtin_amdgcn_readfirstlane(t2 >> 6);
      constexpr int NIT = M / 64, PER = NIT / 8;
      for (int gg = 0; gg < 8; ++gg) { const int grp = (F.bid + gg) & 7; unsigned* cg_ = ctr + grp * 64;
          for (;;) { if (F2.tid == 0) misc[0] = (int)atomicAdd(cg_, 1u); __syncthreads(); const int k = misc[0]; __syncthreads(); if (k >= PER) break; attn_item_mfma2(F2, args, grp * PER + k); } } }
#endif
#endif
    xcd_barrier(xbar); PSTAMP(5);
#ifndef NO_P6
    hg_finalize(F, args);
#endif
    xcd_barrier(xbar); PSTAMP(6);
#ifndef NO_P7
    { pg8::Gemm g{(const bf16*)(ws + WS_MIX), (const bf16*)(ws + WS_WOUT), M, D, D}; pg8::StaticOrder S; S.init(M, D, F.G, F.bid); pg8::EpiResB E{XB, VLO, ALPHA, 1.0f};
      pg8::gemm_phase<pg8::EpiResB, pg8::StaticOrder, PG8_ALIGN, PG8_SP2>(F.lds, g, S, E); }
#endif
    xcd_barrier(xbar); PSTAMP(7);
#ifndef NO_P8
    ln_phase(F, VLO, XB, nullptr, ln_g + D, ln_b + D);
#endif
    xcd_barrier(xbar); PSTAMP(8);
#ifndef NO_P9
#ifdef COOL_TEST
    { const unsigned long long t0_ = __builtin_amdgcn_s_memrealtime(); while (__builtin_amdgcn_s_memrealtime() - t0_ < 100000ull) __builtin_amdgcn_s_sleep(32); PSTAMP(14); }
#endif
    { pg8::Gemm g{XB, (const bf16*)(ws + WS_W13B), M, 2 * FF, D}; pg8::StaticOrder S; S.init(M, 2 * FF, F.G, F.bid); pg8::EpiSwiGLU E{HB};
      pg8::gemm_phase<pg8::EpiSwiGLU, pg8::StaticOrder, false, PG8_SP2>(F.lds, g, S, E); }
#endif
    xcd_barrier(xbar); PSTAMP(9);
#ifndef NO_P10
    { pg8::Gemm g{HB, (const bf16*)(ws + WS_W2B), M, D, FF}; pg8::StaticOrder S; S.init(M, D, F.G, F.bid); pg8::EpiResB E{XB, VHI, ALPHA, 0.5f};
      pg8::gemm_phase<pg8::EpiResB, pg8::StaticOrder, PG8_ALIGN, PG8_SP2>(F.lds, g, S, E); }
#endif
    xcd_barrier(xbar); PSTAMP(10);
#ifndef NO_P11
#if PROBE_MASK
    if (F.bid == 0 && F.tid == 0) *(volatile unsigned long long*)(ws + WS_CTL + 3072) = tacc;
    grid.sync();
    { const unsigned long long dl = *(volatile unsigned long long*)(ws + WS_CTL + 3072); const unsigned long long t0_ = __builtin_amdgcn_s_memrealtime();
      while (__builtin_amdgcn_s_memrealtime() - t0_ < dl) __builtin_amdgcn_s_sleep(8); }
#endif
#ifdef SYNC_TEST
    for (int q_ = 0; q_ < 10; ++q_) grid.sync();
#endif
    ln_phase(F, VHI, nullptr, args.out, ln_g + 2 * D, ln_b + 2 * D);
#ifdef DUP_P11
    xcd_barrier(xbar);
    ln_phase(F, VHI, nullptr, args.out, ln_g + 2 * D, ln_b + 2 * D);
#endif
#endif
}

extern "C" void kernel_launch(void* const* d_in, const int* in_sizes, int n_in, void* d_out, int out_size, void* d_ws, size_t ws_size, hipStream_t stream) {
    static int grid = 0;
    if (grid == 0) {
        if (n_in != 13 || out_size != M * D || ws_size < WS_END) { fprintf(stderr, "kernel_launch: unexpected shapes n_in %d out %d ws %zu\n", n_in, out_size, ws_size); grid = -1; return; }
        int dev = 0, cus = 0, per_cu = 0;
        hipGetDevice(&dev); hipDeviceGetAttribute(&cus, hipDeviceAttributeMultiprocessorCount, dev);
        hipFuncSetAttribute((const void*)hymba_fwd, hipFuncAttributeMaxDynamicSharedMemorySize, LDS_BYTES);
        hipOccupancyMaxActiveBlocksPerMultiprocessor(&per_cu, (const void*)hymba_fwd, NWAVES * 64, LDS_BYTES);
        if (per_cu < 1) { fprintf(stderr, "kernel_launch: occupancy query %d\n", per_cu); per_cu = 1; }
        (void)hipGetLastError();
        grid = cus;
    }
    if (grid < 0) return;
    hipMemsetAsync((char*)d_ws + WS_CTL, 0, 4096 + 16384, stream);
    Args a{};
    for (int i = 0; i < 13; ++i) a.in[i] = (const float*)d_in[i];
    a.out = (float*)d_out; a.ws = (unsigned char*)d_ws;
    void* kargs[] = {&a};
    hipError_t e = hipLaunchCooperativeKernel((const void*)hymba_fwd, dim3(grid), dim3(NWAVES * 64), kargs, LDS_BYTES, stream);
    if (e != hipSuccess) fprintf(stderr, "cooperative launch failed: %s (grid %d)\n", hipGetErrorString(e), grid);
}
```
